# Optimizing an MI355X kernel written in HIP

```python
import jax, jax.numpy as jnp
from jax import lax
import numpy as np

D_MODEL = 1024
BATCH = 32
SEQ = 2048
DEPTH = 1
DEC_BATCH = 1
DEC_SEQ = 16384
PAST_LEN = 128

MLA_HEADS = 16
QK_NOPE = 64
QK_ROPE = 32
V_HEAD = 64
Q_LORA = 384
KV_LORA = 256
MLA_WIDTH = MLA_HEADS * V_HEAD
ROPE_THETA = 10000.0
Q_BLOCK = 128
SSM_HEADS = 16
SSM_HEAD_DIM = 64
D_SSM = SSM_HEADS * SSM_HEAD_DIM
SSM_GROUPS = 2
D_STATE = 64
SSM_CONV = 3
CHUNK = 128
D_XBC = D_SSM + 2 * SSM_GROUPS * D_STATE
MIX_WIDTH = MLA_WIDTH + D_SSM
D_IN = Q_LORA + (KV_LORA + QK_ROPE) + D_SSM + D_XBC + 2 * SSM_HEADS
SPLITS = (Q_LORA,
          Q_LORA + KV_LORA + QK_ROPE,
          Q_LORA + KV_LORA + QK_ROPE + D_SSM,
          Q_LORA + KV_LORA + QK_ROPE + D_SSM + D_XBC)
D_FF = 2816
FFN_CONV = 3
EPS = 1e-6

kernel_name = "hymba_mla_ssd_convffn_encoder"


def rmsnorm(x, w):
    xf = x.astype(jnp.float32)
    y = xf * lax.rsqrt(jnp.mean(xf * xf, axis=-1, keepdims=True) + EPS)
    return (y * w.astype(jnp.float32)).astype(x.dtype)


def dwconv_centred(x, w, b):
    K = w.shape[0]
    p = K // 2
    L = x.shape[1]
    xp = jnp.pad(x, ((0, 0), (p, p), (0, 0)))
    y = xp[:, 0:L] * w[0]
    for k in range(1, K):
        y = y + xp[:, k:k + L] * w[k]
    return y + b


def rope_tables(L):
    inv = ROPE_THETA ** (-jnp.arange(0, QK_ROPE, 2, dtype=jnp.float32) / QK_ROPE)
    ang = jnp.arange(L, dtype=jnp.float32)[:, None] * inv[None, :]
    return jnp.cos(ang), jnp.sin(ang)


def apply_rope(x, cos, sin):
    x1, x2 = jnp.split(x, 2, axis=-1)
    return jnp.concatenate([x1 * cos - x2 * sin, x2 * cos + x1 * sin], axis=-1).astype(x.dtype)


def mla(q_lat, kv_lat, q_a_norm, kv_a_norm, w_q_b, w_kv_b):
    b, L, _ = q_lat.shape
    q = (rmsnorm(q_lat, q_a_norm) @ w_q_b).reshape(b, L, MLA_HEADS, QK_NOPE + QK_ROPE)
    c_kv, k_rope = kv_lat[..., :KV_LORA], kv_lat[..., KV_LORA:]
    kv = (rmsnorm(c_kv, kv_a_norm) @ w_kv_b).reshape(b, L, MLA_HEADS, QK_NOPE + V_HEAD)
    k_nope, v = kv[..., :QK_NOPE], kv[..., QK_NOPE:]
    cos, sin = rope_tables(L)
    q_nope = q[..., :QK_NOPE]
    q_rope = apply_rope(q[..., QK_NOPE:], cos[:, None, :], sin[:, None, :])
    k_rope = apply_rope(k_rope, cos, sin)
    scale = (QK_NOPE + QK_ROPE) ** -0.5
    nb = L // Q_BLOCK

    def blocks(t):
        return jnp.moveaxis(t.reshape(b, nb, Q_BLOCK, *t.shape[2:]), 1, 0)

    def attend(qs):
        qn, qr = qs
        s = (jnp.einsum('bqhd,bkhd->bhqk', qn, k_nope, preferred_element_type=jnp.float32)
             + jnp.einsum('bqhr,bkr->bhqk', qr, k_rope, preferred_element_type=jnp.float32))
        p = jax.nn.softmax(s * scale, axis=-1)
        return jnp.einsum('bhqk,bkhv->bqhv', p.astype(v.dtype), v)

    o = lax.map(attend, (blocks(q_nope), blocks(q_rope)))
    return jnp.moveaxis(o, 0, 1).reshape(b, L, MLA_WIDTH)


def ssd_chunked(x, dt, A, Bm, Cm):
    b, L, H, P = x.shape
    G, N = Bm.shape[2], Bm.shape[3]
    hg = H // G
    c = L // CHUNK
    f32 = jnp.float32
    xf = x.astype(f32).reshape(b, c, CHUNK, G, hg, P)
    dtc = dt.reshape(b, c, CHUNK, G, hg)
    Bc = Bm.astype(f32).reshape(b, c, CHUNK, G, N)
    Cc = Cm.astype(f32).reshape(b, c, CHUNK, G, N)
    xdt = xf * dtc[..., None]
    acs = jnp.cumsum(dtc * A.reshape(G, hg), axis=2)
    acs_t = jnp.moveaxis(acs, 2, -1)
    seg = acs_t[..., :, None] - acs_t[..., None, :]
    lower = jnp.tril(jnp.ones((CHUNK, CHUNK), dtype=bool))
    Lm = jnp.exp(jnp.where(lower, seg, -jnp.inf))
    CB = jnp.einsum('bctgn,bcsgn->bcgts', Cc, Bc)
    y_diag = jnp.einsum('bcgts,bcghts,bcsghp->bctghp', CB, Lm, xdt)
    decay_to_end = jnp.exp(acs[:, :, -1:] - acs)
    states = jnp.einsum('bcsgn,bcsgh,bcsghp->bcghpn', Bc, decay_to_end, xdt)
    chunk_decay = jnp.exp(acs[:, :, -1])

    def step(h, inp):
        s_k, d_k = inp
        return h * d_k[..., None, None] + s_k, h

    h0 = jnp.zeros((b, G, hg, P, N), f32)
    _, h_prev = lax.scan(step, h0, (jnp.moveaxis(states, 1, 0), jnp.moveaxis(chunk_decay, 1, 0)))
    h_prev = jnp.moveaxis(h_prev, 0, 1)
    y_off = jnp.einsum('bctgn,bcghpn,bctgh->bctghp', Cc, h_prev, jnp.exp(acs))
    return (y_diag + y_off).reshape(b, L, H, P)


def ssd_mixer(z, xbc, dt_raw, conv_w, conv_b, dt_bias_f, dt_bias_b, a_log_f, a_log_b, d_skip, ssm_norm):
    b, L, _ = z.shape
    f32 = jnp.float32
    GN = SSM_GROUPS * D_STATE
    xbc = jax.nn.silu(dwconv_centred(xbc, conv_w, conv_b))
    xs = xbc[..., :D_SSM].reshape(b, L, SSM_HEADS, SSM_HEAD_DIM)
    Bm = xbc[..., D_SSM:D_SSM + GN].reshape(b, L, SSM_GROUPS, D_STATE)
    Cm = xbc[..., D_SSM + GN:].reshape(b, L, SSM_GROUPS, D_STATE)
    dt_f = jax.nn.softplus(dt_raw[..., :SSM_HEADS].astype(f32) + dt_bias_f.astype(f32))
    dt_b = jax.nn.softplus(dt_raw[..., SSM_HEADS:].astype(f32) + dt_bias_b.astype(f32))
    A_f = -jnp.exp(a_log_f.astype(f32))
    A_b = -jnp.exp(a_log_b.astype(f32))
    flip = lambda t: jnp.flip(t, axis=1)
    y_f = ssd_chunked(xs, dt_f, A_f, Bm, Cm)
    y_b = flip(ssd_chunked(flip(xs), flip(dt_b), A_b, flip(Bm), flip(Cm)))
    y = y_f + y_b + xs.astype(f32) * d_skip.astype(f32)[:, None]
    y = y.reshape(b, L, D_SSM).astype(z.dtype) * jax.nn.silu(z)
    gs = D_SSM // SSM_GROUPS
    y = rmsnorm(y.reshape(b, L, SSM_GROUPS, gs), ssm_norm.reshape(SSM_GROUPS, gs))
    return y.reshape(b, L, D_SSM)


def conv_ffn(h, w_gate, w_up, conv_w, conv_b, w_down):
    g = dwconv_centred(h @ w_gate, conv_w, conv_b)
    return (jax.nn.silu(g) * (h @ w_up)) @ w_down


def encoder(x, norm1, w_in, q_a_norm, kv_a_norm, w_q_b, w_kv_b, conv_w, conv_b,
            dt_bias_f, dt_bias_b, a_log_f, a_log_b, d_skip, ssm_norm, w_out,
            norm2, w_gate, w_up, ffn_conv_w, ffn_conv_b, w_down, final_norm):
    for l in range(DEPTH):
        h = rmsnorm(x, norm1[l])
        proj = h @ w_in[l]
        q_lat, kv_lat, z, xbc, dt_raw = jnp.split(proj, SPLITS, axis=-1)
        attn = mla(q_lat, kv_lat, q_a_norm[l], kv_a_norm[l], w_q_b[l], w_kv_b[l])
        ssm = ssd_mixer(z, xbc, dt_raw, conv_w[l], conv_b[l], dt_bias_f[l], dt_bias_b[l],
                        a_log_f[l], a_log_b[l], d_skip[l], ssm_norm[l])
        x = x + jnp.concatenate([attn, ssm], axis=-1) @ w_out[l]
        x = x + conv_ffn(rmsnorm(x, norm2[l]), w_gate[l], w_up[l], ffn_conv_w[l], ffn_conv_b[l], w_down[l])
    return rmsnorm(x, final_norm)


def setup_inputs(seed: int = 0) -> dict:
    key = jax.random.key(seed)
    ks = jax.random.split(key, 24)
    f32 = jnp.float32
    nrm = lambda k, shape, fan_in: jax.random.normal(k, shape, f32) * (fan_in ** -0.5)
    gain = lambda k, shape: 1.0 + 0.01 * jax.random.normal(k, shape, f32)
    dt0 = jnp.exp(jax.random.uniform(ks[10], (DEPTH, SSM_HEADS), f32, np.log(1e-3), np.log(1e-1)))
    dt1 = jnp.exp(jax.random.uniform(ks[11], (DEPTH, SSM_HEADS), f32, np.log(1e-3), np.log(1e-1)))
    inv_softplus = lambda d: d + jnp.log(-jnp.expm1(-d))
    return {
        "x_prompt": jax.random.normal(ks[0], (BATCH, SEQ, D_MODEL), f32),
        "x_sample": jax.random.normal(ks[1], (DEC_BATCH, DEC_SEQ, D_MODEL), f32),
        "norm1": gain(ks[2], (DEPTH, D_MODEL)),
        "w_in": nrm(ks[3], (DEPTH, D_MODEL, D_IN), D_MODEL),
        "q_a_norm": gain(ks[4], (DEPTH, Q_LORA)),
        "kv_a_norm": gain(ks[5], (DEPTH, KV_LORA)),
        "w_q_b": nrm(ks[6], (DEPTH, Q_LORA, MLA_HEADS * (QK_NOPE + QK_ROPE)), Q_LORA),
        "w_kv_b": nrm(ks[7], (DEPTH, KV_LORA, MLA_HEADS * (QK_NOPE + V_HEAD)), KV_LORA),
        "conv_w": nrm(ks[8], (DEPTH, SSM_CONV, D_XBC), SSM_CONV),
        "conv_b": 0.01 * jax.random.normal(ks[9], (DEPTH, D_XBC), f32),
        "dt_bias_f": inv_softplus(dt0),
        "dt_bias_b": inv_softplus(dt1),
        "a_log_f": jnp.log(jax.random.uniform(ks[12], (DEPTH, SSM_HEADS), f32, 1.0, 16.0)),
        "a_log_b": jnp.log(jax.random.uniform(ks[13], (DEPTH, SSM_HEADS), f32, 1.0, 16.0)),
        "d_skip": gain(ks[14], (DEPTH, SSM_HEADS)),
        "ssm_norm": gain(ks[15], (DEPTH, D_SSM)),
        "w_out": nrm(ks[16], (DEPTH, MIX_WIDTH, D_MODEL), MIX_WIDTH),
        "norm2": gain(ks[17], (DEPTH, D_MODEL)),
        "w_gate": nrm(ks[18], (DEPTH, D_MODEL, D_FF), D_MODEL),
        "w_up": nrm(ks[19], (DEPTH, D_MODEL, D_FF), D_MODEL),
        "ffn_conv_w": nrm(ks[20], (DEPTH, FFN_CONV, D_FF), FFN_CONV),
        "ffn_conv_b": 0.01 * jax.random.normal(ks[21], (DEPTH, D_FF), f32),
        "w_down": nrm(ks[22], (DEPTH, D_FF, D_MODEL), D_FF),
        "final_norm": gain(ks[23], (D_MODEL,)),
    }


def reference(x_prompt, x_sample, norm1, w_in, q_a_norm, kv_a_norm, w_q_b, w_kv_b, conv_w, conv_b,
              dt_bias_f, dt_bias_b, a_log_f, a_log_b, d_skip, ssm_norm, w_out,
              norm2, w_gate, w_up, ffn_conv_w, ffn_conv_b, w_down, final_norm):
    y_prompt = encoder(x_prompt, norm1, w_in, q_a_norm, kv_a_norm, w_q_b, w_kv_b, conv_w, conv_b,
                       dt_bias_f, dt_bias_b, a_log_f, a_log_b, d_skip, ssm_norm, w_out,
                       norm2, w_gate, w_up, ffn_conv_w, ffn_conv_b, w_down, final_norm)
    y_sample = encoder(x_sample, norm1, w_in, q_a_norm, kv_a_norm, w_q_b, w_kv_b, conv_w, conv_b,
                       dt_bias_f, dt_bias_b, a_log_f, a_log_b, d_skip, ssm_norm, w_out,
                       norm2, w_gate, w_up, ffn_conv_w, ffn_conv_b, w_down, final_norm)
    return (y_prompt, y_sample)
```

```cpp
#include <hip/hip_runtime.h>
#include <hip/hip_cooperative_groups.h>
#include <cstdio>
#include <cstdint>
namespace cg = cooperative_groups;
namespace pg8 {
#define PG8_LAS __attribute__((address_space(3)))
typedef unsigned short bf16_t;
typedef short bf16x8 __attribute__((ext_vector_type(8)));
typedef float f32x4 __attribute__((ext_vector_type(4)));
typedef unsigned u32x4 __attribute__((ext_vector_type(4)));
constexpr int BM = 256, BK = 64, HALF = 128, HTB = HALF * BK * 2  , STAGE_BYTES = 8 * HTB, NXCD = 8, WGM = 8;
__host__ __device__ __forceinline__ int lds_byte(int r, int c) { const int st = (r >> 4) * 2 + (c >> 5), rr = r & 15, cc = c & 31, ob = rr * 64 + cc * 2; return st * 1024 + (ob ^ (((ob >> 9) & 1) << 5)); }
__host__ __device__ __forceinline__ void stage_rc(int b, int& R, int& C) { const int st = b / 1024, sb = b % 1024, swz = sb ^ (((sb >> 9) & 1) << 5); R = (st >> 1) * 16 + swz / 64; C = (st & 1) * 32 + (swz % 64) / 2; }
__host__ __device__ __forceinline__ int perm32(int rho) { const int n = rho >> 4, i = rho & 15; return 8 * (i >> 2) + 4 * n + (i & 3); }
struct Unit { int pm, pn; };
struct Gemm { const bf16_t* A; const bf16_t* Bt; int M, N, K, lda; };
struct StaticOrder {
    int nM, nN, nwg, G, c;
    __host__ __device__ void init(int M, int N, int G_, int c_) { nM = M / BM; nN = N / BM; nwg = nM * nN; G = G_; c = c_; }
    __host__ __device__ bool next(int i, Unit& u) const {
        const long L = (long)i * G + c; if (L >= nwg) return false;
        int wgid = (int)L; { const int q = nwg / NXCD, r = nwg % NXCD, xcd = wgid % NXCD, off = wgid / NXCD; wgid = (xcd < r ? xcd * (q + 1) : r * (q + 1) + (xcd - r) * q) + off; }
        const int nig = WGM * nN, gid = wgid / nig, fm = gid * WGM, gsz = (nM - fm) < WGM ? (nM - fm) : WGM;
        u.pm = fm + ((wgid % nig) % gsz); u.pn = (wgid % nig) / gsz; return true;
    }
    __device__ __forceinline__ void a_ready(const Unit&) const {}
    __device__ __forceinline__ void done(const Unit&) const {}
};
template <class Epi, class Sched, bool ALIGN_EPI = false, bool SP2 = false>
__device__ __forceinline__ void gemm_phase(PG8_LAS unsigned char* lds, const Gemm g, const Sched& S, const Epi& E) {
    int tid_ = threadIdx.x; asm volatile("" : "+v"(tid_)); const int tid = tid_, wid = __builtin_amdgcn_readfirstlane(tid >> 6), lane = tid & 63, wr = wid >> 2, wc = wid & 3, fr = lane & 15, fq = lane >> 4;
    const int K = g.K, nt = K / BK;
    unsigned voffA[2], voffB[2];
#pragma unroll
    for (int i = 0; i < 2; ++i) { int R, C; stage_rc(tid * 16 + i * 8192, R, C); const int Rb = Epi::PERM ? ((R & ~31) + perm32(R & 31)) : R;
        voffA[i] = (unsigned)(R * g.lda + C) * 2u; voffB[i] = (unsigned)(Rb * K + C) * 2u; }
    const size_t kstep = (size_t)(BK * 2);
    const size_t hstepB = (size_t)HALF * K * 2, hstepA = (size_t)HALF * g.lda * 2;
    const size_t tstepA = 2 * hstepA, tstepB = 2 * hstepB;
    const unsigned ldsw = (unsigned)wid * 1024u;
    const int aoff = lds_byte(wr * 64 + fr, fq * 8), boff = lds_byte(wc * 32 + fr, fq * 8);
#define PG8_SA(b, h) (((b) * 2 + (h)) * HTB)
#define PG8_SB(b, h) ((4 + (b) * 2 + (h)) * HTB)
#define PG8_STAGE(bufoff, gbase, voff) do { _Pragma("unroll") for (int _i = 0; _i < 2; ++_i) \
        __builtin_amdgcn_global_load_lds((const unsigned*)((const char*)(gbase) + (voff)[_i]), (PG8_LAS unsigned*)(lds + (bufoff) + ldsw + _i * 8192), 16, 0, 0); } while (0)
#define PG8_LDA(dst, b, h) do { _Pragma("unroll") for (int m = 0; m < 4; ++m) _Pragma("unroll") for (int k = 0; k < 2; ++k) dst[m][k] = *(const PG8_LAS bf16x8*)(lds + PG8_SA(b, h) + aoff + m * 2048 + k * 1024); } while (0)
#define PG8_LDB(dst, b, h) do { _Pragma("unroll") for (int n = 0; n < 2; ++n) _Pragma("unroll") for (int k = 0; k < 2; ++k) dst[n][k] = *(const PG8_LAS bf16x8*)(lds + PG8_SB(b, h) + boff + n * 2048 + k * 1024); } while (0)
#define PG8_MMA(ai, bj, At, Bt) do { __builtin_amdgcn_s_setprio(1); _Pragma("unroll") for (int m = 0; m < 4; ++m) _Pragma("unroll") for (int n = 0; n < 2; ++n) _Pragma("unroll") for (int k = 0; k < 2; ++k) \
        acc[ai][bj][m][n] = __builtin_amdgcn_mfma_f32_16x16x32_bf16(Bt[n][k], At[m][k], acc[ai][bj][m][n], 0, 0, 0); __builtin_amdgcn_s_setprio(0); } while (0)
#define PG8_WAIT_V(n) asm volatile("s_waitcnt vmcnt(" #n ")" ::: "memory")
#define PG8_WAIT_L(n) asm volatile("s_waitcnt lgkmcnt(" #n ")" ::: "memory")
#define PG8_BAR __builtin_amdgcn_s_barrier()
#define PG8_SCHED __builtin_amdgcn_sched_barrier(0)
    Unit cur, nxt; int ui = 0;
    if (!S.next(0, cur)) return;
    f32x4 acc[2][2][4][2];
#pragma unroll
    for (int a = 0; a < 2; ++a)
#pragma unroll
        for (int b = 0; b < 2; ++b)
#pragma unroll
            for (int m = 0; m < 4; ++m)
#pragma unroll
                for (int n = 0; n < 2; ++n) acc[a][b][m][n] = (f32x4){0.f, 0.f, 0.f, 0.f};
    bf16x8 At[4][2], B0[2][2], B1[2][2];
    const char* cA = (const char*)g.A + (size_t)cur.pm * tstepA; const char* cB = (const char*)g.Bt + (size_t)cur.pn * tstepB;
    S.a_ready(cur);
    if constexpr (SP2) {
        PG8_STAGE(PG8_SB(0, 0), cB, voffB); PG8_STAGE(PG8_SB(0, 1), cB + hstepB, voffB); PG8_STAGE(PG8_SA(0, 0), cA, voffA); PG8_STAGE(PG8_SA(0, 1), cA + hstepA, voffA);
        if (wr == 1) PG8_BAR;
        PG8_WAIT_V(2); PG8_BAR;
        PG8_STAGE(PG8_SB(1, 0), cB + kstep, voffB); PG8_STAGE(PG8_SA(1, 0), cA + kstep, voffA); PG8_STAGE(PG8_SB(1, 1), cB + hstepB + kstep, voffB);
        PG8_WAIT_V(6); PG8_BAR;
    } else {
        PG8_STAGE(PG8_SB(0, 0), cB, voffB); PG8_STAGE(PG8_SA(0, 0), cA, voffA); PG8_STAGE(PG8_SB(0, 1), cB + hstepB, voffB); PG8_STAGE(PG8_SA(0, 1), cA + hstepA, voffA);
        if (wr == 1) PG8_BAR;
        PG8_WAIT_V(4); PG8_BAR;
        PG8_STAGE(PG8_SB(1, 0), cB + kstep, voffB); PG8_STAGE(PG8_SA(1, 0), cA + kstep, voffA); PG8_STAGE(PG8_SB(1, 1), cB + hstepB + kstep, voffB);
        PG8_WAIT_V(6); PG8_BAR;
    }
    for (;;) {
        const bool has_next = S.next(ui + 1, nxt);
        const char* nA = has_next ? (const char*)g.A + (size_t)nxt.pm * tstepA : cA; const char* nB = has_next ? (const char*)g.Bt + (size_t)nxt.pn * tstepB : cB;
        for (int t = 0; t < nt; t += 2) {
            const bool last = (t == nt - 2);
            const char* a1 = cA + (size_t)(t + 1) * kstep;
            const char* a2 = last ? nA : cA + (size_t)(t + 2) * kstep; const char* b2 = last ? nB : cB + (size_t)(t + 2) * kstep;
            const char* a3 = a2 + kstep; const char* b3 = b2 + kstep;
            if (last && has_next) S.a_ready(nxt);
            if constexpr (SP2) {
            PG8_LDB(B0, 0, 0); PG8_LDB(B1, 0, 1); PG8_SCHED; PG8_LDA(At, 0, 0); PG8_STAGE(PG8_SA(1, 1), a1 + hstepA, voffA);
            PG8_WAIT_V(8); PG8_WAIT_L(0); PG8_BAR; PG8_MMA(0, 0, At, B0); PG8_MMA(0, 1, At, B1); PG8_BAR; PG8_SCHED;
            PG8_LDA(At, 0, 1); PG8_STAGE(PG8_SB(0, 0), b2, voffB); PG8_STAGE(PG8_SB(0, 1), b2 + hstepB, voffB); PG8_STAGE(PG8_SA(0, 0), a2, voffA);
            PG8_WAIT_V(8); PG8_WAIT_L(0); PG8_BAR; PG8_MMA(1, 0, At, B0); PG8_MMA(1, 1, At, B1); PG8_BAR; PG8_SCHED;
            PG8_LDB(B0, 1, 0); PG8_LDB(B1, 1, 1); PG8_SCHED; PG8_LDA(At, 1, 0); PG8_STAGE(PG8_SA(0, 1), a2 + hstepA, voffA);
            PG8_WAIT_V(8); PG8_WAIT_L(0); PG8_BAR; PG8_MMA(0, 0, At, B0); PG8_MMA(0, 1, At, B1); PG8_BAR; PG8_SCHED;
            PG8_LDA(At, 1, 1); PG8_STAGE(PG8_SB(1, 0), b3, voffB); PG8_STAGE(PG8_SB(1, 1), b3 + hstepB, voffB); PG8_STAGE(PG8_SA(1, 0), a3, voffA);
            PG8_WAIT_V(8); PG8_WAIT_L(0); PG8_BAR; PG8_MMA(1, 0, At, B0); PG8_MMA(1, 1, At, B1); PG8_BAR; PG8_SCHED;
            } else {
            PG8_LDB(B0, 0, 0); PG8_SCHED; PG8_LDA(At, 0, 0); PG8_STAGE(PG8_SA(1, 1), a1 + hstepA, voffA);
            PG8_WAIT_L(8); PG8_BAR; PG8_WAIT_L(0); PG8_MMA(0, 0, At, B0); PG8_BAR; PG8_SCHED;
            PG8_LDB(B1, 0, 1); PG8_STAGE(PG8_SB(0, 0), b2, voffB);
            PG8_BAR; PG8_WAIT_L(0); PG8_MMA(0, 1, At, B1); PG8_BAR;
            PG8_LDA(At, 0, 1); PG8_STAGE(PG8_SA(0, 0), a2, voffA);
            PG8_BAR; PG8_WAIT_L(0); PG8_MMA(1, 0, At, B0); PG8_BAR; PG8_SCHED;
            PG8_STAGE(PG8_SB(0, 1), b2 + hstepB, voffB);
            PG8_WAIT_V(6); PG8_BAR; PG8_MMA(1, 1, At, B1); PG8_BAR;
            PG8_LDB(B0, 1, 0); PG8_SCHED; PG8_LDA(At, 1, 0); PG8_STAGE(PG8_SA(0, 1), a2 + hstepA, voffA);
            PG8_WAIT_L(8); PG8_BAR; PG8_WAIT_L(0); PG8_MMA(0, 0, At, B0); PG8_BAR; PG8_SCHED;
            PG8_LDB(B1, 1, 1); PG8_STAGE(PG8_SB(1, 0), b3, voffB);
            PG8_BAR; PG8_WAIT_L(0); PG8_MMA(0, 1, At, B1); PG8_BAR;
            PG8_LDA(At, 1, 1); PG8_STAGE(PG8_SA(1, 0), a3, voffA);
            PG8_BAR; PG8_WAIT_L(0); PG8_MMA(1, 0, At, B0); PG8_BAR; PG8_SCHED;
            PG8_STAGE(PG8_SB(1, 1), b3 + hstepB, voffB);
            PG8_WAIT_V(6); PG8_BAR; PG8_MMA(1, 1, At, B1); PG8_BAR;
            }
        }
        if constexpr (ALIGN_EPI) { if (wr == 0) PG8_BAR; }
        if constexpr (!Epi::AFTER_DRAIN) { E(acc, cur, wr, wc, fr, fq); S.done(cur); }
        if (!has_next) break;
#pragma unroll
        for (int a = 0; a < 2; ++a)
#pragma unroll
            for (int b = 0; b < 2; ++b)
#pragma unroll
                for (int m = 0; m < 4; ++m)
#pragma unroll
                    for (int n = 0; n < 2; ++n) acc[a][b][m][n] = (f32x4){0.f, 0.f, 0.f, 0.f};
        cur = nxt; cA = nA; cB = nB; ++ui;
        if constexpr (ALIGN_EPI) { if (wr == 1) PG8_BAR; }
    }
    PG8_WAIT_V(0);
    if constexpr (!ALIGN_EPI) { if (wr == 0) PG8_BAR; }
    PG8_BAR;
    if constexpr (Epi::AFTER_DRAIN) { E.fused(acc, cur, wr, wc, fr, fq, lds, wid, lane); S.done(cur); }
#undef PG8_SA
#undef PG8_SB
#undef PG8_STAGE
#undef PG8_LDA
#undef PG8_LDB
#undef PG8_MMA
#undef PG8_WAIT_V
#undef PG8_WAIT_L
#undef PG8_BAR
#undef PG8_SCHED
}
}

#define DI __device__ __forceinline__
#define LAS __attribute__((address_space(3)))
typedef unsigned short bf16_t;
typedef unsigned char uchar;
typedef short bf16x8 __attribute__((ext_vector_type(8)));
typedef short s16x4 __attribute__((ext_vector_type(4)));
typedef float f32x4 __attribute__((ext_vector_type(4)));
typedef float f32x16 __attribute__((ext_vector_type(16)));
typedef unsigned u32x4 __attribute__((ext_vector_type(4)));
typedef unsigned u32x2 __attribute__((ext_vector_type(2)));
typedef float f32x2_t __attribute__((ext_vector_type(2)));
typedef __bf16 bf16x2_t __attribute__((ext_vector_type(2)));

constexpr int T = 81920, TP = 65536, DM = 1024;
constexpr int LP = 2048, LS = 16384;
constexpr int DIN = 3008, DINP = 3072;
constexpr int NQ = 1536, NKV = 2048, NLAT = 768, NXBC = 1280;
constexpr int DFF = 2816, NGU = 5632;
constexpr float EPS = 1e-6f;
constexpr float QSCALE = 0.10206207261596575f * 1.4426950408889634f;
constexpr int CH0_ROWS = 49152, CH1_ROWS = 32768;

constexpr size_t MiB = 1u << 20;
constexpr size_t WS_WIN = 0, WS_WQB = 6 * MiB, WS_WKVB = 8 * MiB, WS_WOUT = 9 * MiB, WS_WGU = 13 * MiB, WS_WDN = 24 * MiB;
constexpr size_t WS_TAB = 30 * MiB;
constexpr size_t WS_H = 32 * MiB;
constexpr size_t WS_XBC = 192 * MiB;
constexpr size_t WS_MIX = 32 * MiB;
constexpr size_t WS_Z = 392 * MiB;
constexpr size_t WS_LAT = 552 * MiB;
constexpr size_t WS_DT = 672 * MiB;
constexpr size_t WS_XBC2 = 682 * MiB;
constexpr size_t WS_KV = 682 * MiB;
constexpr size_t WS_X1B = 352 * MiB;
constexpr size_t WS_SS = 1004 * MiB;
constexpr size_t WS_G = 32 * MiB;
constexpr size_t WS_U = 512 * MiB;
static_assert(WS_XBC2 + (size_t)T * NXBC * 2 <= WS_SS && WS_KV + (size_t)T * NKV * 2 <= WS_SS, "ws map");
static_assert(WS_G + (size_t)CH0_ROWS * DFF * 2 <= WS_X1B && WS_X1B + (size_t)T * DM * 2 <= WS_U && WS_U + (size_t)CH0_ROWS * DFF * 2 <= WS_SS, "ws map 2");
static_assert(WS_MIX + (size_t)T * 2048 * 2 <= WS_X1B, "ws map 3");

struct Params {
    const float *xp, *xs, *norm1, *w_in, *q_a_norm, *kv_a_norm, *w_q_b, *w_kv_b, *conv_w, *conv_b, *dt_bias_f, *dt_bias_b, *a_log_f, *a_log_b,
        *d_skip, *ssm_norm, *w_out, *norm2, *w_gate, *w_up, *ffn_conv_w, *ffn_conv_b, *w_down, *final_norm;
    float* out; uchar* ws;
};

DI float bf2f(bf16_t v) { return __uint_as_float((unsigned)v << 16); }
DI unsigned pk2(float lo, float hi) { f32x2_t v = {lo, hi}; bf16x2_t b = __builtin_convertvector(v, bf16x2_t); return __builtin_bit_cast(unsigned, b); }
DI void unpack8(const u32x4 w, float (&f)[8]) {
#pragma unroll
    for (int i = 0; i < 4; ++i) { f[2 * i] = __uint_as_float(w[i] << 16); f[2 * i + 1] = __uint_as_float(w[i] & 0xffff0000u); }
}
DI u32x4 pack8(const float (&f)[8]) { u32x4 w; w.x = pk2(f[0], f[1]); w.y = pk2(f[2], f[3]); w.z = pk2(f[4], f[5]); w.w = pk2(f[6], f[7]); return w; }
DI float wave_sum(float v) {
#pragma unroll
    for (int o = 1; o < 64; o <<= 1) v += __shfl_xor(v, o);
    return v;
}
DI const float* xrow(const Params& P, int row) { return row < TP ? P.xp + (size_t)row * DM : P.xs + (size_t)(row - TP) * DM; }
DI int posof(int row) { return row < TP ? (row & (LP - 1)) : row - TP; }
DI int lenof(int row) { return row < TP ? LP : LS; }
DI float silu(float v) { return v / (1.f + __expf(-v)); }

#define EPI_LOOP_BEGIN \
    _Pragma("unroll") for (int ai = 0; ai < 2; ++ai) _Pragma("unroll") for (int m = 0; m < 4; ++m) { const int row = u.pm * 256 + ai * 128 + wr * 64 + m * 16 + fr; \
    _Pragma("unroll") for (int bj = 0; bj < 2; ++bj) { const f32x4 v0 = acc[ai][bj][m][0], v1 = acc[ai][bj][m][1];
#define EPI_LOOP_END } }

struct EpiIn {
    static constexpr bool PERM = true, AFTER_DRAIN = false;
    bf16_t *z, *xbc, *lat; float* dt;
    DI void operator()(const f32x4 (&acc)[2][2][4][2], const pg8::Unit& u, int wr, int wc, int fr, int fq) const {
        bf16_t* base; int ld, colt;
        if (u.pn < 4) { base = z; ld = DM; colt = u.pn * 256; } else if (u.pn < 9) { base = xbc; ld = NXBC; colt = (u.pn - 4) * 256; } else { base = lat; ld = NLAT; colt = (u.pn - 9) * 256; }
        const int col0 = colt + wc * 32 + 8 * fq;
        EPI_LOOP_BEGIN
            u32x4 w; w.x = pk2(v0[0], v0[1]); w.y = pk2(v0[2], v0[3]); w.z = pk2(v1[0], v1[1]); w.w = pk2(v1[2], v1[3]);
            *(u32x4*)(base + (size_t)row * ld + col0 + bj * 128) = w;
            if (u.pn == 11 && bj == 1 && wc == 1) { float* d = dt + (size_t)row * 32 + 8 * fq; *(f32x4*)d = v0; *(f32x4*)(d + 4) = v1; }
        EPI_LOOP_END
    }
};
struct EpiPlain {
    static constexpr bool PERM = true, AFTER_DRAIN = false;
    bf16_t* o; int ld; float sc;
    DI void operator()(const f32x4 (&acc)[2][2][4][2], const pg8::Unit& u, int wr, int wc, int fr, int fq) const {
        const int col0 = u.pn * 256 + wc * 32 + 8 * fq;
        EPI_LOOP_BEGIN
            u32x4 w; w.x = pk2(v0[0] * sc, v0[1] * sc); w.y = pk2(v0[2] * sc, v0[3] * sc); w.z = pk2(v1[0] * sc, v1[1] * sc); w.w = pk2(v1[2] * sc, v1[3] * sc);
            *(u32x4*)(o + (size_t)row * ld + col0 + bj * 128) = w;
        EPI_LOOP_END
    }
};
struct EpiRes {
    static constexpr bool PERM = true, AFTER_DRAIN = false;
    const float* resp; const float* ress; float* xo; bf16_t* xb; float* ss; int row_off;
    DI void operator()(const f32x4 (&acc)[2][2][4][2], const pg8::Unit& u, int wr, int wc, int fr, int fq) const {
        const int col0 = u.pn * 256 + wc * 32 + 8 * fq;
#pragma unroll
        for (int ai = 0; ai < 2; ++ai)
#pragma unroll
            for (int m = 0; m < 4; ++m) {
                const int row = row_off + u.pm * 256 + ai * 128 + wr * 64 + m * 16 + fr;
                const float* rp = (row < TP ? resp + (size_t)row * DM : ress + (size_t)(row - TP) * DM) + col0;
                float s = 0.f;
#pragma unroll
                for (int bj = 0; bj < 2; ++bj) {
                    const f32x4 r0 = *(const f32x4*)(rp + bj * 128), r1 = *(const f32x4*)(rp + bj * 128 + 4);
                    const f32x4 a = acc[ai][bj][m][0] + r0, b = acc[ai][bj][m][1] + r1;
                    float* op = xo + (size_t)row * DM + col0 + bj * 128;
                    *(f32x4*)op = a; *(f32x4*)(op + 4) = b;
                    if (xb) { u32x4 w; w.x = pk2(a[0], a[1]); w.y = pk2(a[2], a[3]); w.z = pk2(b[0], b[1]); w.w = pk2(b[2], b[3]); *(u32x4*)(xb + (size_t)row * DM + col0 + bj * 128) = w; }
                    s += (a[0] * a[0] + a[1] * a[1]) + (a[2] * a[2] + a[3] * a[3]) + (b[0] * b[0] + b[1] * b[1]) + (b[2] * b[2] + b[3] * b[3]);
                }
                s += __shfl_xor(s, 16); s += __shfl_xor(s, 32);
                if (fq == 0) atomicAdd(ss + row, s);
            }
    }
};
struct EpiGU {
    static constexpr bool PERM = true, AFTER_DRAIN = false;
    bf16_t *g, *uo; const float* ss; int row_off;
    DI void operator()(const f32x4 (&acc)[2][2][4][2], const pg8::Unit& u, int wr, int wc, int fr, int fq) const {
        const int col0 = u.pn * 128 + wc * 32 + 8 * fq;
#pragma unroll
        for (int ai = 0; ai < 2; ++ai)
#pragma unroll
            for (int m = 0; m < 4; ++m) {
                const int lrow = u.pm * 256 + ai * 128 + wr * 64 + m * 16 + fr;
                const float rs = rsqrtf(ss[row_off + lrow] * (1.f / DM) + EPS);
#pragma unroll
                for (int bj = 0; bj < 2; ++bj) {
                    const f32x4 a = acc[ai][bj][m][0] * rs, b = acc[ai][bj][m][1] * rs;
                    u32x4 w; w.x = pk2(a[0], a[1]); w.y = pk2(a[2], a[3]); w.z = pk2(b[0], b[1]); w.w = pk2(b[2], b[3]);
                    *(u32x4*)((bj == 0 ? g : uo) + (size_t)lrow * DFF + col0) = w;
                }
            }
    }
};

template <class F> DI void transpose_item(const float* W, int K, int N, bf16_t* WT, LAS float* scr, int item, int lane, F destrow, const float* kscale) {
    const int nblk = N / 32, kb = item / nblk, nb = item % nblk, k0 = 64 * kb, n0 = 32 * nb;
#pragma unroll 8
    for (int i = 0; i < 32; ++i) { const int kk = 2 * i + (lane >> 5); float w = W[(size_t)(k0 + kk) * N + n0 + (lane & 31)]; if (kscale) w *= kscale[k0 + kk]; scr[kk * 33 + (lane & 31)] = w; }
    asm volatile("s_waitcnt lgkmcnt(0)" ::: "memory");
    const int c = lane & 7;
#pragma unroll
    for (int j = 0; j < 4; ++j) { const int n = (lane >> 3) + 8 * j; const LAS float* s = scr + (8 * c) * 33 + n;
        u32x4 o; o.x = pk2(s[0 * 33], s[1 * 33]); o.y = pk2(s[2 * 33], s[3 * 33]); o.z = pk2(s[4 * 33], s[5 * 33]); o.w = pk2(s[6 * 33], s[7 * 33]);
        *(u32x4*)(WT + (size_t)destrow(n0 + n) * K + k0 + 8 * c) = o; }
    asm volatile("s_waitcnt lgkmcnt(0)" ::: "memory");
}
struct DestIn { DI int operator()(int c) const { return c < 672 ? 2304 + c : (c < 1696 ? c - 672 : (c < 2976 ? 1024 + (c - 1696) : 2304 + 672 + (c - 2976))); } };
struct DestQb { DI int operator()(int c) const { const int h = c / 96, j = c % 96; if (j < 64) return h * 64 + j; const int i = j - 64; return 1024 + h * 32 + (i < 16 ? 2 * i : 2 * (i - 16) + 1); } };
struct DestKvb { DI int operator()(int c) const { const int h = c >> 7, j = c & 127; return j < 64 ? h * 64 + j : 1024 + h * 64 + (j - 64); } };
struct DestId { DI int operator()(int c) const { return c; } };
struct DestGate { DI int operator()(int c) const { return 256 * (c >> 7) + (c & 127); } };
struct DestUp { DI int operator()(int c) const { return 256 * (c >> 7) + 128 + (c & 127); } };

DI void p0_prologue(const Params& P, LAS uchar* lds) {
    const int tid = threadIdx.x, lane = tid & 63, wave = tid >> 6, G = gridDim.x;
    const int gw = blockIdx.x * 8 + wave, NGW = G * 8;
    const int gt = blockIdx.x * 512 + tid, NGT = G * 512;
    LAS float* scr = (LAS float*)(lds + wave * 16384);
    bf16_t* Win = (bf16_t*)(P.ws + WS_WIN); bf16_t* Wqb = (bf16_t*)(P.ws + WS_WQB); bf16_t* Wkvb = (bf16_t*)(P.ws + WS_WKVB);
    bf16_t* Wout = (bf16_t*)(P.ws + WS_WOUT); bf16_t* Wgu = (bf16_t*)(P.ws + WS_WGU); bf16_t* Wdn = (bf16_t*)(P.ws + WS_WDN);
    constexpr int I_IN = 16 * 94, I_QB = 6 * 48, I_KVB = 4 * 64, I_OUT = 32 * 32, I_G = 16 * 88, I_DN = 44 * 32;
    constexpr int NITEMS = I_IN + I_QB + I_KVB + I_OUT + 2 * I_G + I_DN;
    for (int it = gw; it < NITEMS; it += NGW) {
        int r = it;
        if (r < I_IN) { transpose_item(P.w_in, 1024, DIN, Win, scr, r, lane, DestIn(), nullptr); continue; } r -= I_IN;
        if (r < I_QB) { transpose_item(P.w_q_b, 384, NQ, Wqb, scr, r, lane, DestQb(), nullptr); continue; } r -= I_QB;
        if (r < I_KVB) { transpose_item(P.w_kv_b, 256, NKV, Wkvb, scr, r, lane, DestKvb(), nullptr); continue; } r -= I_KVB;
        if (r < I_OUT) { transpose_item(P.w_out, 2048, DM, Wout, scr, r, lane, DestId(), nullptr); continue; } r -= I_OUT;
        if (r < I_G) { transpose_item(P.w_gate, 1024, DFF, Wgu, scr, r, lane, DestGate(), P.norm2); continue; } r -= I_G;
        if (r < I_G) { transpose_item(P.w_up, 1024, DFF, Wgu, scr, r, lane, DestUp(), P.norm2); continue; } r -= I_G;
        transpose_item(P.w_down, DFF, DM, Wdn, scr, r, lane, DestId(), nullptr);
    }
    for (int i = gt; i < 64 * 1024 / 8; i += NGT) *(u32x4*)(Win + (size_t)3008 * 1024 + (size_t)i * 8) = (u32x4){0u, 0u, 0u, 0u};
    float* tab = (float*)(P.ws + WS_TAB);
    for (int i = gt; i < LS * 16; i += NGT) { const int pos = i >> 4, k = i & 15; const float inv = powf(10000.0f, -(float)(2 * k) / 32.0f); const float ang = (float)pos * inv; float s, c; sincosf(ang, &s, &c); tab[2 * i] = c; tab[2 * i + 1] = s; }
    float* ss = (float*)(P.ws + WS_SS);
    for (int i = gt; i < 2 * T; i += NGT) ss[i] = 0.f;
    bf16_t* hb = (bf16_t*)(P.ws + WS_H);
    for (int row = gw; row < T; row += NGW) {
        const f32x4* xr = (const f32x4*)xrow(P, row) + lane;
        f32x4 v[4]; float s = 0.f;
#pragma unroll
        for (int j = 0; j < 4; ++j) { v[j] = xr[64 * j]; s += (v[j][0] * v[j][0] + v[j][1] * v[j][1]) + (v[j][2] * v[j][2] + v[j][3] * v[j][3]); }
        const float rs = rsqrtf(wave_sum(s) * (1.f / DM) + EPS);
        u32x2* o = (u32x2*)(hb + (size_t)row * DM) + lane;
#pragma unroll
        for (int j = 0; j < 4; ++j) { const f32x4 w = ((const f32x4*)P.norm1)[lane + 64 * j]; u32x2 pk; pk.x = pk2(v[j][0] * rs * w[0], v[j][1] * rs * w[1]); pk.y = pk2(v[j][2] * rs * w[2], v[j][3] * rs * w[3]); o[64 * j] = pk; }
    }
}

DI void p2_prep(const Params& P) {
    const int tid = threadIdx.x, lane = tid & 63, wave = tid >> 6, G = gridDim.x;
    const int gw = blockIdx.x * 8 + wave, NGW = G * 8;
    const int gt = blockIdx.x * 512 + tid, NGT = G * 512;
    bf16_t* lat = (bf16_t*)(P.ws + WS_LAT); float* dt = (float*)(P.ws + WS_DT); const float* tab = (const float*)(P.ws + WS_TAB);
    for (int row = gw; row < T; row += NGW) {
        bf16_t* lr = lat + (size_t)row * NLAT;
        float qv[8], kv[8];
#pragma unroll
        for (int j = 0; j < 8; ++j) { qv[j] = 0.f; kv[j] = 0.f; }
        if (lane < 48) unpack8(*(const u32x4*)(lr + lane * 8), qv);
        if (lane < 32) unpack8(*(const u32x4*)(lr + 384 + lane * 8), kv);
        float sq = 0.f, sk = 0.f;
#pragma unroll
        for (int j = 0; j < 8; ++j) { sq += qv[j] * qv[j]; sk += kv[j] * kv[j]; }
        sq = wave_sum(sq); sk = wave_sum(sk);
        const float rq = rsqrtf(sq * (1.f / 384.f) + EPS), rk = rsqrtf(sk * (1.f / 256.f) + EPS);
        float x1 = 0.f, x2 = 0.f, dtv = 0.f;
        if (lane < 16) { x1 = bf2f(lr[640 + lane]); x2 = bf2f(lr[656 + lane]); }
        if (lane < 32) dtv = dt[(size_t)row * 32 + lane];
        asm volatile("s_waitcnt vmcnt(0)" ::: "memory");
        if (lane < 48) { float o[8];
#pragma unroll
            for (int j = 0; j < 8; ++j) o[j] = qv[j] * rq * P.q_a_norm[lane * 8 + j];
            *(u32x4*)(lr + lane * 8) = pack8(o); }
        if (lane < 32) { float o[8];
#pragma unroll
            for (int j = 0; j < 8; ++j) o[j] = kv[j] * rk * P.kv_a_norm[lane * 8 + j];
            *(u32x4*)(lr + 384 + lane * 8) = pack8(o); }
        if (lane < 16) { const float c = tab[((size_t)posof(row) * 16 + lane) * 2], s = tab[((size_t)posof(row) * 16 + lane) * 2 + 1];
            *(unsigned*)(lr + 640 + 2 * lane) = pk2(x1 * c - x2 * s, x2 * c + x1 * s); }
        if (lane < 32) { const float b = lane < 16 ? P.dt_bias_f[lane] : P.dt_bias_b[lane - 16]; const float v = dtv + b;
            dt[(size_t)row * 32 + lane] = fmaxf(v, 0.f) + log1pf(__expf(-fabsf(v))); }
    }
    const bf16_t* xbc = (const bf16_t*)(P.ws + WS_XBC); bf16_t* xbc2 = (bf16_t*)(P.ws + WS_XBC2);
    for (int idx = gt; idx < T * 160; idx += NGT) {
        const int row = idx / 160, c0 = (idx - row * 160) * 8; const int pos = posof(row), L = lenof(row);
        float cur[8], prv[8], nxt[8];
        unpack8(*(const u32x4*)(xbc + (size_t)row * NXBC + c0), cur);
        if (pos > 0) unpack8(*(const u32x4*)(xbc + (size_t)(row - 1) * NXBC + c0), prv); else {
#pragma unroll
            for (int j = 0; j < 8; ++j) prv[j] = 0.f; }
        if (pos < L - 1) unpack8(*(const u32x4*)(xbc + (size_t)(row + 1) * NXBC + c0), nxt); else {
#pragma unroll
            for (int j = 0; j < 8; ++j) nxt[j] = 0.f; }
        float o[8];
#pragma unroll
        for (int j = 0; j < 8; ++j) { const float v = P.conv_w[c0 + j] * prv[j] + P.conv_w[NXBC + c0 + j] * cur[j] + P.conv_w[2 * NXBC + c0 + j] * nxt[j] + P.conv_b[c0 + j]; o[j] = silu(v); }
        *(u32x4*)(xbc2 + (size_t)row * NXBC + c0) = pack8(o);
    }
}

DI void p3_ssd_naive(const Params& P, LAS uchar* lds) {
    const int tid = threadIdx.x, lane = tid & 63, wave = tid >> 6;
    LAS float* BC = (LAS float*)lds;
    const bf16_t* xbc2 = (const bf16_t*)(P.ws + WS_XBC2); const float* dtb = (const float*)(P.ws + WS_DT); const bf16_t* zb = (const bf16_t*)(P.ws + WS_Z);
    float* ysc = P.out;
    bf16_t* mix = (bf16_t*)(P.ws + WS_MIX);
    for (int item = blockIdx.x; item < 66; item += gridDim.x) {
        const int seq = item >> 1, g = item & 1; const int rowbase = seq < 32 ? seq * LP : TP; const int L = seq < 32 ? LP : LS;
        const int head = g * 8 + wave, p = lane;
        const float Af = -__expf(P.a_log_f[head]), Ab = -__expf(P.a_log_b[head]), Dk = P.d_skip[head];
        float hs[64];
#pragma unroll
        for (int dir = 0; dir < 2; ++dir) {
#pragma unroll
            for (int n = 0; n < 64; ++n) hs[n] = 0.f;
            for (int tb = 0; tb < L; tb += 64) {
                const int t0 = dir == 0 ? tb : L - 64 - tb;
                __syncthreads();
                for (int k = tid; k < 8192; k += 512) { const int tt = k >> 7, c = k & 127; BC[k] = bf2f(xbc2[(size_t)(rowbase + t0 + tt) * NXBC + 1024 + (c >> 6) * 128 + g * 64 + (c & 63)]); }
                __syncthreads();
                for (int ti = 0; ti < 64; ++ti) {
                    const int tt = dir == 0 ? ti : 63 - ti; const int row = rowbase + t0 + tt;
                    const float dtv = dtb[(size_t)row * 32 + dir * 16 + head]; const float x = bf2f(xbc2[(size_t)row * NXBC + head * 64 + p]);
                    const float a = __expf((dir == 0 ? Af : Ab) * dtv), uu = dtv * x; float y = 0.f;
                    const LAS f32x4* Bp = (const LAS f32x4*)(BC + tt * 128); const LAS f32x4* Cp = Bp + 16;
#pragma unroll
                    for (int n4 = 0; n4 < 16; ++n4) { const f32x4 b = Bp[n4], c = Cp[n4];
#pragma unroll
                        for (int e = 0; e < 4; ++e) { hs[4 * n4 + e] = a * hs[4 * n4 + e] + uu * b[e]; y += c[e] * hs[4 * n4 + e]; } }
                    float* yp = ysc + (size_t)row * DM + head * 64 + p;
                    if (dir == 0) *yp = y; else *yp = *yp + y + Dk * x;
                }
            }
        }
        __threadfence_block(); __syncthreads();
        for (int t = wave; t < L; t += 8) {
            const int row = rowbase + t; const int c = g * 512 + lane * 8;
            const f32x4 y0 = *(const f32x4*)(ysc + (size_t)row * DM + c), y1 = *(const f32x4*)(ysc + (size_t)row * DM + c + 4);
            float zf[8]; unpack8(*(const u32x4*)(zb + (size_t)row * DM + c), zf);
            float v[8]; float s = 0.f;
#pragma unroll
            for (int j = 0; j < 8; ++j) { const float yy = j < 4 ? y0[j] : y1[j - 4]; v[j] = yy * silu(zf[j]); s += v[j] * v[j]; }
            const float rs = rsqrtf(wave_sum(s) * (1.f / 512.f) + EPS);
#pragma unroll
            for (int j = 0; j < 8; ++j) v[j] = v[j] * rs * P.ssm_norm[c + j];
            *(u32x4*)(mix + (size_t)row * 2048 + 1024 + c) = pack8(v);
        }
        __syncthreads();
    }
}

constexpr int KROW = 208, VROW = 192, KTILE = 64 * KROW, VTILE = 64 * VROW;
DI void attn_unit(const Params& P, LAS uchar* lds, int rowbase, int L, int h, int qb) {
    const int tid = threadIdx.x, lane = tid & 63, wid = tid >> 6, r32 = lane & 31, hi = lane >> 5;
    const bf16_t* qbuf = (const bf16_t*)P.out; const bf16_t* kvb = (const bf16_t*)(P.ws + WS_KV); const bf16_t* lat = (const bf16_t*)(P.ws + WS_LAT);
    bf16_t* mix = (bf16_t*)(P.ws + WS_MIX);
    const int qrow = rowbase + qb * 256 + wid * 32 + r32;
    bf16x8 qf[6];
    { const bf16_t* Qg = qbuf + (size_t)qrow * NQ;
#pragma unroll
      for (int ks = 0; ks < 4; ++ks) qf[ks] = *(const bf16x8*)(Qg + h * 64 + ks * 16 + hi * 8);
#pragma unroll
      for (int ks = 0; ks < 2; ++ks) { float f[8], o[8]; unpack8(*(const u32x4*)(Qg + 1024 + h * 32 + ks * 16 + hi * 8), f);
          const float* tp = (const float*)(P.ws + WS_TAB) + ((size_t)(qrow - rowbase) * 16 + 8 * ks + 4 * hi) * 2;
          const f32x4 c0 = *(const f32x4*)tp, c1 = *(const f32x4*)(tp + 4);
          o[0] = f[0] * c0[0] - f[1] * c0[1]; o[1] = f[1] * c0[0] + f[0] * c0[1]; o[2] = f[2] * c0[2] - f[3] * c0[3]; o[3] = f[3] * c0[2] + f[2] * c0[3];
          o[4] = f[4] * c1[0] - f[5] * c1[1]; o[5] = f[5] * c1[0] + f[4] * c1[1]; o[6] = f[6] * c1[2] - f[7] * c1[3]; o[7] = f[7] * c1[2] + f[6] * c1[3];
          qf[4 + ks] = __builtin_bit_cast(bf16x8, pack8(o)); } }
    LAS uchar* Kb0 = lds; LAS uchar* Vb0 = lds + 2 * KTILE;
    const int skey = tid >> 3, sch = tid & 7, rkey = (tid >> 2) & 63, rch = tid & 3;
    const bf16_t* kn_src = kvb + (size_t)(rowbase + skey) * NKV + h * 64 + sch * 8;
    const bf16_t* v_src = kn_src + 1024;
    const bf16_t* kr_src = lat + (size_t)(rowbase + rkey) * NLAT + 640 + rch * 8;
    u32x4 rkn, rv, rkr;
    rkn = *(const u32x4*)kn_src; rv = *(const u32x4*)v_src; if (tid < 256) rkr = *(const u32x4*)kr_src;
    *(LAS u32x4*)(Kb0 + skey * KROW + sch * 16) = rkn; *(LAS u32x4*)(Vb0 + skey * VROW + sch * 16) = rv; if (tid < 256) *(LAS u32x4*)(Kb0 + rkey * KROW + 128 + rch * 16) = rkr;
    __syncthreads();
    float mrun = -1e30f, lrun = 0.f; f32x16 o0, o1;
#pragma unroll
    for (int r = 0; r < 16; ++r) { o0[r] = 0.f; o1[r] = 0.f; }
    const int NT = L / 64;
    const int i16 = lane & 15, qq = i16 >> 2, pp = i16 & 3, blk = (lane >> 4) & 1;
    const int vtr_off = (4 * hi + qq) * VROW + (16 * blk + 4 * pp) * 2;
    for (int kt = 0; kt < NT; ++kt) {
        const int cur = kt & 1;
        if (kt + 1 < NT) { const size_t adv = (size_t)(kt + 1) * 64; rkn = *(const u32x4*)(kn_src + adv * NKV); rv = *(const u32x4*)(v_src + adv * NKV); if (tid < 256) rkr = *(const u32x4*)(kr_src + adv * NLAT); }
        const LAS uchar* Kb = Kb0 + cur * KTILE; const LAS uchar* Vb = Vb0 + cur * VTILE;
        f32x16 p0, p1;
#pragma unroll
        for (int r = 0; r < 16; ++r) { p0[r] = 0.f; p1[r] = 0.f; }
#pragma unroll
        for (int ks = 0; ks < 6; ++ks) {
            const bf16x8 k0 = *(const LAS bf16x8*)(Kb + r32 * KROW + ks * 32 + hi * 16);
            const bf16x8 k1 = *(const LAS bf16x8*)(Kb + (32 + r32) * KROW + ks * 32 + hi * 16);
            p0 = __builtin_amdgcn_mfma_f32_32x32x16_bf16(k0, qf[ks], p0, 0, 0, 0);
            p1 = __builtin_amdgcn_mfma_f32_32x32x16_bf16(k1, qf[ks], p1, 0, 0, 0);
        }
        float mx = fmaxf(p0[0], p1[0]);
#pragma unroll
        for (int r = 1; r < 16; ++r) mx = fmaxf(mx, fmaxf(p0[r], p1[r]));
        mx = fmaxf(mx, __shfl_xor(mx, 32));
        const float mnew = fmaxf(mrun, mx);
        if (__any(mnew > mrun)) { const float al = __builtin_amdgcn_exp2f(mrun - mnew); lrun *= al;
#pragma unroll
            for (int r = 0; r < 16; ++r) { o0[r] *= al; o1[r] *= al; } }
        mrun = mnew;
        float ls = 0.f;
#pragma unroll
        for (int r = 0; r < 16; ++r) { p0[r] = __builtin_amdgcn_exp2f(p0[r] - mnew); p1[r] = __builtin_amdgcn_exp2f(p1[r] - mnew); ls += p0[r] + p1[r]; }
        lrun += ls;
#pragma unroll
        for (int s = 0; s < 4; ++s) {
            u32x4 pw;
            if (s == 0) { pw.x = pk2(p0[0], p0[1]); pw.y = pk2(p0[2], p0[3]); pw.z = pk2(p0[4], p0[5]); pw.w = pk2(p0[6], p0[7]); }
            else if (s == 1) { pw.x = pk2(p0[8], p0[9]); pw.y = pk2(p0[10], p0[11]); pw.z = pk2(p0[12], p0[13]); pw.w = pk2(p0[14], p0[15]); }
            else if (s == 2) { pw.x = pk2(p1[0], p1[1]); pw.y = pk2(p1[2], p1[3]); pw.z = pk2(p1[4], p1[5]); pw.w = pk2(p1[6], p1[7]); }
            else { pw.x = pk2(p1[8], p1[9]); pw.y = pk2(p1[10], p1[11]); pw.z = pk2(p1[12], p1[13]); pw.w = pk2(p1[14], p1[15]); }
            const bf16x8 pb = __builtin_bit_cast(bf16x8, pw);
#pragma unroll
            for (int db = 0; db < 2; ++db) {
                const LAS uchar* vp = Vb + vtr_off + s * 16 * VROW + db * 64;
                const s16x4 lo = __builtin_bit_cast(s16x4, __builtin_amdgcn_ds_read_tr16_b64_v4i16((LAS s16x4*)vp));
                const s16x4 hh = __builtin_bit_cast(s16x4, __builtin_amdgcn_ds_read_tr16_b64_v4i16((LAS s16x4*)(vp + 8 * VROW)));
                const bf16x8 va = __builtin_shufflevector(lo, hh, 0, 1, 2, 3, 4, 5, 6, 7);
                if (db == 0) o0 = __builtin_amdgcn_mfma_f32_32x32x16_bf16(va, pb, o0, 0, 0, 0);
                else o1 = __builtin_amdgcn_mfma_f32_32x32x16_bf16(va, pb, o1, 0, 0, 0);
            }
        }
        if (kt + 1 < NT) { LAS uchar* Kn = Kb0 + (cur ^ 1) * KTILE; LAS uchar* Vn = Vb0 + (cur ^ 1) * VTILE;
            *(LAS u32x4*)(Kn + skey * KROW + sch * 16) = rkn; *(LAS u32x4*)(Vn + skey * VROW + sch * 16) = rv; if (tid < 256) *(LAS u32x4*)(Kn + rkey * KROW + 128 + rch * 16) = rkr; }
        __syncthreads();
    }
    const float ltot = lrun + __shfl_xor(lrun, 32); const float inv = 1.f / ltot;
    bf16_t* op = mix + (size_t)qrow * 2048 + h * 64 + 4 * hi;
#pragma unroll
    for (int g = 0; g < 4; ++g) {
        u32x2 w0, w1;
        w0.x = pk2(o0[4 * g] * inv, o0[4 * g + 1] * inv); w0.y = pk2(o0[4 * g + 2] * inv, o0[4 * g + 3] * inv);
        w1.x = pk2(o1[4 * g] * inv, o1[4 * g + 1] * inv); w1.y = pk2(o1[4 * g + 2] * inv, o1[4 * g + 3] * inv);
        *(u32x2*)(op + 8 * g) = w0; *(u32x2*)(op + 32 + 8 * g) = w1;
    }
}
DI void p5_attention(const Params& P, LAS uchar* lds) {
    const int G = gridDim.x, bx = blockIdx.x; const int vcu = (G % 8 == 0) ? (bx % 8) * (G / 8) + bx / 8 : bx;
    const int perS = (1024 + G - 1) / G, perP = (4096 + G - 1) / G;
    for (int i = 0; i < perS; ++i) { const int s = vcu * perS + i; if (s < 1024) attn_unit(P, lds, TP, LS, s >> 6, s & 63); }
    for (int i = 0; i < perP; ++i) { const int s = vcu * perP + i; if (s < 4096) { const int b = s >> 7, rem = s & 127; attn_unit(P, lds, b * LP, LP, rem >> 3, rem & 7); } }
}

DI void p8_act(const Params& P, int rows, int row_off) {
    const int gt = blockIdx.x * 512 + threadIdx.x, NGT = gridDim.x * 512;
    const bf16_t* g = (const bf16_t*)(P.ws + WS_G); bf16_t* uo = (bf16_t*)(P.ws + WS_U);
    for (int idx = gt; idx < rows * 352; idx += NGT) {
        const int lrow = idx / 352, c0 = (idx - lrow * 352) * 8; const int row = row_off + lrow; const int pos = posof(row), L = lenof(row);
        float cur[8], prv[8], nxt[8], uu[8];
        unpack8(*(const u32x4*)(g + (size_t)lrow * DFF + c0), cur); unpack8(*(const u32x4*)(uo + (size_t)lrow * DFF + c0), uu);
        if (pos > 0) unpack8(*(const u32x4*)(g + (size_t)(lrow - 1) * DFF + c0), prv); else {
#pragma unroll
            for (int j = 0; j < 8; ++j) prv[j] = 0.f; }
        if (pos < L - 1) unpack8(*(const u32x4*)(g + (size_t)(lrow + 1) * DFF + c0), nxt); else {
#pragma unroll
            for (int j = 0; j < 8; ++j) nxt[j] = 0.f; }
        float o[8];
#pragma unroll
        for (int j = 0; j < 8; ++j) { const float v = P.ffn_conv_w[c0 + j] * prv[j] + P.ffn_conv_w[DFF + c0 + j] * cur[j] + P.ffn_conv_w[2 * DFF + c0 + j] * nxt[j] + P.ffn_conv_b[c0 + j]; o[j] = silu(v) * uu[j]; }
        *(u32x4*)(uo + (size_t)lrow * DFF + c0) = pack8(o);
    }
}
DI void p_final(const Params& P) {
    const int gt = blockIdx.x * 512 + threadIdx.x, NGT = gridDim.x * 512;
    const float* ss2 = (const float*)(P.ws + WS_SS) + T;
    for (int idx = gt; idx < T * 256; idx += NGT) { const int row = idx >> 8, c4 = idx & 255;
        const float rs = rsqrtf(ss2[row] * (1.f / DM) + EPS); const f32x4 w = ((const f32x4*)P.final_norm)[c4];
        f32x4 v = ((f32x4*)P.out)[idx]; v = v * rs * w; ((f32x4*)P.out)[idx] = v; }
}

constexpr int LDS_BYTES = 147456;
template <class Epi> DI void run_gemm(LAS uchar* lds, const bf16_t* A, int lda, const bf16_t* Bt, int M, int N, int K, const Epi& E) {
    pg8::Gemm g{A, Bt, M, N, K, lda}; pg8::StaticOrder S; S.init(M, N, (int)gridDim.x, (int)blockIdx.x);
    pg8::gemm_phase<Epi, pg8::StaticOrder, true, true>(lds, g, S, E);
}
__global__ void __launch_bounds__(512, 2) mega(Params P) {
    extern __shared__ __attribute__((aligned(16))) uchar lds_[];
    LAS uchar* lds = (LAS uchar*)lds_;
    cg::grid_group grid = cg::this_grid();
    uchar* ws = P.ws;
    bf16_t* lat = (bf16_t*)(ws + WS_LAT); float* ss = (float*)(ws + WS_SS);
    p0_prologue(P, lds);
    grid.sync();
    { EpiIn E{(bf16_t*)(ws + WS_Z), (bf16_t*)(ws + WS_XBC), lat, (float*)(ws + WS_DT)};
      run_gemm(lds, (const bf16_t*)(ws + WS_H), DM, (const bf16_t*)(ws + WS_WIN), T, DINP, DM, E); }
    grid.sync();
    p2_prep(P);
    grid.sync();
    p3_ssd_naive(P, lds);
    grid.sync();
    { EpiPlain E{(bf16_t*)P.out, NQ, QSCALE};
      run_gemm(lds, lat, NLAT, (const bf16_t*)(ws + WS_WQB), T, NQ, 384, E); }
    __syncthreads();
    { EpiPlain E{(bf16_t*)(ws + WS_KV), NKV, 1.0f};
      run_gemm(lds, lat + 384, NLAT, (const bf16_t*)(ws + WS_WKVB), T, NKV, 256, E); }
    grid.sync();
    p5_attention(P, lds);
    grid.sync();
    { EpiRes E{P.xp, P.xs, P.out, (bf16_t*)(ws + WS_X1B), ss, 0};
      run_gemm(lds, (const bf16_t*)(ws + WS_MIX), 2048, (const bf16_t*)(ws + WS_WOUT), T, DM, 2048, E); }
    grid.sync();
#pragma unroll 1
    for (int ch = 0; ch < 2; ++ch) {
        const int r0 = ch == 0 ? 0 : CH0_ROWS, rows = ch == 0 ? CH0_ROWS : CH1_ROWS;
        { EpiGU E{(bf16_t*)(ws + WS_G), (bf16_t*)(ws + WS_U), ss, r0};
          run_gemm(lds, (const bf16_t*)(ws + WS_X1B) + (size_t)r0 * DM, DM, (const bf16_t*)(ws + WS_WGU), rows, NGU, DM, E); }
        grid.sync();
        p8_act(P, rows, r0);
        grid.sync();
        { EpiRes E{P.out, P.out + (size_t)TP * DM, P.out, nullptr, ss + T, r0};
          run_gemm(lds, (const bf16_t*)(ws + WS_U), DFF, (const bf16_t*)(ws + WS_WDN), rows, DM, DFF, E); }
        grid.sync();
    }
    p_final(P);
}

extern "C" void kernel_launch(void* const* d_in, const int* in_sizes, int n_in, void* d_out, int out_size, void* d_ws, size_t ws_size, hipStream_t stream) {
    static int grid = 0;
    if (grid == 0) {
        int dev = 0, cus = 0, per_cu = 0;
        hipGetDevice(&dev); hipDeviceGetAttribute(&cus, hipDeviceAttributeMultiprocessorCount, dev);
        hipFuncSetAttribute((const void*)mega, hipFuncAttributeMaxDynamicSharedMemorySize, LDS_BYTES);
        if (hipOccupancyMaxActiveBlocksPerMultiprocessor(&per_cu, (const void*)mega, 512, LDS_BYTES) != hipSuccess || per_cu < 1) per_cu = 1;
        (void)hipGetLastError();
        grid = cus * per_cu;
        if (ws_size < 1020 * MiB) fprintf(stderr, "kernel_launch: workspace too small: %zu\n", ws_size);
    }
    Params p{};
    const float** pf = (const float**)&p;
    for (int i = 0; i < 24; ++i) pf[i] = (const float*)d_in[i];
    p.out = (float*)d_out; p.ws = (uchar*)d_ws;
    void* args[] = {&p};
    hipError_t e = hipLaunchCooperativeKernel((const void*)mega, dim3(grid), dim3(512), args, LDS_BYTES, stream);
    if (e != hipSuccess) fprintf(stderr, "cooperative launch failed: %s (grid %d)\n", hipGetErrorString(e), grid);
}
```

```cpp
#include <hip/hip_runtime.h>
#include <hip/hip_cooperative_groups.h>
#include <cstdio>
#include <cstdint>
namespace cg = cooperative_groups;
namespace pg8 {
#define PG8_LAS __attribute__((address_space(3)))
typedef unsigned short bf16_t;
typedef short bf16x8 __attribute__((ext_vector_type(8)));
typedef float f32x4 __attribute__((ext_vector_type(4)));
typedef unsigned u32x4 __attribute__((ext_vector_type(4)));
constexpr int BM = 256, BK = 64, HALF = 128, HTB = HALF * BK * 2  , STAGE_BYTES = 8 * HTB, NXCD = 8, WGM = 8;
__host__ __device__ __forceinline__ int lds_byte(int r, int c) { const int st = (r >> 4) * 2 + (c >> 5), rr = r & 15, cc = c & 31, ob = rr * 64 + cc * 2; return st * 1024 + (ob ^ (((ob >> 9) & 1) << 5)); }
__host__ __device__ __forceinline__ void stage_rc(int b, int& R, int& C) { const int st = b / 1024, sb = b % 1024, swz = sb ^ (((sb >> 9) & 1) << 5); R = (st >> 1) * 16 + swz / 64; C = (st & 1) * 32 + (swz % 64) / 2; }
__host__ __device__ __forceinline__ int perm32(int rho) { const int n = rho >> 4, i = rho & 15; return 8 * (i >> 2) + 4 * n + (i & 3); }
struct Unit { int pm, pn; };
struct Gemm { const bf16_t* A; const bf16_t* Bt; int M, N, K, lda; };
struct StaticOrder {
    int nM, nN, nwg, G, c;
    __host__ __device__ void init(int M, int N, int G_, int c_) { nM = M / BM; nN = N / BM; nwg = nM * nN; G = G_; c = c_; }
    __host__ __device__ bool next(int i, Unit& u) const {
        const long L = (long)i * G + c; if (L >= nwg) return false;
        int wgid = (int)L; { const int q = nwg / NXCD, r = nwg % NXCD, xcd = wgid % NXCD, off = wgid / NXCD; wgid = (xcd < r ? xcd * (q + 1) : r * (q + 1) + (xcd - r) * q) + off; }
        const int nig = WGM * nN, gid = wgid / nig, fm = gid * WGM, gsz = (nM - fm) < WGM ? (nM - fm) : WGM;
        u.pm = fm + ((wgid % nig) % gsz); u.pn = (wgid % nig) / gsz; return true;
    }
    __device__ __forceinline__ void a_ready(const Unit&) const {}
    __device__ __forceinline__ void done(const Unit&) const {}
};
template <class Epi, class Sched, bool ALIGN_EPI = false, bool SP2 = false>
__device__ __forceinline__ void gemm_phase(PG8_LAS unsigned char* lds, const Gemm g, const Sched& S, const Epi& E) {
    int tid_ = threadIdx.x; asm volatile("" : "+v"(tid_)); const int tid = tid_, wid = __builtin_amdgcn_readfirstlane(tid >> 6), lane = tid & 63, wr = wid >> 2, wc = wid & 3, fr = lane & 15, fq = lane >> 4;
    const int K = g.K, nt = K / BK;
    unsigned voffA[2], voffB[2];
#pragma unroll
    for (int i = 0; i < 2; ++i) { int R, C; stage_rc(tid * 16 + i * 8192, R, C); const int Rb = Epi::PERM ? ((R & ~31) + perm32(R & 31)) : R;
        voffA[i] = (unsigned)(R * g.lda + C) * 2u; voffB[i] = (unsigned)(Rb * K + C) * 2u; }
    const size_t kstep = (size_t)(BK * 2);
    const size_t hstepB = (size_t)HALF * K * 2, hstepA = (size_t)HALF * g.lda * 2;
    const size_t tstepA = 2 * hstepA, tstepB = 2 * hstepB;
    const unsigned ldsw = (unsigned)wid * 1024u;
    const int aoff = lds_byte(wr * 64 + fr, fq * 8), boff = lds_byte(wc * 32 + fr, fq * 8);
#define PG8_SA(b, h) (((b) * 2 + (h)) * HTB)
#define PG8_SB(b, h) ((4 + (b) * 2 + (h)) * HTB)
#define PG8_STAGE(bufoff, gbase, voff) do { _Pragma("unroll") for (int _i = 0; _i < 2; ++_i) \
        __builtin_amdgcn_global_load_lds((const unsigned*)((const char*)(gbase) + (voff)[_i]), (PG8_LAS unsigned*)(lds + (bufoff) + ldsw + _i * 8192), 16, 0, 0); } while (0)
#define PG8_LDA(dst, b, h) do { _Pragma("unroll") for (int m = 0; m < 4; ++m) _Pragma("unroll") for (int k = 0; k < 2; ++k) dst[m][k] = *(const PG8_LAS bf16x8*)(lds + PG8_SA(b, h) + aoff + m * 2048 + k * 1024); } while (0)
#define PG8_LDB(dst, b, h) do { _Pragma("unroll") for (int n = 0; n < 2; ++n) _Pragma("unroll") for (int k = 0; k < 2; ++k) dst[n][k] = *(const PG8_LAS bf16x8*)(lds + PG8_SB(b, h) + boff + n * 2048 + k * 1024); } while (0)
#define PG8_MMA(ai, bj, At, Bt) do { __builtin_amdgcn_s_setprio(1); _Pragma("unroll") for (int m = 0; m < 4; ++m) _Pragma("unroll") for (int n = 0; n < 2; ++n) _Pragma("unroll") for (int k = 0; k < 2; ++k) \
        acc[ai][bj][m][n] = __builtin_amdgcn_mfma_f32_16x16x32_bf16(Bt[n][k], At[m][k], acc[ai][bj][m][n], 0, 0, 0); __builtin_amdgcn_s_setprio(0); } while (0)
#define PG8_WAIT_V(n) asm volatile("s_waitcnt vmcnt(" #n ")" ::: "memory")
#define PG8_WAIT_L(n) asm volatile("s_waitcnt lgkmcnt(" #n ")" ::: "memory")
#define PG8_BAR __builtin_amdgcn_s_barrier()
#define PG8_SCHED __builtin_amdgcn_sched_barrier(0)
    Unit cur, nxt; int ui = 0;
    if (!S.next(0, cur)) return;
    f32x4 acc[2][2][4][2];
#pragma unroll
    for (int a = 0; a < 2; ++a)
#pragma unroll
        for (int b = 0; b < 2; ++b)
#pragma unroll
            for (int m = 0; m < 4; ++m)
#pragma unroll
                for (int n = 0; n < 2; ++n) acc[a][b][m][n] = (f32x4){0.f, 0.f, 0.f, 0.f};
    bf16x8 At[4][2], B0[2][2], B1[2][2];
    const char* cA = (const char*)g.A + (size_t)cur.pm * tstepA; const char* cB = (const char*)g.Bt + (size_t)cur.pn * tstepB;
    S.a_ready(cur);
    if constexpr (SP2) {
        PG8_STAGE(PG8_SB(0, 0), cB, voffB); PG8_STAGE(PG8_SB(0, 1), cB + hstepB, voffB); PG8_STAGE(PG8_SA(0, 0), cA, voffA); PG8_STAGE(PG8_SA(0, 1), cA + hstepA, voffA);
        if (wr == 1) PG8_BAR;
        PG8_WAIT_V(2); PG8_BAR;
        PG8_STAGE(PG8_SB(1, 0), cB + kstep, voffB); PG8_STAGE(PG8_SA(1, 0), cA + kstep, voffA); PG8_STAGE(PG8_SB(1, 1), cB + hstepB + kstep, voffB);
        PG8_WAIT_V(6); PG8_BAR;
    } else {
        PG8_STAGE(PG8_SB(0, 0), cB, voffB); PG8_STAGE(PG8_SA(0, 0), cA, voffA); PG8_STAGE(PG8_SB(0, 1), cB + hstepB, voffB); PG8_STAGE(PG8_SA(0, 1), cA + hstepA, voffA);
        if (wr == 1) PG8_BAR;
        PG8_WAIT_V(4); PG8_BAR;
        PG8_STAGE(PG8_SB(1, 0), cB + kstep, voffB); PG8_STAGE(PG8_SA(1, 0), cA + kstep, voffA); PG8_STAGE(PG8_SB(1, 1), cB + hstepB + kstep, voffB);
        PG8_WAIT_V(6); PG8_BAR;
    }
    for (;;) {
        const bool has_next = S.next(ui + 1, nxt);
        const char* nA = has_next ? (const char*)g.A + (size_t)nxt.pm * tstepA : cA; const char* nB = has_next ? (const char*)g.Bt + (size_t)nxt.pn * tstepB : cB;
        for (int t = 0; t < nt; t += 2) {
            const bool last = (t == nt - 2);
            const char* a1 = cA + (size_t)(t + 1) * kstep;
            const char* a2 = last ? nA : cA + (size_t)(t + 2) * kstep; const char* b2 = last ? nB : cB + (size_t)(t + 2) * kstep;
            const char* a3 = a2 + kstep; const char* b3 = b2 + kstep;
            if (last && has_next) S.a_ready(nxt);
            if constexpr (SP2) {
            PG8_LDB(B0, 0, 0); PG8_LDB(B1, 0, 1); PG8_SCHED; PG8_LDA(At, 0, 0); PG8_STAGE(PG8_SA(1, 1), a1 + hstepA, voffA);
            PG8_WAIT_V(8); PG8_WAIT_L(0); PG8_BAR; PG8_MMA(0, 0, At, B0); PG8_MMA(0, 1, At, B1); PG8_BAR; PG8_SCHED;
            PG8_LDA(At, 0, 1); PG8_STAGE(PG8_SB(0, 0), b2, voffB); PG8_STAGE(PG8_SB(0, 1), b2 + hstepB, voffB); PG8_STAGE(PG8_SA(0, 0), a2, voffA);
            PG8_WAIT_V(8); PG8_WAIT_L(0); PG8_BAR; PG8_MMA(1, 0, At, B0); PG8_MMA(1, 1, At, B1); PG8_BAR; PG8_SCHED;
            PG8_LDB(B0, 1, 0); PG8_LDB(B1, 1, 1); PG8_SCHED; PG8_LDA(At, 1, 0); PG8_STAGE(PG8_SA(0, 1), a2 + hstepA, voffA);
            PG8_WAIT_V(8); PG8_WAIT_L(0); PG8_BAR; PG8_MMA(0, 0, At, B0); PG8_MMA(0, 1, At, B1); PG8_BAR; PG8_SCHED;
            PG8_LDA(At, 1, 1); PG8_STAGE(PG8_SB(1, 0), b3, voffB); PG8_STAGE(PG8_SB(1, 1), b3 + hstepB, voffB); PG8_STAGE(PG8_SA(1, 0), a3, voffA);
            PG8_WAIT_V(8); PG8_WAIT_L(0); PG8_BAR; PG8_MMA(1, 0, At, B0); PG8_MMA(1, 1, At, B1); PG8_BAR; PG8_SCHED;
            } else {
            PG8_LDB(B0, 0, 0); PG8_SCHED; PG8_LDA(At, 0, 0); PG8_STAGE(PG8_SA(1, 1), a1 + hstepA, voffA);
            PG8_WAIT_L(8); PG8_BAR; PG8_WAIT_L(0); PG8_MMA(0, 0, At, B0); PG8_BAR; PG8_SCHED;
            PG8_LDB(B1, 0, 1); PG8_STAGE(PG8_SB(0, 0), b2, voffB);
            PG8_BAR; PG8_WAIT_L(0); PG8_MMA(0, 1, At, B1); PG8_BAR;
            PG8_LDA(At, 0, 1); PG8_STAGE(PG8_SA(0, 0), a2, voffA);
            PG8_BAR; PG8_WAIT_L(0); PG8_MMA(1, 0, At, B0); PG8_BAR; PG8_SCHED;
            PG8_STAGE(PG8_SB(0, 1), b2 + hstepB, voffB);
            PG8_WAIT_V(6); PG8_BAR; PG8_MMA(1, 1, At, B1); PG8_BAR;
            PG8_LDB(B0, 1, 0); PG8_SCHED; PG8_LDA(At, 1, 0); PG8_STAGE(PG8_SA(0, 1), a2 + hstepA, voffA);
            PG8_WAIT_L(8); PG8_BAR; PG8_WAIT_L(0); PG8_MMA(0, 0, At, B0); PG8_BAR; PG8_SCHED;
            PG8_LDB(B1, 1, 1); PG8_STAGE(PG8_SB(1, 0), b3, voffB);
            PG8_BAR; PG8_WAIT_L(0); PG8_MMA(0, 1, At, B1); PG8_BAR;
            PG8_LDA(At, 1, 1); PG8_STAGE(PG8_SA(1, 0), a3, voffA);
            PG8_BAR; PG8_WAIT_L(0); PG8_MMA(1, 0, At, B0); PG8_BAR; PG8_SCHED;
            PG8_STAGE(PG8_SB(1, 1), b3 + hstepB, voffB);
            PG8_WAIT_V(6); PG8_BAR; PG8_MMA(1, 1, At, B1); PG8_BAR;
            }
        }
        if constexpr (ALIGN_EPI) { if (wr == 0) PG8_BAR; }
        if constexpr (!Epi::AFTER_DRAIN) { E(acc, cur, wr, wc, fr, fq); S.done(cur); }
        if (!has_next) break;
#pragma unroll
        for (int a = 0; a < 2; ++a)
#pragma unroll
            for (int b = 0; b < 2; ++b)
#pragma unroll
                for (int m = 0; m < 4; ++m)
#pragma unroll
                    for (int n = 0; n < 2; ++n) acc[a][b][m][n] = (f32x4){0.f, 0.f, 0.f, 0.f};
        cur = nxt; cA = nA; cB = nB; ++ui;
        if constexpr (ALIGN_EPI) { if (wr == 1) PG8_BAR; }
    }
    PG8_WAIT_V(0);
    if constexpr (!ALIGN_EPI) { if (wr == 0) PG8_BAR; }
    PG8_BAR;
    if constexpr (Epi::AFTER_DRAIN) { E.fused(acc, cur, wr, wc, fr, fq, lds, wid, lane); S.done(cur); }
#undef PG8_SA
#undef PG8_SB
#undef PG8_STAGE
#undef PG8_LDA
#undef PG8_LDB
#undef PG8_MMA
#undef PG8_WAIT_V
#undef PG8_WAIT_L
#undef PG8_BAR
#undef PG8_SCHED
}
}

#define DI __device__ __forceinline__
#define LAS __attribute__((address_space(3)))
typedef unsigned short bf16_t;
typedef unsigned char uchar;
typedef short bf16x8 __attribute__((ext_vector_type(8)));
typedef short s16x4 __attribute__((ext_vector_type(4)));
typedef float f32x4 __attribute__((ext_vector_type(4)));
typedef float f32x16 __attribute__((ext_vector_type(16)));
typedef unsigned u32x4 __attribute__((ext_vector_type(4)));
typedef unsigned u32x2 __attribute__((ext_vector_type(2)));
typedef float f32x2_t __attribute__((ext_vector_type(2)));
typedef __bf16 bf16x2_t __attribute__((ext_vector_type(2)));

constexpr int T = 81920, TP = 65536, DM = 1024;
constexpr int LP = 2048, LS = 16384;
constexpr int DIN = 3008, DINP = 3072;
constexpr int NQ = 1536, NKV = 2048, NLAT = 768, NXBC = 1280;
constexpr int DFF = 2816, NGU = 5632;
constexpr float EPS = 1e-6f;
constexpr float QSCALE = 0.10206207261596575f * 1.4426950408889634f;
constexpr int CH0_ROWS = 49152, CH1_ROWS = 32768;

constexpr size_t MiB = 1u << 20;
constexpr size_t WS_WIN = 0, WS_WQB = 6 * MiB, WS_WKVB = 8 * MiB, WS_WOUT = 9 * MiB, WS_WGU = 13 * MiB, WS_WDN = 24 * MiB;
constexpr size_t WS_TAB = 30 * MiB;
constexpr size_t WS_H = 32 * MiB;
constexpr size_t WS_XBC = 192 * MiB;
constexpr size_t WS_MIX = 32 * MiB;
constexpr size_t WS_Z = 392 * MiB;
constexpr size_t WS_LAT = 552 * MiB;
constexpr size_t WS_DT = 672 * MiB;
constexpr size_t WS_XBC2 = 682 * MiB;
constexpr size_t WS_KV = 682 * MiB;
constexpr size_t WS_X1B = 352 * MiB;
constexpr size_t WS_SS = 1004 * MiB;
constexpr size_t WS_G = 32 * MiB;
constexpr size_t WS_U = 512 * MiB;
static_assert(WS_XBC2 + (size_t)T * NXBC * 2 <= WS_SS && WS_KV + (size_t)T * NKV * 2 <= WS_SS, "ws map");
static_assert(WS_G + (size_t)CH0_ROWS * DFF * 2 <= WS_X1B && WS_X1B + (size_t)T * DM * 2 <= WS_U && WS_U + (size_t)CH0_ROWS * DFF * 2 <= WS_SS, "ws map 2");
static_assert(WS_MIX + (size_t)T * 2048 * 2 <= WS_X1B, "ws map 3");

struct Params {
    const float *xp, *xs, *norm1, *w_in, *q_a_norm, *kv_a_norm, *w_q_b, *w_kv_b, *conv_w, *conv_b, *dt_bias_f, *dt_bias_b, *a_log_f, *a_log_b,
        *d_skip, *ssm_norm, *w_out, *norm2, *w_gate, *w_up, *ffn_conv_w, *ffn_conv_b, *w_down, *final_norm;
    float* out; uchar* ws;
};

DI float bf2f(bf16_t v) { return __uint_as_float((unsigned)v << 16); }
DI unsigned pk2(float lo, float hi) { f32x2_t v = {lo, hi}; bf16x2_t b = __builtin_convertvector(v, bf16x2_t); return __builtin_bit_cast(unsigned, b); }
DI void unpack8(const u32x4 w, float (&f)[8]) {
#pragma unroll
    for (int i = 0; i < 4; ++i) { f[2 * i] = __uint_as_float(w[i] << 16); f[2 * i + 1] = __uint_as_float(w[i] & 0xffff0000u); }
}
DI u32x4 pack8(const float (&f)[8]) { u32x4 w; w.x = pk2(f[0], f[1]); w.y = pk2(f[2], f[3]); w.z = pk2(f[4], f[5]); w.w = pk2(f[6], f[7]); return w; }
DI float wave_sum(float v) {
#pragma unroll
    for (int o = 1; o < 64; o <<= 1) v += __shfl_xor(v, o);
    return v;
}
DI const float* xrow(const Params& P, int row) { return row < TP ? P.xp + (size_t)row * DM : P.xs + (size_t)(row - TP) * DM; }
DI int posof(int row) { return row < TP ? (row & (LP - 1)) : row - TP; }
DI int lenof(int row) { return row < TP ? LP : LS; }
DI float silu(float v) { return v / (1.f + __expf(-v)); }

#define EPI_LOOP_BEGIN \
    _Pragma("unroll") for (int ai = 0; ai < 2; ++ai) _Pragma("unroll") for (int m = 0; m < 4; ++m) { const int row = u.pm * 256 + ai * 128 + wr * 64 + m * 16 + fr; \
    _Pragma("unroll") for (int bj = 0; bj < 2; ++bj) { const f32x4 v0 = acc[ai][bj][m][0], v1 = acc[ai][bj][m][1];
#define EPI_LOOP_END } }

struct EpiIn {
    static constexpr bool PERM = true, AFTER_DRAIN = false;
    bf16_t *z, *xbc, *lat; float* dt;
    DI void operator()(const f32x4 (&acc)[2][2][4][2], const pg8::Unit& u, int wr, int wc, int fr, int fq) const {
        bf16_t* base; int ld, colt;
        if (u.pn < 4) { base = z; ld = DM; colt = u.pn * 256; } else if (u.pn < 9) { base = xbc; ld = NXBC; colt = (u.pn - 4) * 256; } else { base = lat; ld = NLAT; colt = (u.pn - 9) * 256; }
        const int col0 = colt + wc * 32 + 8 * fq;
        EPI_LOOP_BEGIN
            u32x4 w; w.x = pk2(v0[0], v0[1]); w.y = pk2(v0[2], v0[3]); w.z = pk2(v1[0], v1[1]); w.w = pk2(v1[2], v1[3]);
            *(u32x4*)(base + (size_t)row * ld + col0 + bj * 128) = w;
            if (u.pn == 11 && bj == 1 && wc == 1) { float* d = dt + (size_t)row * 32 + 8 * fq; *(f32x4*)d = v0; *(f32x4*)(d + 4) = v1; }
        EPI_LOOP_END
    }
};
struct EpiPlain {
    static constexpr bool PERM = true, AFTER_DRAIN = false;
    bf16_t* o; int ld; float sc;
    DI void operator()(const f32x4 (&acc)[2][2][4][2], const pg8::Unit& u, int wr, int wc, int fr, int fq) const {
        const int col0 = u.pn * 256 + wc * 32 + 8 * fq;
        EPI_LOOP_BEGIN
            u32x4 w; w.x = pk2(v0[0] * sc, v0[1] * sc); w.y = pk2(v0[2] * sc, v0[3] * sc); w.z = pk2(v1[0] * sc, v1[1] * sc); w.w = pk2(v1[2] * sc, v1[3] * sc);
            *(u32x4*)(o + (size_t)row * ld + col0 + bj * 128) = w;
        EPI_LOOP_END
    }
};
struct EpiRes {
    static constexpr bool PERM = true, AFTER_DRAIN = false;
    const float* resp; const float* ress; float* xo; bf16_t* xb; float* ss; int row_off;
    DI void operator()(const f32x4 (&acc)[2][2][4][2], const pg8::Unit& u, int wr, int wc, int fr, int fq) const {
        const int col0 = u.pn * 256 + wc * 32 + 8 * fq;
#pragma unroll
        for (int ai = 0; ai < 2; ++ai)
#pragma unroll
            for (int m = 0; m < 4; ++m) {
                const int row = row_off + u.pm * 256 + ai * 128 + wr * 64 + m * 16 + fr;
                const float* rp = (row < TP ? resp + (size_t)row * DM : ress + (size_t)(row - TP) * DM) + col0;
                float s = 0.f;
#pragma unroll
                for (int bj = 0; bj < 2; ++bj) {
                    const f32x4 r0 = *(const f32x4*)(rp + bj * 128), r1 = *(const f32x4*)(rp + bj * 128 + 4);
                    const f32x4 a = acc[ai][bj][m][0] + r0, b = acc[ai][bj][m][1] + r1;
                    float* op = xo + (size_t)row * DM + col0 + bj * 128;
                    *(f32x4*)op = a; *(f32x4*)(op + 4) = b;
                    if (xb) { u32x4 w; w.x = pk2(a[0], a[1]); w.y = pk2(a[2], a[3]); w.z = pk2(b[0], b[1]); w.w = pk2(b[2], b[3]); *(u32x4*)(xb + (size_t)row * DM + col0 + bj * 128) = w; }
                    s += (a[0] * a[0] + a[1] * a[1]) + (a[2] * a[2] + a[3] * a[3]) + (b[0] * b[0] + b[1] * b[1]) + (b[2] * b[2] + b[3] * b[3]);
                }
                s += __shfl_xor(s, 16); s += __shfl_xor(s, 32);
                if (fq == 0) atomicAdd(ss + row, s);
            }
    }
};
struct EpiGU {
    static constexpr bool PERM = true, AFTER_DRAIN = false;
    bf16_t *g, *uo; const float* ss; int row_off;
    DI void operator()(const f32x4 (&acc)[2][2][4][2], const pg8::Unit& u, int wr, int wc, int fr, int fq) const {
        const int col0 = u.pn * 128 + wc * 32 + 8 * fq;
#pragma unroll
        for (int ai = 0; ai < 2; ++ai)
#pragma unroll
            for (int m = 0; m < 4; ++m) {
                const int lrow = u.pm * 256 + ai * 128 + wr * 64 + m * 16 + fr;
                const float rs = rsqrtf(ss[row_off + lrow] * (1.f / DM) + EPS);
#pragma unroll
                for (int bj = 0; bj < 2; ++bj) {
                    const f32x4 a = acc[ai][bj][m][0] * rs, b = acc[ai][bj][m][1] * rs;
                    u32x4 w; w.x = pk2(a[0], a[1]); w.y = pk2(a[2], a[3]); w.z = pk2(b[0], b[1]); w.w = pk2(b[2], b[3]);
                    *(u32x4*)((bj == 0 ? g : uo) + (size_t)lrow * DFF + col0) = w;
                }
            }
    }
};

template <class F> DI void transpose_item(const float* W, int K, int N, bf16_t* WT, LAS float* scr, int item, int lane, F destrow, const float* kscale) {
    const int nblk = N / 32, kb = item / nblk, nb = item % nblk, k0 = 64 * kb, n0 = 32 * nb;
#pragma unroll 8
    for (int i = 0; i < 32; ++i) { const int kk = 2 * i + (lane >> 5); float w = W[(size_t)(k0 + kk) * N + n0 + (lane & 31)]; if (kscale) w *= kscale[k0 + kk]; scr[kk * 33 + (lane & 31)] = w; }
    asm volatile("s_waitcnt lgkmcnt(0)" ::: "memory");
    const int c = lane & 7;
#pragma unroll
    for (int j = 0; j < 4; ++j) { const int n = (lane >> 3) + 8 * j; const LAS float* s = scr + (8 * c) * 33 + n;
        u32x4 o; o.x = pk2(s[0 * 33], s[1 * 33]); o.y = pk2(s[2 * 33], s[3 * 33]); o.z = pk2(s[4 * 33], s[5 * 33]); o.w = pk2(s[6 * 33], s[7 * 33]);
        *(u32x4*)(WT + (size_t)destrow(n0 + n) * K + k0 + 8 * c) = o; }
    asm volatile("s_waitcnt lgkmcnt(0)" ::: "memory");
}
struct DestIn { DI int operator()(int c) const { return c < 672 ? 2304 + c : (c < 1696 ? c - 672 : (c < 2976 ? 1024 + (c - 1696) : 2304 + 672 + (c - 2976))); } };
struct DestQb { DI int operator()(int c) const { const int h = c / 96, j = c % 96; if (j < 64) return h * 64 + j; const int i = j - 64; return 1024 + h * 32 + (i < 16 ? 2 * i : 2 * (i - 16) + 1); } };
struct DestKvb { DI int operator()(int c) const { const int h = c >> 7, j = c & 127; return j < 64 ? h * 64 + j : 1024 + h * 64 + (j - 64); } };
struct DestId { DI int operator()(int c) const { return c; } };
struct DestGate { DI int operator()(int c) const { return 256 * (c >> 7) + (c & 127); } };
struct DestUp { DI int operator()(int c) const { return 256 * (c >> 7) + 128 + (c & 127); } };

DI void p0_prologue(const Params& P, LAS uchar* lds) {
    const int tid = threadIdx.x, lane = tid & 63, wave = tid >> 6, G = gridDim.x;
    const int gw = blockIdx.x * 8 + wave, NGW = G * 8;
    const int gt = blockIdx.x * 512 + tid, NGT = G * 512;
    LAS float* scr = (LAS float*)(lds + wave * 16384);
    bf16_t* Win = (bf16_t*)(P.ws + WS_WIN); bf16_t* Wqb = (bf16_t*)(P.ws + WS_WQB); bf16_t* Wkvb = (bf16_t*)(P.ws + WS_WKVB);
    bf16_t* Wout = (bf16_t*)(P.ws + WS_WOUT); bf16_t* Wgu = (bf16_t*)(P.ws + WS_WGU); bf16_t* Wdn = (bf16_t*)(P.ws + WS_WDN);
    constexpr int I_IN = 16 * 94, I_QB = 6 * 48, I_KVB = 4 * 64, I_OUT = 32 * 32, I_G = 16 * 88, I_DN = 44 * 32;
    constexpr int NITEMS = I_IN + I_QB + I_KVB + I_OUT + 2 * I_G + I_DN;
    for (int it = gw; it < NITEMS; it += NGW) {
        int r = it;
        if (r < I_IN) { transpose_item(P.w_in, 1024, DIN, Win, scr, r, lane, DestIn(), nullptr); continue; } r -= I_IN;
        if (r < I_QB) { transpose_item(P.w_q_b, 384, NQ, Wqb, scr, r, lane, DestQb(), nullptr); continue; } r -= I_QB;
        if (r < I_KVB) { transpose_item(P.w_kv_b, 256, NKV, Wkvb, scr, r, lane, DestKvb(), nullptr); continue; } r -= I_KVB;
        if (r < I_OUT) { transpose_item(P.w_out, 2048, DM, Wout, scr, r, lane, DestId(), nullptr); continue; } r -= I_OUT;
        if (r < I_G) { transpose_item(P.w_gate, 1024, DFF, Wgu, scr, r, lane, DestGate(), P.norm2); continue; } r -= I_G;
        if (r < I_G) { transpose_item(P.w_up, 1024, DFF, Wgu, scr, r, lane, DestUp(), P.norm2); continue; } r -= I_G;
        transpose_item(P.w_down, DFF, DM, Wdn, scr, r, lane, DestId(), nullptr);
    }
    for (int i = gt; i < 64 * 1024 / 8; i += NGT) *(u32x4*)(Win + (size_t)3008 * 1024 + (size_t)i * 8) = (u32x4){0u, 0u, 0u, 0u};
    float* tab = (float*)(P.ws + WS_TAB);
    for (int i = gt; i < LS * 16; i += NGT) { const int pos = i >> 4, k = i & 15; const float inv = powf(10000.0f, -(float)(2 * k) / 32.0f); const float ang = (float)pos * inv; float s, c; sincosf(ang, &s, &c); tab[2 * i] = c; tab[2 * i + 1] = s; }
    float* ss = (float*)(P.ws + WS_SS);
    for (int i = gt; i < 2 * T; i += NGT) ss[i] = 0.f;
    bf16_t* hb = (bf16_t*)(P.ws + WS_H);
    for (int row = gw; row < T; row += NGW) {
        const f32x4* xr = (const f32x4*)xrow(P, row) + lane;
        f32x4 v[4]; float s = 0.f;
#pragma unroll
        for (int j = 0; j < 4; ++j) { v[j] = xr[64 * j]; s += (v[j][0] * v[j][0] + v[j][1] * v[j][1]) + (v[j][2] * v[j][2] + v[j][3] * v[j][3]); }
        const float rs = rsqrtf(wave_sum(s) * (1.f / DM) + EPS);
        u32x2* o = (u32x2*)(hb + (size_t)row * DM) + lane;
#pragma unroll
        for (int j = 0; j < 4; ++j) { const f32x4 w = ((const f32x4*)P.norm1)[lane + 64 * j]; u32x2 pk; pk.x = pk2(v[j][0] * rs * w[0], v[j][1] * rs * w[1]); pk.y = pk2(v[j][2] * rs * w[2], v[j][3] * rs * w[3]); o[64 * j] = pk; }
    }
}

DI void p2_prep(const Params& P) {
    const int tid = threadIdx.x, lane = tid & 63, wave = tid >> 6, G = gridDim.x;
    const int gw = blockIdx.x * 8 + wave, NGW = G * 8;
    const int gt = blockIdx.x * 512 + tid, NGT = G * 512;
    bf16_t* lat = (bf16_t*)(P.ws + WS_LAT); float* dt = (float*)(P.ws + WS_DT); const float* tab = (const float*)(P.ws + WS_TAB);
    for (int row = gw; row < T; row += NGW) {
        bf16_t* lr = lat + (size_t)row * NLAT;
        float qv[8], kv[8];
#pragma unroll
        for (int j = 0; j < 8; ++j) { qv[j] = 0.f; kv[j] = 0.f; }
        if (lane < 48) unpack8(*(const u32x4*)(lr + lane * 8), qv);
        if (lane < 32) unpack8(*(const u32x4*)(lr + 384 + lane * 8), kv);
        float sq = 0.f, sk = 0.f;
#pragma unroll
        for (int j = 0; j < 8; ++j) { sq += qv[j] * qv[j]; sk += kv[j] * kv[j]; }
        sq = wave_sum(sq); sk = wave_sum(sk);
        const float rq = rsqrtf(sq * (1.f / 384.f) + EPS), rk = rsqrtf(sk * (1.f / 256.f) + EPS);
        float x1 = 0.f, x2 = 0.f, dtv = 0.f;
        if (lane < 16) { x1 = bf2f(lr[640 + lane]); x2 = bf2f(lr[656 + lane]); }
        if (lane < 32) dtv = dt[(size_t)row * 32 + lane];
        asm volatile("s_waitcnt vmcnt(0)" ::: "memory");
        if (lane < 48) { float o[8];
#pragma unroll
            for (int j = 0; j < 8; ++j) o[j] = qv[j] * rq * P.q_a_norm[lane * 8 + j];
            *(u32x4*)(lr + lane * 8) = pack8(o); }
        if (lane < 32) { float o[8];
#pragma unroll
            for (int j = 0; j < 8; ++j) o[j] = kv[j] * rk * P.kv_a_norm[lane * 8 + j];
            *(u32x4*)(lr + 384 + lane * 8) = pack8(o); }
        if (lane < 16) { const float c = tab[((size_t)posof(row) * 16 + lane) * 2], s = tab[((size_t)posof(row) * 16 + lane) * 2 + 1];
            *(unsigned*)(lr + 640 + 2 * lane) = pk2(x1 * c - x2 * s, x2 * c + x1 * s); }
        if (lane < 32) { const float b = lane < 16 ? P.dt_bias_f[lane] : P.dt_bias_b[lane - 16]; const float v = dtv + b;
            dt[(size_t)row * 32 + lane] = fmaxf(v, 0.f) + log1pf(__expf(-fabsf(v))); }
    }
    const bf16_t* xbc = (const bf16_t*)(P.ws + WS_XBC); bf16_t* xbc2 = (bf16_t*)(P.ws + WS_XBC2);
    for (int idx = gt; idx < T * 160; idx += NGT) {
        const int row = idx / 160, c0 = (idx - row * 160) * 8; const int pos = posof(row), L = lenof(row);
        float cur[8], prv[8], nxt[8];
        unpack8(*(const u32x4*)(xbc + (size_t)row * NXBC + c0), cur);
        if (pos > 0) unpack8(*(const u32x4*)(xbc + (size_t)(row - 1) * NXBC + c0), prv); else {
#pragma unroll
            for (int j = 0; j < 8; ++j) prv[j] = 0.f; }
        if (pos < L - 1) unpack8(*(const u32x4*)(xbc + (size_t)(row + 1) * NXBC + c0), nxt); else {
#pragma unroll
            for (int j = 0; j < 8; ++j) nxt[j] = 0.f; }
        float o[8];
#pragma unroll
        for (int j = 0; j < 8; ++j) { const float v = P.conv_w[c0 + j] * prv[j] + P.conv_w[NXBC + c0 + j] * cur[j] + P.conv_w[2 * NXBC + c0 + j] * nxt[j] + P.conv_b[c0 + j]; o[j] = silu(v); }
        *(u32x4*)(xbc2 + (size_t)row * NXBC + c0) = pack8(o);
    }
}

constexpr int BCROW = 144, SSD_BT = 0, SSD_CT = 128 * BCROW, SSD_WAVE = 2 * 128 * BCROW, SSD_WSZ = 8192 + 2048, SSD_RED = SSD_WAVE + 8 * SSD_WSZ;
constexpr size_t WS_DEC = 352 * MiB;
DI float wave_incl_scan(float v, int lane) {
#pragma unroll
    for (int o = 1; o < 64; o <<= 1) { const float n = __shfl_up(v, o); if (lane >= o) v += n; }
    return v;
}
DI bf16x8 tr_frag(const LAS uchar* p, int rowstride) {
    const s16x4 lo = __builtin_bit_cast(s16x4, __builtin_amdgcn_ds_read_tr16_b64_v4i16((LAS s16x4*)p));
    const s16x4 hh = __builtin_bit_cast(s16x4, __builtin_amdgcn_ds_read_tr16_b64_v4i16((LAS s16x4*)(p + 8 * rowstride)));
    return __builtin_shufflevector(lo, hh, 0, 1, 2, 3, 4, 5, 6, 7);
}
DI void ssd_chunk_prologue(const Params& P, LAS uchar* lds, int cg, int g) {
    const int tid = threadIdx.x, lane = tid & 63, wave = tid >> 6;
    const bf16_t* xbc2 = (const bf16_t*)(P.ws + WS_XBC2); const float* dtg = (const float*)(P.ws + WS_DT);
    const int row0 = cg * 128, head = g * 8 + wave;
    __syncthreads();
#pragma unroll
    for (int k = 0; k < 2; ++k) { const int c = tid + 512 * k, row = c >> 3, c16 = c & 7;
        const bf16_t* src = xbc2 + (size_t)(row0 + row) * NXBC + 1024 + g * 64 + c16 * 8;
        *(LAS u32x4*)(lds + SSD_BT + row * BCROW + c16 * 16) = *(const u32x4*)src;
        *(LAS u32x4*)(lds + SSD_CT + row * BCROW + c16 * 16) = *(const u32x4*)(src + 128); }
    LAS float* arr = (LAS float*)(lds + SSD_WAVE + wave * SSD_WSZ + 8192);
    const float Af = -__expf(P.a_log_f[head]), Ab = -__expf(P.a_log_b[head]);
    const float df0 = dtg[(size_t)(row0 + lane) * 32 + head], df1 = dtg[(size_t)(row0 + 64 + lane) * 32 + head];
    const float db0 = dtg[(size_t)(row0 + lane) * 32 + 16 + head], db1 = dtg[(size_t)(row0 + 64 + lane) * 32 + 16 + head];
    float p0 = wave_incl_scan(Af * df0, lane); const float tot0 = __shfl(p0, 63); float p1 = wave_incl_scan(Af * df1, lane) + tot0;
    float q0 = wave_incl_scan(Ab * db0, lane); const float qt0 = __shfl(q0, 63); float q1 = wave_incl_scan(Ab * db1, lane) + qt0; const float qtot = __shfl(q1, 63);
    arr[lane] = df0; arr[64 + lane] = df1; arr[128 + lane] = db0; arr[192 + lane] = db1;
    arr[256 + lane] = p0; arr[320 + lane] = p1;
    arr[384 + lane] = qtot - q0 + Ab * db0; arr[448 + lane] = qtot - q1 + Ab * db1;
    __syncthreads();
}
DI void ssd_stage_x(const Params& P, LAS uchar* xb, int row0, int sb, int head, int lane) {
    const bf16_t* xbc2 = (const bf16_t*)(P.ws + WS_XBC2);
    u32x4 v[4];
#pragma unroll
    for (int i = 0; i < 4; ++i) { const int c = lane + 64 * i, row = c >> 3, c16 = c & 7; v[i] = *(const u32x4*)(xbc2 + (size_t)(row0 + 32 * sb + row) * NXBC + head * 64 + c16 * 8); }
#pragma unroll
    for (int i = 0; i < 4; ++i) { const int c = lane + 64 * i, row = c >> 3, c16 = c & 7; *(LAS u32x4*)(xb + row * 128 + c16 * 16) = v[i]; }
}
DI void p3_s1_states(const Params& P, LAS uchar* lds) {
    const int tid = threadIdx.x, lane = tid & 63, wave = tid >> 6, r32 = lane & 31, hi = lane >> 5;
    const int i16 = lane & 15, qq = i16 >> 2, pp = i16 & 3, blk = (lane >> 4) & 1;
    float* st = P.out; float* dec = (float*)(P.ws + WS_DEC);
    LAS uchar* xbuf = lds + SSD_WAVE + wave * SSD_WSZ; const LAS float* arr = (const LAS float*)(xbuf + 8192);
    for (int item = blockIdx.x; item < 1280; item += gridDim.x) {
        const int cg = item >> 1, g = item & 1, row0 = cg * 128, head = g * 8 + wave;
        ssd_chunk_prologue(P, lds, cg, g);
#pragma unroll 1
        for (int dir = 0; dir < 2; ++dir) {
            f32x16 acc[2][2];
#pragma unroll
            for (int a = 0; a < 2; ++a)
#pragma unroll
                for (int b = 0; b < 2; ++b)
#pragma unroll
                    for (int r = 0; r < 16; ++r) acc[a][b][r] = 0.f;
            const LAS float* dta = arr + dir * 128; const LAS float* cs = arr + 256 + dir * 128;
            const float wlast = dir == 0 ? cs[127] : cs[0];
#pragma unroll 1
            for (int sb = 0; sb < 4; ++sb) {
                LAS uchar* xb = xbuf + (sb & 1) * 4096;
                ssd_stage_x(P, xb, row0, sb, head, lane);
#pragma unroll
                for (int k2 = 0; k2 < 2; ++k2) {
                    const int sbase = 32 * sb + 16 * k2 + 4 * hi;
                    const f32x4 a0 = *(const LAS f32x4*)(cs + sbase), a1 = *(const LAS f32x4*)(cs + sbase + 8);
                    const f32x4 d0 = *(const LAS f32x4*)(dta + sbase), d1 = *(const LAS f32x4*)(dta + sbase + 8);
                    float w[8];
#pragma unroll
                    for (int j = 0; j < 4; ++j) { w[j] = __expf(wlast - a0[j]) * d0[j]; w[4 + j] = __expf(wlast - a1[j]) * d1[j]; }
                    bf16x8 xs[2];
#pragma unroll
                    for (int pb = 0; pb < 2; ++pb) {
                        const bf16x8 xf = tr_frag(xb + (16 * k2 + 4 * hi + qq) * 128 + (32 * pb + 16 * blk + 4 * pp) * 2, 128);
                        float f[8]; unpack8(__builtin_bit_cast(u32x4, xf), f);
#pragma unroll
                        for (int j = 0; j < 8; ++j) f[j] *= w[j];
                        xs[pb] = __builtin_bit_cast(bf16x8, pack8(f));
                    }
#pragma unroll
                    for (int nb = 0; nb < 2; ++nb) {
                        const bf16x8 bf = tr_frag(lds + SSD_BT + (32 * sb + 16 * k2 + 4 * hi + qq) * BCROW + (32 * nb + 16 * blk + 4 * pp) * 2, BCROW);
#pragma unroll
                        for (int pb = 0; pb < 2; ++pb) acc[pb][nb] = __builtin_amdgcn_mfma_f32_32x32x16_bf16(xs[pb], bf, acc[pb][nb], 0, 0, 0);
                    }
                }
            }
            float* so = st + ((size_t)(cg * 2 + dir) * 16 + head) * 4096;
#pragma unroll
            for (int pb = 0; pb < 2; ++pb)
#pragma unroll
                for (int nb = 0; nb < 2; ++nb)
#pragma unroll
                    for (int r = 0; r < 16; ++r) so[(32 * pb + (r & 3) + 8 * (r >> 2) + 4 * hi) * 64 + 32 * nb + r32] = acc[pb][nb][r];
            if (lane == 0) dec[(cg * 2 + dir) * 16 + head] = __expf(wlast);
        }
    }
}
DI void p3_s2_scan(const Params& P) {
    float* st = P.out; const float* dec = (const float*)(P.ws + WS_DEC);
    for (int e = blockIdx.x * 512 + threadIdx.x; e < 131072; e += gridDim.x * 512) {
        const int dir = e >> 16, dh = e >> 12;
        for (int seq = 0; seq < 33; ++seq) {
            const int c0 = seq * 16, nc = seq < 32 ? 16 : 128;
            float hp = 0.f;
            for (int b = 0; b < nc; b += 16) {
                float s[16], d[16];
#pragma unroll
                for (int i = 0; i < 16; ++i) { const int c = dir == 0 ? c0 + b + i : c0 + nc - 1 - b - i; s[i] = st[(size_t)c * 131072 + e]; d[i] = dec[c * 32 + dh]; }
#pragma unroll
                for (int i = 0; i < 16; ++i) { const float t = s[i]; s[i] = hp; hp = hp * d[i] + t; }
#pragma unroll
                for (int i = 0; i < 16; ++i) { const int c = dir == 0 ? c0 + b + i : c0 + nc - 1 - b - i; st[(size_t)c * 131072 + e] = s[i]; }
            }
        }
    }
}
DI void p3_s3_output(const Params& P, LAS uchar* lds) {
    const int tid = threadIdx.x, lane = tid & 63, wave = tid >> 6, r32 = lane & 31, hi = lane >> 5;
    const int i16 = lane & 15, qq = i16 >> 2, pp = i16 & 3, blk = (lane >> 4) & 1;
    const float* st = P.out; const bf16_t* zb = (const bf16_t*)(P.ws + WS_Z); bf16_t* mix = (bf16_t*)(P.ws + WS_MIX);
    LAS uchar* xbuf = lds + SSD_WAVE + wave * SSD_WSZ; const LAS float* arr = (const LAS float*)(xbuf + 8192);
    LAS float* red = (LAS float*)(lds + SSD_RED);
    for (int item = blockIdx.x; item < 1280; item += gridDim.x) {
        const int cg = item >> 1, g = item & 1, row0 = cg * 128, head = g * 8 + wave;
        ssd_chunk_prologue(P, lds, cg, g);
        const float Dk = P.d_skip[head];
        const float* Hf = st + ((size_t)(cg * 2 + 0) * 16 + head) * 4096; const float* Hb = st + ((size_t)(cg * 2 + 1) * 16 + head) * 4096;
#pragma unroll 1
        for (int tb = 0; tb < 4; ++tb) {
            const int t = 32 * tb + r32;
            const float af_t = arr[256 + t], rb_t = arr[384 + t];
            const float ef = __expf(af_t), eb = __expf(rb_t);
            bf16x8 cfr[4];
#pragma unroll
            for (int ks = 0; ks < 4; ++ks) cfr[ks] = *(const LAS bf16x8*)(lds + SSD_CT + t * BCROW + ks * 32 + hi * 16);
            f32x16 acc[2];
#pragma unroll
            for (int dir = 0; dir < 2; ++dir) {
                const float* H = dir == 0 ? Hf : Hb;
                f32x16 tmp[2];
#pragma unroll
                for (int pb = 0; pb < 2; ++pb)
#pragma unroll
                    for (int r = 0; r < 16; ++r) tmp[pb][r] = 0.f;
#pragma unroll
                for (int ks = 0; ks < 4; ++ks)
#pragma unroll
                    for (int pb = 0; pb < 2; ++pb) {
                        const float* hp = H + (32 * pb + r32) * 64 + 16 * ks + 8 * hi;
                        const f32x4 h0 = *(const f32x4*)hp, h1 = *(const f32x4*)(hp + 4);
                        u32x4 w; w.x = pk2(h0[0], h0[1]); w.y = pk2(h0[2], h0[3]); w.z = pk2(h1[0], h1[1]); w.w = pk2(h1[2], h1[3]);
                        tmp[pb] = __builtin_amdgcn_mfma_f32_32x32x16_bf16(__builtin_bit_cast(bf16x8, w), cfr[ks], tmp[pb], 0, 0, 0);
                    }
                const float e = dir == 0 ? ef : eb;
#pragma unroll
                for (int pb = 0; pb < 2; ++pb)
#pragma unroll
                    for (int r = 0; r < 16; ++r) acc[pb][r] = dir == 0 ? e * tmp[pb][r] : acc[pb][r] + e * tmp[pb][r];
            }
#pragma unroll 1
            for (int sb = 0; sb < 4; ++sb) {
                LAS uchar* xb = xbuf + (sb & 1) * 4096;
                ssd_stage_x(P, xb, row0, sb, head, lane);
                f32x16 X;
#pragma unroll
                for (int r = 0; r < 16; ++r) X[r] = 0.f;
#pragma unroll
                for (int ks = 0; ks < 4; ++ks) {
                    const bf16x8 bfa = *(const LAS bf16x8*)(lds + SSD_BT + (32 * sb + r32) * BCROW + ks * 32 + hi * 16);
                    X = __builtin_amdgcn_mfma_f32_32x32x16_bf16(bfa, cfr[ks], X, 0, 0, 0);
                }
#pragma unroll
                for (int gq = 0; gq < 4; ++gq) {
                    const int s0 = 32 * sb + 8 * gq + 4 * hi;
                    const f32x4 dfv = *(const LAS f32x4*)(arr + s0), dbv = *(const LAS f32x4*)(arr + 128 + s0);
                    const f32x4 afv = *(const LAS f32x4*)(arr + 256 + s0), rbv = *(const LAS f32x4*)(arr + 384 + s0);
#pragma unroll
                    for (int j = 0; j < 4; ++j) {
                        const int s = s0 + j;
                        float coef = 0.f;
                        if (s <= t) coef = __expf(af_t - afv[j]) * dfv[j];
                        if (s >= t) coef += __expf(rb_t - rbv[j]) * dbv[j];
                        float v = X[4 * gq + j] * coef;
                        if (s == t) v += Dk;
                        X[4 * gq + j] = v;
                    }
                }
#pragma unroll
                for (int s2 = 0; s2 < 2; ++s2) {
                    u32x4 pw;
                    if (s2 == 0) { pw.x = pk2(X[0], X[1]); pw.y = pk2(X[2], X[3]); pw.z = pk2(X[4], X[5]); pw.w = pk2(X[6], X[7]); }
                    else { pw.x = pk2(X[8], X[9]); pw.y = pk2(X[10], X[11]); pw.z = pk2(X[12], X[13]); pw.w = pk2(X[14], X[15]); }
                    const bf16x8 pbk = __builtin_bit_cast(bf16x8, pw);
#pragma unroll
                    for (int pb = 0; pb < 2; ++pb) {
                        const bf16x8 xf = tr_frag(xb + (16 * s2 + 4 * hi + qq) * 128 + (32 * pb + 16 * blk + 4 * pp) * 2, 128);
                        acc[pb] = __builtin_amdgcn_mfma_f32_32x32x16_bf16(xf, pbk, acc[pb], 0, 0, 0);
                    }
                }
            }
            const int row = row0 + t; const int cbase = g * 512 + wave * 64;
            float ssum = 0.f;
#pragma unroll
            for (int pb = 0; pb < 2; ++pb)
#pragma unroll
                for (int gq = 0; gq < 4; ++gq) {
                    const int p0 = 32 * pb + 8 * gq + 4 * hi;
                    const u32x2 zw = *(const u32x2*)(zb + (size_t)row * DM + cbase + p0);
                    const float z0 = __uint_as_float(zw.x << 16), z1 = __uint_as_float(zw.x & 0xffff0000u), z2 = __uint_as_float(zw.y << 16), z3 = __uint_as_float(zw.y & 0xffff0000u);
                    float v0 = acc[pb][4 * gq] * silu(z0), v1 = acc[pb][4 * gq + 1] * silu(z1), v2 = acc[pb][4 * gq + 2] * silu(z2), v3 = acc[pb][4 * gq + 3] * silu(z3);
                    acc[pb][4 * gq] = v0; acc[pb][4 * gq + 1] = v1; acc[pb][4 * gq + 2] = v2; acc[pb][4 * gq + 3] = v3;
                    ssum += (v0 * v0 + v1 * v1) + (v2 * v2 + v3 * v3);
                }
            ssum += __shfl_xor(ssum, 32);
            LAS float* rd = red + (tb & 1) * 256;
            if (hi == 0) rd[wave * 32 + r32] = ssum;
            __syncthreads();
            float tot = 0.f;
#pragma unroll
            for (int w = 0; w < 8; ++w) tot += rd[w * 32 + r32];
            const float rs = rsqrtf(tot * (1.f / 512.f) + EPS);
#pragma unroll
            for (int pb = 0; pb < 2; ++pb)
#pragma unroll
                for (int gq = 0; gq < 4; ++gq) {
                    const int p0 = 32 * pb + 8 * gq + 4 * hi;
                    const f32x4 nw = *(const f32x4*)(P.ssm_norm + cbase + p0);
                    u32x2 o; o.x = pk2(acc[pb][4 * gq] * rs * nw[0], acc[pb][4 * gq + 1] * rs * nw[1]); o.y = pk2(acc[pb][4 * gq + 2] * rs * nw[2], acc[pb][4 * gq + 3] * rs * nw[3]);
                    *(u32x2*)(mix + (size_t)row * 2048 + 1024 + cbase + p0) = o;
                }
        }
    }
}

constexpr int KROW = 208, VROW = 192, KTILE = 64 * KROW, VTILE = 64 * VROW;
DI void attn_unit(const Params& P, LAS uchar* lds, int rowbase, int L, int h, int qb) {
    const int tid = threadIdx.x, lane = tid & 63, wid = tid >> 6, r32 = lane & 31, hi = lane >> 5;
    const bf16_t* qbuf = (const bf16_t*)P.out; const bf16_t* kvb = (const bf16_t*)(P.ws + WS_KV); const bf16_t* lat = (const bf16_t*)(P.ws + WS_LAT);
    bf16_t* mix = (bf16_t*)(P.ws + WS_MIX);
    const int qrow = rowbase + qb * 256 + wid * 32 + r32;
    bf16x8 qf[6];
    { const bf16_t* Qg = qbuf + (size_t)qrow * NQ;
#pragma unroll
      for (int ks = 0; ks < 4; ++ks) qf[ks] = *(const bf16x8*)(Qg + h * 64 + ks * 16 + hi * 8);
#pragma unroll
      for (int ks = 0; ks < 2; ++ks) { float f[8], o[8]; unpack8(*(const u32x4*)(Qg + 1024 + h * 32 + ks * 16 + hi * 8), f);
          const float* tp = (const float*)(P.ws + WS_TAB) + ((size_t)(qrow - rowbase) * 16 + 8 * ks + 4 * hi) * 2;
          const f32x4 c0 = *(const f32x4*)tp, c1 = *(const f32x4*)(tp + 4);
          o[0] = f[0] * c0[0] - f[1] * c0[1]; o[1] = f[1] * c0[0] + f[0] * c0[1]; o[2] = f[2] * c0[2] - f[3] * c0[3]; o[3] = f[3] * c0[2] + f[2] * c0[3];
          o[4] = f[4] * c1[0] - f[5] * c1[1]; o[5] = f[5] * c1[0] + f[4] * c1[1]; o[6] = f[6] * c1[2] - f[7] * c1[3]; o[7] = f[7] * c1[2] + f[6] * c1[3];
          qf[4 + ks] = __builtin_bit_cast(bf16x8, pack8(o)); } }
    LAS uchar* Kb0 = lds; LAS uchar* Vb0 = lds + 2 * KTILE;
    const int skey = tid >> 3, sch = tid & 7, rkey = (tid >> 2) & 63, rch = tid & 3;
    const bf16_t* kn_src = kvb + (size_t)(rowbase + skey) * NKV + h * 64 + sch * 8;
    const bf16_t* v_src = kn_src + 1024;
    const bf16_t* kr_src = lat + (size_t)(rowbase + rkey) * NLAT + 640 + rch * 8;
    u32x4 rkn, rv, rkr;
    rkn = *(const u32x4*)kn_src; rv = *(const u32x4*)v_src; if (tid < 256) rkr = *(const u32x4*)kr_src;
    *(LAS u32x4*)(Kb0 + skey * KROW + sch * 16) = rkn; *(LAS u32x4*)(Vb0 + skey * VROW + sch * 16) = rv; if (tid < 256) *(LAS u32x4*)(Kb0 + rkey * KROW + 128 + rch * 16) = rkr;
    __syncthreads();
    float mrun = -1e30f, lrun = 0.f; f32x16 o0, o1;
#pragma unroll
    for (int r = 0; r < 16; ++r) { o0[r] = 0.f; o1[r] = 0.f; }
    const int NT = L / 64;
    const int i16 = lane & 15, qq = i16 >> 2, pp = i16 & 3, blk = (lane >> 4) & 1;
    const int vtr_off = (4 * hi + qq) * VROW + (16 * blk + 4 * pp) * 2;
    for (int kt = 0; kt < NT; ++kt) {
        const int cur = kt & 1;
        if (kt + 1 < NT) { const size_t adv = (size_t)(kt + 1) * 64; rkn = *(const u32x4*)(kn_src + adv * NKV); rv = *(const u32x4*)(v_src + adv * NKV); if (tid < 256) rkr = *(const u32x4*)(kr_src + adv * NLAT); }
        const LAS uchar* Kb = Kb0 + cur * KTILE; const LAS uchar* Vb = Vb0 + cur * VTILE;
        f32x16 p0, p1;
#pragma unroll
        for (int r = 0; r < 16; ++r) { p0[r] = 0.f; p1[r] = 0.f; }
#pragma unroll
        for (int ks = 0; ks < 6; ++ks) {
            const bf16x8 k0 = *(const LAS bf16x8*)(Kb + r32 * KROW + ks * 32 + hi * 16);
            const bf16x8 k1 = *(const LAS bf16x8*)(Kb + (32 + r32) * KROW + ks * 32 + hi * 16);
            p0 = __builtin_amdgcn_mfma_f32_32x32x16_bf16(k0, qf[ks], p0, 0, 0, 0);
            p1 = __builtin_amdgcn_mfma_f32_32x32x16_bf16(k1, qf[ks], p1, 0, 0, 0);
        }
        float mx = fmaxf(p0[0], p1[0]);
#pragma unroll
        for (int r = 1; r < 16; ++r) mx = fmaxf(mx, fmaxf(p0[r], p1[r]));
        mx = fmaxf(mx, __shfl_xor(mx, 32));
        const float mnew = fmaxf(mrun, mx);
        if (__any(mnew > mrun)) { const float al = __builtin_amdgcn_exp2f(mrun - mnew); lrun *= al;
#pragma unroll
            for (int r = 0; r < 16; ++r) { o0[r] *= al; o1[r] *= al; } }
        mrun = mnew;
        float ls = 0.f;
#pragma unroll
        for (int r = 0; r < 16; ++r) { p0[r] = __builtin_amdgcn_exp2f(p0[r] - mnew); p1[r] = __builtin_amdgcn_exp2f(p1[r] - mnew); ls += p0[r] + p1[r]; }
        lrun += ls;
#pragma unroll
        for (int s = 0; s < 4; ++s) {
            u32x4 pw;
            if (s == 0) { pw.x = pk2(p0[0], p0[1]); pw.y = pk2(p0[2], p0[3]); pw.z = pk2(p0[4], p0[5]); pw.w = pk2(p0[6], p0[7]); }
            else if (s == 1) { pw.x = pk2(p0[8], p0[9]); pw.y = pk2(p0[10], p0[11]); pw.z = pk2(p0[12], p0[13]); pw.w = pk2(p0[14], p0[15]); }
            else if (s == 2) { pw.x = pk2(p1[0], p1[1]); pw.y = pk2(p1[2], p1[3]); pw.z = pk2(p1[4], p1[5]); pw.w = pk2(p1[6], p1[7]); }
            else { pw.x = pk2(p1[8], p1[9]); pw.y = pk2(p1[10], p1[11]); pw.z = pk2(p1[12], p1[13]); pw.w = pk2(p1[14], p1[15]); }
            const bf16x8 pb = __builtin_bit_cast(bf16x8, pw);
#pragma unroll
            for (int db = 0; db < 2; ++db) {
                const LAS uchar* vp = Vb + vtr_off + s * 16 * VROW + db * 64;
                const s16x4 lo = __builtin_bit_cast(s16x4, __builtin_amdgcn_ds_read_tr16_b64_v4i16((LAS s16x4*)vp));
                const s16x4 hh = __builtin_bit_cast(s16x4, __builtin_amdgcn_ds_read_tr16_b64_v4i16((LAS s16x4*)(vp + 8 * VROW)));
                const bf16x8 va = __builtin_shufflevector(lo, hh, 0, 1, 2, 3, 4, 5, 6, 7);
                if (db == 0) o0 = __builtin_amdgcn_mfma_f32_32x32x16_bf16(va, pb, o0, 0, 0, 0);
                else o1 = __builtin_amdgcn_mfma_f32_32x32x16_bf16(va, pb, o1, 0, 0, 0);
            }
        }
        if (kt + 1 < NT) { LAS uchar* Kn = Kb0 + (cur ^ 1) * KTILE; LAS uchar* Vn = Vb0 + (cur ^ 1) * VTILE;
            *(LAS u32x4*)(Kn + skey * KROW + sch * 16) = rkn; *(LAS u32x4*)(Vn + skey * VROW + sch * 16) = rv; if (tid < 256) *(LAS u32x4*)(Kn + rkey * KROW + 128 + rch * 16) = rkr; }
        __syncthreads();
    }
    const float ltot = lrun + __shfl_xor(lrun, 32); const float inv = 1.f / ltot;
    bf16_t* op = mix + (size_t)qrow * 2048 + h * 64 + 4 * hi;
#pragma unroll
    for (int g = 0; g < 4; ++g) {
        u32x2 w0, w1;
        w0.x = pk2(o0[4 * g] * inv, o0[4 * g + 1] * inv); w0.y = pk2(o0[4 * g + 2] * inv, o0[4 * g + 3] * inv);
        w1.x = pk2(o1[4 * g] * inv, o1[4 * g + 1] * inv); w1.y = pk2(o1[4 * g + 2] * inv, o1[4 * g + 3] * inv);
        *(u32x2*)(op + 8 * g) = w0; *(u32x2*)(op + 32 + 8 * g) = w1;
    }
}
DI void p5_attention(const Params& P, LAS uchar* lds) {
    const int G = gridDim.x, bx = blockIdx.x; const int vcu = (G % 8 == 0) ? (bx % 8) * (G / 8) + bx / 8 : bx;
    const int perS = (1024 + G - 1) / G, perP = (4096 + G - 1) / G;
    for (int i = 0; i < perS; ++i) { const int s = vcu * perS + i; if (s < 1024) attn_unit(P, lds, TP, LS, s >> 6, s & 63); }
    for (int i = 0; i < perP; ++i) { const int s = vcu * perP + i; if (s < 4096) { const int b = s >> 7, rem = s & 127; attn_unit(P, lds, b * LP, LP, rem >> 3, rem & 7); } }
}

DI void p8_act(const Params& P, int rows, int row_off) {
    const int gt = blockIdx.x * 512 + threadIdx.x, NGT = gridDim.x * 512;
    const bf16_t* g = (const bf16_t*)(P.ws + WS_G); bf16_t* uo = (bf16_t*)(P.ws + WS_U);
    for (int idx = gt; idx < rows * 352; idx += NGT) {
        const int lrow = idx / 352, c0 = (idx - lrow * 352) * 8; const int row = row_off + lrow; const int pos = posof(row), L = lenof(row);
        float cur[8], prv[8], nxt[8], uu[8];
        unpack8(*(const u32x4*)(g + (size_t)lrow * DFF + c0), cur); unpack8(*(const u32x4*)(uo + (size_t)lrow * DFF + c0), uu);
        if (pos > 0) unpack8(*(const u32x4*)(g + (size_t)(lrow - 1) * DFF + c0), prv); else {
#pragma unroll
            for (int j = 0; j < 8; ++j) prv[j] = 0.f; }
        if (pos < L - 1) unpack8(*(const u32x4*)(g + (size_t)(lrow + 1) * DFF + c0), nxt); else {
#pragma unroll
            for (int j = 0; j < 8; ++j) nxt[j] = 0.f; }
        float o[8];
#pragma unroll
        for (int j = 0; j < 8; ++j) { const float v = P.ffn_conv_w[c0 + j] * prv[j] + P.ffn_conv_w[DFF + c0 + j] * cur[j] + P.ffn_conv_w[2 * DFF + c0 + j] * nxt[j] + P.ffn_conv_b[c0 + j]; o[j] = silu(v) * uu[j]; }
        *(u32x4*)(uo + (size_t)lrow * DFF + c0) = pack8(o);
    }
}
DI void p_final(const Params& P) {
    const int gt = blockIdx.x * 512 + threadIdx.x, NGT = gridDim.x * 512;
    const float* ss2 = (const float*)(P.ws + WS_SS) + T;
    for (int idx = gt; idx < T * 256; idx += NGT) { const int row = idx >> 8, c4 = idx & 255;
        const float rs = rsqrtf(ss2[row] * (1.f / DM) + EPS); const f32x4 w = ((const f32x4*)P.final_norm)[c4];
        f32x4 v = ((f32x4*)P.out)[idx]; v = v * rs * w; ((f32x4*)P.out)[idx] = v; }
}

constexpr int LDS_BYTES = 147456;
template <class Epi> DI void run_gemm(LAS uchar* lds, const bf16_t* A, int lda, const bf16_t* Bt, int M, int N, int K, const Epi& E) {
    pg8::Gemm g{A, Bt, M, N, K, lda}; pg8::StaticOrder S; S.init(M, N, (int)gridDim.x, (int)blockIdx.x);
    pg8::gemm_phase<Epi, pg8::StaticOrder, true, true>(lds, g, S, E);
}
__global__ void __launch_bounds__(512, 2) mega(Params P) {
    extern __shared__ __attribute__((aligned(16))) uchar lds_[];
    LAS uchar* lds = (LAS uchar*)lds_;
    cg::grid_group grid = cg::this_grid();
    uchar* ws = P.ws;
    bf16_t* lat = (bf16_t*)(ws + WS_LAT); float* ss = (float*)(ws + WS_SS);
    p0_prologue(P, lds);
    grid.sync();
    { EpiIn E{(bf16_t*)(ws + WS_Z), (bf16_t*)(ws + WS_XBC), lat, (float*)(ws + WS_DT)};
      run_gemm(lds, (const bf16_t*)(ws + WS_H), DM, (const bf16_t*)(ws + WS_WIN), T, DINP, DM, E); }
    grid.sync();
    p2_prep(P);
    grid.sync();
    p3_s1_states(P, lds);
    grid.sync();
    p3_s2_scan(P);
    grid.sync();
    p3_s3_output(P, lds);
    grid.sync();
    { EpiPlain E{(bf16_t*)P.out, NQ, QSCALE};
      run_gemm(lds, lat, NLAT, (const bf16_t*)(ws + WS_WQB), T, NQ, 384, E); }
    __syncthreads();
    { EpiPlain E{(bf16_t*)(ws + WS_KV), NKV, 1.0f};
      run_gemm(lds, lat + 384, NLAT, (const bf16_t*)(ws + WS_WKVB), T, NKV, 256, E); }
    grid.sync();
    p5_attention(P, lds);
    grid.sync();
    { EpiRes E{P.xp, P.xs, P.out, (bf16_t*)(ws + WS_X1B), ss, 0};
      run_gemm(lds, (const bf16_t*)(ws + WS_MIX), 2048, (const bf16_t*)(ws + WS_WOUT), T, DM, 2048, E); }
    grid.sync();
#pragma unroll 1
    for (int ch = 0; ch < 2; ++ch) {
        const int r0 = ch == 0 ? 0 : CH0_ROWS, rows = ch == 0 ? CH0_ROWS : CH1_ROWS;
        { EpiGU E{(bf16_t*)(ws + WS_G), (bf16_t*)(ws + WS_U), ss, r0};
          run_gemm(lds, (const bf16_t*)(ws + WS_X1B) + (size_t)r0 * DM, DM, (const bf16_t*)(ws + WS_WGU), rows, NGU, DM, E); }
        grid.sync();
        p8_act(P, rows, r0);
        grid.sync();
        { EpiRes E{P.out, P.out + (size_t)TP * DM, P.out, nullptr, ss + T, r0};
          run_gemm(lds, (const bf16_t*)(ws + WS_U), DFF, (const bf16_t*)(ws + WS_WDN), rows, DM, DFF, E); }
        grid.sync();
    }
    p_final(P);
}

extern "C" void kernel_launch(void* const* d_in, const int* in_sizes, int n_in, void* d_out, int out_size, void* d_ws, size_t ws_size, hipStream_t stream) {
    static int grid = 0;
    if (grid == 0) {
        int dev = 0, cus = 0, per_cu = 0;
        hipGetDevice(&dev); hipDeviceGetAttribute(&cus, hipDeviceAttributeMultiprocessorCount, dev);
        hipFuncSetAttribute((const void*)mega, hipFuncAttributeMaxDynamicSharedMemorySize, LDS_BYTES);
        if (hipOccupancyMaxActiveBlocksPerMultiprocessor(&per_cu, (const void*)mega, 512, LDS_BYTES) != hipSuccess || per_cu < 1) per_cu = 1;
        (void)hipGetLastError();
        grid = cus * per_cu;
        if (ws_size < 1020 * MiB) fprintf(stderr, "kernel_launch: workspace too small: %zu\n", ws_size);
    }
    Params p{};
    const float** pf = (const float**)&p;
    for (int i = 0; i < 24; ++i) pf[i] = (const float*)d_in[i];
    p.out = (float*)d_out; p.ws = (uchar*)d_ws;
    void* args[] = {&p};
    hipError_t e = hipLaunchCooperativeKernel((const void*)mega, dim3(grid), dim3(512), args, LDS_BYTES, stream);
    if (e != hipSuccess) fprintf(stderr, "cooperative launch failed: %s (grid %d)\n", hipGetErrorString(e), grid);
}
```

```cpp
#include <hip/hip_runtime.h>
#include <hip/hip_cooperative_groups.h>
#include <cstdio>
#include <cstdint>
namespace cg = cooperative_groups;
namespace pg8 {
#define PG8_LAS __attribute__((address_space(3)))
typedef unsigned short bf16_t;
typedef short bf16x8 __attribute__((ext_vector_type(8)));
typedef float f32x4 __attribute__((ext_vector_type(4)));
typedef unsigned u32x4 __attribute__((ext_vector_type(4)));
constexpr int BM = 256, BK = 64, HALF = 128, HTB = HALF * BK * 2  , STAGE_BYTES = 8 * HTB, NXCD = 8, WGM = 8;
__host__ __device__ __forceinline__ int lds_byte(int r, int c) { const int st = (r >> 4) * 2 + (c >> 5), rr = r & 15, cc = c & 31, ob = rr * 64 + cc * 2; return st * 1024 + (ob ^ (((ob >> 9) & 1) << 5)); }
__host__ __device__ __forceinline__ void stage_rc(int b, int& R, int& C) { const int st = b / 1024, sb = b % 1024, swz = sb ^ (((sb >> 9) & 1) << 5); R = (st >> 1) * 16 + swz / 64; C = (st & 1) * 32 + (swz % 64) / 2; }
__host__ __device__ __forceinline__ int perm32(int rho) { const int n = rho >> 4, i = rho & 15; return 8 * (i >> 2) + 4 * n + (i & 3); }
struct Unit { int pm, pn; };
struct Gemm { const bf16_t* A; const bf16_t* Bt; int M, N, K, lda; };
struct StaticOrder {
    int nM, nN, nwg, G, c;
    __host__ __device__ void init(int M, int N, int G_, int c_) { nM = M / BM; nN = N / BM; nwg = nM * nN; G = G_; c = c_; }
    __host__ __device__ bool next(int i, Unit& u) const {
        const long L = (long)i * G + c; if (L >= nwg) return false;
        int wgid = (int)L; { const int q = nwg / NXCD, r = nwg % NXCD, xcd = wgid % NXCD, off = wgid / NXCD; wgid = (xcd < r ? xcd * (q + 1) : r * (q + 1) + (xcd - r) * q) + off; }
        const int nig = WGM * nN, gid = wgid / nig, fm = gid * WGM, gsz = (nM - fm) < WGM ? (nM - fm) : WGM;
        u.pm = fm + ((wgid % nig) % gsz); u.pn = (wgid % nig) / gsz; return true;
    }
    __device__ __forceinline__ void a_ready(const Unit&) const {}
    __device__ __forceinline__ void done(const Unit&) const {}
};
template <class Epi, class Sched, bool ALIGN_EPI = false, bool SP2 = false>
__device__ __forceinline__ void gemm_phase(PG8_LAS unsigned char* lds, const Gemm g, const Sched& S, const Epi& E) {
    int tid_ = threadIdx.x; asm volatile("" : "+v"(tid_)); const int tid = tid_, wid = __builtin_amdgcn_readfirstlane(tid >> 6), lane = tid & 63, wr = wid >> 2, wc = wid & 3, fr = lane & 15, fq = lane >> 4;
    const int K = g.K, nt = K / BK;
    unsigned voffA[2], voffB[2];
#pragma unroll
    for (int i = 0; i < 2; ++i) { int R, C; stage_rc(tid * 16 + i * 8192, R, C); const int Rb = Epi::PERM ? ((R & ~31) + perm32(R & 31)) : R;
        voffA[i] = (unsigned)(R * g.lda + C) * 2u; voffB[i] = (unsigned)(Rb * K + C) * 2u; }
    const size_t kstep = (size_t)(BK * 2);
    const size_t hstepB = (size_t)HALF * K * 2, hstepA = (size_t)HALF * g.lda * 2;
    const size_t tstepA = 2 * hstepA, tstepB = 2 * hstepB;
    const unsigned ldsw = (unsigned)wid * 1024u;
    const int aoff = lds_byte(wr * 64 + fr, fq * 8), boff = lds_byte(wc * 32 + fr, fq * 8);
#define PG8_SA(b, h) (((b) * 2 + (h)) * HTB)
#define PG8_SB(b, h) ((4 + (b) * 2 + (h)) * HTB)
#define PG8_STAGE(bufoff, gbase, voff) do { _Pragma("unroll") for (int _i = 0; _i < 2; ++_i) \
        __builtin_amdgcn_global_load_lds((const unsigned*)((const char*)(gbase) + (voff)[_i]), (PG8_LAS unsigned*)(lds + (bufoff) + ldsw + _i * 8192), 16, 0, 0); } while (0)
#define PG8_LDA(dst, b, h) do { _Pragma("unroll") for (int m = 0; m < 4; ++m) _Pragma("unroll") for (int k = 0; k < 2; ++k) dst[m][k] = *(const PG8_LAS bf16x8*)(lds + PG8_SA(b, h) + aoff + m * 2048 + k * 1024); } while (0)
#define PG8_LDB(dst, b, h) do { _Pragma("unroll") for (int n = 0; n < 2; ++n) _Pragma("unroll") for (int k = 0; k < 2; ++k) dst[n][k] = *(const PG8_LAS bf16x8*)(lds + PG8_SB(b, h) + boff + n * 2048 + k * 1024); } while (0)
#define PG8_MMA(ai, bj, At, Bt) do { __builtin_amdgcn_s_setprio(1); _Pragma("unroll") for (int m = 0; m < 4; ++m) _Pragma("unroll") for (int n = 0; n < 2; ++n) _Pragma("unroll") for (int k = 0; k < 2; ++k) \
        acc[ai][bj][m][n] = __builtin_amdgcn_mfma_f32_16x16x32_bf16(Bt[n][k], At[m][k], acc[ai][bj][m][n], 0, 0, 0); __builtin_amdgcn_s_setprio(0); } while (0)
#define PG8_WAIT_V(n) asm volatile("s_waitcnt vmcnt(" #n ")" ::: "memory")
#define PG8_WAIT_L(n) asm volatile("s_waitcnt lgkmcnt(" #n ")" ::: "memory")
#define PG8_BAR __builtin_amdgcn_s_barrier()
#define PG8_SCHED __builtin_amdgcn_sched_barrier(0)
    Unit cur, nxt; int ui = 0;
    if (!S.next(0, cur)) return;
    f32x4 acc[2][2][4][2];
#pragma unroll
    for (int a = 0; a < 2; ++a)
#pragma unroll
        for (int b = 0; b < 2; ++b)
#pragma unroll
            for (int m = 0; m < 4; ++m)
#pragma unroll
                for (int n = 0; n < 2; ++n) acc[a][b][m][n] = (f32x4){0.f, 0.f, 0.f, 0.f};
    bf16x8 At[4][2], B0[2][2], B1[2][2];
    const char* cA = (const char*)g.A + (size_t)cur.pm * tstepA; const char* cB = (const char*)g.Bt + (size_t)cur.pn * tstepB;
    S.a_ready(cur);
    if constexpr (SP2) {
        PG8_STAGE(PG8_SB(0, 0), cB, voffB); PG8_STAGE(PG8_SB(0, 1), cB + hstepB, voffB); PG8_STAGE(PG8_SA(0, 0), cA, voffA); PG8_STAGE(PG8_SA(0, 1), cA + hstepA, voffA);
        if (wr == 1) PG8_BAR;
        PG8_WAIT_V(2); PG8_BAR;
        PG8_STAGE(PG8_SB(1, 0), cB + kstep, voffB); PG8_STAGE(PG8_SA(1, 0), cA + kstep, voffA); PG8_STAGE(PG8_SB(1, 1), cB + hstepB + kstep, voffB);
        PG8_WAIT_V(6); PG8_BAR;
    } else {
        PG8_STAGE(PG8_SB(0, 0), cB, voffB); PG8_STAGE(PG8_SA(0, 0), cA, voffA); PG8_STAGE(PG8_SB(0, 1), cB + hstepB, voffB); PG8_STAGE(PG8_SA(0, 1), cA + hstepA, voffA);
        if (wr == 1) PG8_BAR;
        PG8_WAIT_V(4); PG8_BAR;
        PG8_STAGE(PG8_SB(1, 0), cB + kstep, voffB); PG8_STAGE(PG8_SA(1, 0), cA + kstep, voffA); PG8_STAGE(PG8_SB(1, 1), cB + hstepB + kstep, voffB);
        PG8_WAIT_V(6); PG8_BAR;
    }
    for (;;) {
        const bool has_next = S.next(ui + 1, nxt);
        const char* nA = has_next ? (const char*)g.A + (size_t)nxt.pm * tstepA : cA; const char* nB = has_next ? (const char*)g.Bt + (size_t)nxt.pn * tstepB : cB;
        for (int t = 0; t < nt; t += 2) {
            const bool last = (t == nt - 2);
            const char* a1 = cA + (size_t)(t + 1) * kstep;
            const char* a2 = last ? nA : cA + (size_t)(t + 2) * kstep; const char* b2 = last ? nB : cB + (size_t)(t + 2) * kstep;
            const char* a3 = a2 + kstep; const char* b3 = b2 + kstep;
            if (last && has_next) S.a_ready(nxt);
            if constexpr (SP2) {
            PG8_LDB(B0, 0, 0); PG8_LDB(B1, 0, 1); PG8_SCHED; PG8_LDA(At, 0, 0); PG8_STAGE(PG8_SA(1, 1), a1 + hstepA, voffA);
            PG8_WAIT_V(8); PG8_WAIT_L(0); PG8_BAR; PG8_MMA(0, 0, At, B0); PG8_MMA(0, 1, At, B1); PG8_BAR; PG8_SCHED;
            PG8_LDA(At, 0, 1); PG8_STAGE(PG8_SB(0, 0), b2, voffB); PG8_STAGE(PG8_SB(0, 1), b2 + hstepB, voffB); PG8_STAGE(PG8_SA(0, 0), a2, voffA);
            PG8_WAIT_V(8); PG8_WAIT_L(0); PG8_BAR; PG8_MMA(1, 0, At, B0); PG8_MMA(1, 1, At, B1); PG8_BAR; PG8_SCHED;
            PG8_LDB(B0, 1, 0); PG8_LDB(B1, 1, 1); PG8_SCHED; PG8_LDA(At, 1, 0); PG8_STAGE(PG8_SA(0, 1), a2 + hstepA, voffA);
            PG8_WAIT_V(8); PG8_WAIT_L(0); PG8_BAR; PG8_MMA(0, 0, At, B0); PG8_MMA(0, 1, At, B1); PG8_BAR; PG8_SCHED;
            PG8_LDA(At, 1, 1); PG8_STAGE(PG8_SB(1, 0), b3, voffB); PG8_STAGE(PG8_SB(1, 1), b3 + hstepB, voffB); PG8_STAGE(PG8_SA(1, 0), a3, voffA);
            PG8_WAIT_V(8); PG8_WAIT_L(0); PG8_BAR; PG8_MMA(1, 0, At, B0); PG8_MMA(1, 1, At, B1); PG8_BAR; PG8_SCHED;
            } else {
            PG8_LDB(B0, 0, 0); PG8_SCHED; PG8_LDA(At, 0, 0); PG8_STAGE(PG8_SA(1, 1), a1 + hstepA, voffA);
            PG8_WAIT_L(8); PG8_BAR; PG8_WAIT_L(0); PG8_MMA(0, 0, At, B0); PG8_BAR; PG8_SCHED;
            PG8_LDB(B1, 0, 1); PG8_STAGE(PG8_SB(0, 0), b2, voffB);
            PG8_BAR; PG8_WAIT_L(0); PG8_MMA(0, 1, At, B1); PG8_BAR;
            PG8_LDA(At, 0, 1); PG8_STAGE(PG8_SA(0, 0), a2, voffA);
            PG8_BAR; PG8_WAIT_L(0); PG8_MMA(1, 0, At, B0); PG8_BAR; PG8_SCHED;
            PG8_STAGE(PG8_SB(0, 1), b2 + hstepB, voffB);
            PG8_WAIT_V(6); PG8_BAR; PG8_MMA(1, 1, At, B1); PG8_BAR;
            PG8_LDB(B0, 1, 0); PG8_SCHED; PG8_LDA(At, 1, 0); PG8_STAGE(PG8_SA(0, 1), a2 + hstepA, voffA);
            PG8_WAIT_L(8); PG8_BAR; PG8_WAIT_L(0); PG8_MMA(0, 0, At, B0); PG8_BAR; PG8_SCHED;
            PG8_LDB(B1, 1, 1); PG8_STAGE(PG8_SB(1, 0), b3, voffB);
            PG8_BAR; PG8_WAIT_L(0); PG8_MMA(0, 1, At, B1); PG8_BAR;
            PG8_LDA(At, 1, 1); PG8_STAGE(PG8_SA(1, 0), a3, voffA);
            PG8_BAR; PG8_WAIT_L(0); PG8_MMA(1, 0, At, B0); PG8_BAR; PG8_SCHED;
            PG8_STAGE(PG8_SB(1, 1), b3 + hstepB, voffB);
            PG8_WAIT_V(6); PG8_BAR; PG8_MMA(1, 1, At, B1); PG8_BAR;
            }
        }
        if constexpr (ALIGN_EPI) { if (wr == 0) PG8_BAR; }
        if constexpr (!Epi::AFTER_DRAIN) { E(acc, cur, wr, wc, fr, fq); S.done(cur); }
        if (!has_next) break;
#pragma unroll
        for (int a = 0; a < 2; ++a)
#pragma unroll
            for (int b = 0; b < 2; ++b)
#pragma unroll
                for (int m = 0; m < 4; ++m)
#pragma unroll
                    for (int n = 0; n < 2; ++n) acc[a][b][m][n] = (f32x4){0.f, 0.f, 0.f, 0.f};
        cur = nxt; cA = nA; cB = nB; ++ui;
        if constexpr (ALIGN_EPI) { if (wr == 1) PG8_BAR; }
    }
    PG8_WAIT_V(0);
    if constexpr (!ALIGN_EPI) { if (wr == 0) PG8_BAR; }
    PG8_BAR;
    if constexpr (Epi::AFTER_DRAIN) { E.fused(acc, cur, wr, wc, fr, fq, lds, wid, lane); S.done(cur); }
#undef PG8_SA
#undef PG8_SB
#undef PG8_STAGE
#undef PG8_LDA
#undef PG8_LDB
#undef PG8_MMA
#undef PG8_WAIT_V
#undef PG8_WAIT_L
#undef PG8_BAR
#undef PG8_SCHED
}
}

#define DI __device__ __forceinline__
#define LAS __attribute__((address_space(3)))
typedef unsigned short bf16_t;
typedef unsigned char uchar;
typedef short bf16x8 __attribute__((ext_vector_type(8)));
typedef short s16x4 __attribute__((ext_vector_type(4)));
typedef float f32x4 __attribute__((ext_vector_type(4)));
typedef float f32x16 __attribute__((ext_vector_type(16)));
typedef unsigned u32x4 __attribute__((ext_vector_type(4)));
typedef unsigned u32x2 __attribute__((ext_vector_type(2)));
typedef float f32x2_t __attribute__((ext_vector_type(2)));
typedef __bf16 bf16x2_t __attribute__((ext_vector_type(2)));

constexpr int T = 81920, TP = 65536, DM = 1024;
constexpr int LP = 2048, LS = 16384;
constexpr int DIN = 3008, DINP = 3072;
constexpr int NQ = 1536, NKV = 2048, NLAT = 768, NXBC = 1280;
constexpr int DFF = 2816, NGU = 5632;
constexpr float EPS = 1e-6f;
constexpr float QSCALE = 0.10206207261596575f * 1.4426950408889634f;
constexpr int CH0_ROWS = 49152, CH1_ROWS = 32768;

constexpr size_t MiB = 1u << 20;
constexpr size_t WS_WIN = 0, WS_WQB = 6 * MiB, WS_WKVB = 8 * MiB, WS_WOUT = 9 * MiB, WS_WGU = 13 * MiB, WS_WDN = 24 * MiB;
constexpr size_t WS_TAB = 30 * MiB;
constexpr size_t WS_H = 32 * MiB;
constexpr size_t WS_XBC = 192 * MiB;
constexpr size_t WS_MIX = 32 * MiB;
constexpr size_t WS_Z = 392 * MiB;
constexpr size_t WS_LAT = 552 * MiB;
constexpr size_t WS_DT = 672 * MiB;
constexpr size_t WS_XBC2 = 682 * MiB;
constexpr size_t WS_KV = 682 * MiB;
constexpr size_t WS_X1B = 352 * MiB;
constexpr size_t WS_SS = 1004 * MiB;
constexpr size_t WS_BAR = 1006 * MiB;
constexpr size_t WS_G = 32 * MiB;
constexpr size_t WS_U = 512 * MiB;
static_assert(WS_XBC2 + (size_t)T * NXBC * 2 <= WS_SS && WS_KV + (size_t)T * NKV * 2 <= WS_SS, "ws map");
static_assert(WS_G + (size_t)CH0_ROWS * DFF * 2 <= WS_X1B && WS_X1B + (size_t)T * DM * 2 <= WS_U && WS_U + (size_t)CH0_ROWS * DFF * 2 <= WS_SS, "ws map 2");
static_assert(WS_MIX + (size_t)T * 2048 * 2 <= WS_X1B, "ws map 3");

struct Params {
    const float *xp, *xs, *norm1, *w_in, *q_a_norm, *kv_a_norm, *w_q_b, *w_kv_b, *conv_w, *conv_b, *dt_bias_f, *dt_bias_b, *a_log_f, *a_log_b,
        *d_skip, *ssm_norm, *w_out, *norm2, *w_gate, *w_up, *ffn_conv_w, *ffn_conv_b, *w_down, *final_norm;
    float* out; uchar* ws;
};

DI float bf2f(bf16_t v) { return __uint_as_float((unsigned)v << 16); }
DI unsigned pk2(float lo, float hi) { f32x2_t v = {lo, hi}; bf16x2_t b = __builtin_convertvector(v, bf16x2_t); return __builtin_bit_cast(unsigned, b); }
DI void unpack8(const u32x4 w, float (&f)[8]) {
#pragma unroll
    for (int i = 0; i < 4; ++i) { f[2 * i] = __uint_as_float(w[i] << 16); f[2 * i + 1] = __uint_as_float(w[i] & 0xffff0000u); }
}
DI u32x4 pack8(const float (&f)[8]) { u32x4 w; w.x = pk2(f[0], f[1]); w.y = pk2(f[2], f[3]); w.z = pk2(f[4], f[5]); w.w = pk2(f[6], f[7]); return w; }
DI float wave_sum(float v) {
#pragma unroll
    for (int o = 1; o < 64; o <<= 1) v += __shfl_xor(v, o);
    return v;
}
DI const float* xrow(const Params& P, int row) { return row < TP ? P.xp + (size_t)row * DM : P.xs + (size_t)(row - TP) * DM; }
DI int posof(int row) { return row < TP ? (row & (LP - 1)) : row - TP; }
DI int lenof(int row) { return row < TP ? LP : LS; }
DI float silu(float v) { return v / (1.f + __expf(-v)); }

#define EPI_LOOP_BEGIN \
    _Pragma("unroll") for (int ai = 0; ai < 2; ++ai) _Pragma("unroll") for (int m = 0; m < 4; ++m) { const int row = u.pm * 256 + ai * 128 + wr * 64 + m * 16 + fr; \
    _Pragma("unroll") for (int bj = 0; bj < 2; ++bj) { const f32x4 v0 = acc[ai][bj][m][0], v1 = acc[ai][bj][m][1];
#define EPI_LOOP_END } }

struct EpiIn {
    static constexpr bool PERM = true, AFTER_DRAIN = false;
    bf16_t *z, *xbc, *lat; float* dt;
    DI void operator()(const f32x4 (&acc)[2][2][4][2], const pg8::Unit& u, int wr, int wc, int fr, int fq) const {
        bf16_t* base; int ld, colt;
        if (u.pn < 4) { base = z; ld = DM; colt = u.pn * 256; } else if (u.pn < 9) { base = xbc; ld = NXBC; colt = (u.pn - 4) * 256; } else { base = lat; ld = NLAT; colt = (u.pn - 9) * 256; }
        const int col0 = colt + wc * 32 + 8 * fq;
        EPI_LOOP_BEGIN
            u32x4 w; w.x = pk2(v0[0], v0[1]); w.y = pk2(v0[2], v0[3]); w.z = pk2(v1[0], v1[1]); w.w = pk2(v1[2], v1[3]);
            *(u32x4*)(base + (size_t)row * ld + col0 + bj * 128) = w;
            if (u.pn == 11 && bj == 1 && wc == 1) { float* d = dt + (size_t)row * 32 + 8 * fq; *(f32x4*)d = v0; *(f32x4*)(d + 4) = v1; }
        EPI_LOOP_END
    }
};
struct EpiPlain {
    static constexpr bool PERM = true, AFTER_DRAIN = false;
    bf16_t* o; int ld; float sc;
    DI void operator()(const f32x4 (&acc)[2][2][4][2], const pg8::Unit& u, int wr, int wc, int fr, int fq) const {
        const int col0 = u.pn * 256 + wc * 32 + 8 * fq;
        EPI_LOOP_BEGIN
            u32x4 w; w.x = pk2(v0[0] * sc, v0[1] * sc); w.y = pk2(v0[2] * sc, v0[3] * sc); w.z = pk2(v1[0] * sc, v1[1] * sc); w.w = pk2(v1[2] * sc, v1[3] * sc);
            *(u32x4*)(o + (size_t)row * ld + col0 + bj * 128) = w;
        EPI_LOOP_END
    }
};
struct EpiRes {
    static constexpr bool PERM = true, AFTER_DRAIN = false;
    const float* resp; const float* ress; float* xo; bf16_t* xb; float* ss; int row_off;
    DI void operator()(const f32x4 (&acc)[2][2][4][2], const pg8::Unit& u, int wr, int wc, int fr, int fq) const {
        const int col0 = u.pn * 256 + wc * 32 + 8 * fq;
#pragma unroll
        for (int ai = 0; ai < 2; ++ai)
#pragma unroll
            for (int m = 0; m < 4; ++m) {
                const int row = row_off + u.pm * 256 + ai * 128 + wr * 64 + m * 16 + fr;
                const float* rp = (row < TP ? resp + (size_t)row * DM : ress + (size_t)(row - TP) * DM) + col0;
                float s = 0.f;
#pragma unroll
                for (int bj = 0; bj < 2; ++bj) {
                    const f32x4 r0 = *(const f32x4*)(rp + bj * 128), r1 = *(const f32x4*)(rp + bj * 128 + 4);
                    const f32x4 a = acc[ai][bj][m][0] + r0, b = acc[ai][bj][m][1] + r1;
                    float* op = xo + (size_t)row * DM + col0 + bj * 128;
                    *(f32x4*)op = a; *(f32x4*)(op + 4) = b;
                    if (xb) { u32x4 w; w.x = pk2(a[0], a[1]); w.y = pk2(a[2], a[3]); w.z = pk2(b[0], b[1]); w.w = pk2(b[2], b[3]); *(u32x4*)(xb + (size_t)row * DM + col0 + bj * 128) = w; }
                    s += (a[0] * a[0] + a[1] * a[1]) + (a[2] * a[2] + a[3] * a[3]) + (b[0] * b[0] + b[1] * b[1]) + (b[2] * b[2] + b[3] * b[3]);
                }
                s += __shfl_xor(s, 16); s += __shfl_xor(s, 32);
                if (fq == 0) atomicAdd(ss + row, s);
            }
    }
};
struct EpiGU {
    static constexpr bool PERM = true, AFTER_DRAIN = false;
    bf16_t *g, *uo; const float* ss; int row_off;
    DI void operator()(const f32x4 (&acc)[2][2][4][2], const pg8::Unit& u, int wr, int wc, int fr, int fq) const {
        const int col0 = u.pn * 128 + wc * 32 + 8 * fq;
#pragma unroll
        for (int ai = 0; ai < 2; ++ai)
#pragma unroll
            for (int m = 0; m < 4; ++m) {
                const int lrow = u.pm * 256 + ai * 128 + wr * 64 + m * 16 + fr;
                const float rs = rsqrtf(ss[row_off + lrow] * (1.f / DM) + EPS);
#pragma unroll
                for (int bj = 0; bj < 2; ++bj) {
                    const f32x4 a = acc[ai][bj][m][0] * rs, b = acc[ai][bj][m][1] * rs;
                    u32x4 w; w.x = pk2(a[0], a[1]); w.y = pk2(a[2], a[3]); w.z = pk2(b[0], b[1]); w.w = pk2(b[2], b[3]);
                    *(u32x4*)((bj == 0 ? g : uo) + (size_t)lrow * DFF + col0) = w;
                }
            }
    }
};

template <class F> DI void transpose_item(const float* W, int K, int N, bf16_t* WT, LAS float* scr, int item, int lane, F destrow, const float* kscale) {
    const int nblk = N / 32, kb = item / nblk, nb = item % nblk, k0 = 64 * kb, n0 = 32 * nb;
#pragma unroll 8
    for (int i = 0; i < 32; ++i) { const int kk = 2 * i + (lane >> 5); float w = W[(size_t)(k0 + kk) * N + n0 + (lane & 31)]; if (kscale) w *= kscale[k0 + kk]; scr[kk * 33 + (lane & 31)] = w; }
    asm volatile("s_waitcnt lgkmcnt(0)" ::: "memory");
    const int c = lane & 7;
#pragma unroll
    for (int j = 0; j < 4; ++j) { const int n = (lane >> 3) + 8 * j; const LAS float* s = scr + (8 * c) * 33 + n;
        u32x4 o; o.x = pk2(s[0 * 33], s[1 * 33]); o.y = pk2(s[2 * 33], s[3 * 33]); o.z = pk2(s[4 * 33], s[5 * 33]); o.w = pk2(s[6 * 33], s[7 * 33]);
        *(u32x4*)(WT + (size_t)destrow(n0 + n) * K + k0 + 8 * c) = o; }
    asm volatile("s_waitcnt lgkmcnt(0)" ::: "memory");
}
struct DestIn { DI int operator()(int c) const { return c < 672 ? 2304 + c : (c < 1696 ? c - 672 : (c < 2976 ? 1024 + (c - 1696) : 2304 + 672 + (c - 2976))); } };
struct DestQb { DI int operator()(int c) const { const int h = c / 96, j = c % 96; if (j < 64) return h * 64 + j; const int i = j - 64; return 1024 + h * 32 + (i < 16 ? 2 * i : 2 * (i - 16) + 1); } };
struct DestKvb { DI int operator()(int c) const { const int h = c >> 7, j = c & 127; return j < 64 ? h * 64 + j : 1024 + h * 64 + (j - 64); } };
struct DestId { DI int operator()(int c) const { return c; } };
struct DestGate { DI int operator()(int c) const { return 256 * (c >> 7) + (c & 127); } };
struct DestUp { DI int operator()(int c) const { return 256 * (c >> 7) + 128 + (c & 127); } };

DI void p0_prologue(const Params& P, LAS uchar* lds) {
    const int tid = threadIdx.x, lane = tid & 63, wave = tid >> 6, G = gridDim.x;
    const int gw = blockIdx.x * 8 + wave, NGW = G * 8;
    const int gt = blockIdx.x * 512 + tid, NGT = G * 512;
    LAS float* scr = (LAS float*)(lds + wave * 16384);
    bf16_t* Win = (bf16_t*)(P.ws + WS_WIN); bf16_t* Wqb = (bf16_t*)(P.ws + WS_WQB); bf16_t* Wkvb = (bf16_t*)(P.ws + WS_WKVB);
    bf16_t* Wout = (bf16_t*)(P.ws + WS_WOUT); bf16_t* Wgu = (bf16_t*)(P.ws + WS_WGU); bf16_t* Wdn = (bf16_t*)(P.ws + WS_WDN);
    constexpr int I_IN = 16 * 94, I_QB = 6 * 48, I_KVB = 4 * 64, I_OUT = 32 * 32, I_G = 16 * 88, I_DN = 44 * 32;
    constexpr int NITEMS = I_IN + I_QB + I_KVB + I_OUT + 2 * I_G + I_DN;
    for (int it = gw; it < NITEMS; it += NGW) {
        int r = it;
        if (r < I_IN) { transpose_item(P.w_in, 1024, DIN, Win, scr, r, lane, DestIn(), nullptr); continue; } r -= I_IN;
        if (r < I_QB) { transpose_item(P.w_q_b, 384, NQ, Wqb, scr, r, lane, DestQb(), nullptr); continue; } r -= I_QB;
        if (r < I_KVB) { transpose_item(P.w_kv_b, 256, NKV, Wkvb, scr, r, lane, DestKvb(), nullptr); continue; } r -= I_KVB;
        if (r < I_OUT) { transpose_item(P.w_out, 2048, DM, Wout, scr, r, lane, DestId(), nullptr); continue; } r -= I_OUT;
        if (r < I_G) { transpose_item(P.w_gate, 1024, DFF, Wgu, scr, r, lane, DestGate(), P.norm2); continue; } r -= I_G;
        if (r < I_G) { transpose_item(P.w_up, 1024, DFF, Wgu, scr, r, lane, DestUp(), P.norm2); continue; } r -= I_G;
        transpose_item(P.w_down, DFF, DM, Wdn, scr, r, lane, DestId(), nullptr);
    }
    for (int i = gt; i < 64 * 1024 / 8; i += NGT) *(u32x4*)(Win + (size_t)3008 * 1024 + (size_t)i * 8) = (u32x4){0u, 0u, 0u, 0u};
    float* tab = (float*)(P.ws + WS_TAB);
    for (int i = gt; i < LS * 16; i += NGT) { const int pos = i >> 4, k = i & 15; const float inv = powf(10000.0f, -(float)(2 * k) / 32.0f); const float ang = (float)pos * inv; float s, c; sincosf(ang, &s, &c); tab[2 * i] = c; tab[2 * i + 1] = s; }
    float* ss = (float*)(P.ws + WS_SS);
    for (int i = gt; i < 2 * T; i += NGT) ss[i] = 0.f;
    bf16_t* hb = (bf16_t*)(P.ws + WS_H);
    for (int row = gw; row < T; row += NGW) {
        const f32x4* xr = (const f32x4*)xrow(P, row) + lane;
        f32x4 v[4]; float s = 0.f;
#pragma unroll
        for (int j = 0; j < 4; ++j) { v[j] = xr[64 * j]; s += (v[j][0] * v[j][0] + v[j][1] * v[j][1]) + (v[j][2] * v[j][2] + v[j][3] * v[j][3]); }
        const float rs = rsqrtf(wave_sum(s) * (1.f / DM) + EPS);
        u32x2* o = (u32x2*)(hb + (size_t)row * DM) + lane;
#pragma unroll
        for (int j = 0; j < 4; ++j) { const f32x4 w = ((const f32x4*)P.norm1)[lane + 64 * j]; u32x2 pk; pk.x = pk2(v[j][0] * rs * w[0], v[j][1] * rs * w[1]); pk.y = pk2(v[j][2] * rs * w[2], v[j][3] * rs * w[3]); o[64 * j] = pk; }
    }
}

DI void p2_prep(const Params& P) {
    const int tid = threadIdx.x, lane = tid & 63, wave = tid >> 6, G = gridDim.x;
    const int gw = blockIdx.x * 8 + wave, NGW = G * 8;
    const int gt = blockIdx.x * 512 + tid, NGT = G * 512;
    bf16_t* lat = (bf16_t*)(P.ws + WS_LAT); float* dt = (float*)(P.ws + WS_DT); const float* tab = (const float*)(P.ws + WS_TAB);
    for (int row = gw; row < T; row += NGW) {
        bf16_t* lr = lat + (size_t)row * NLAT;
        float qv[8], kv[8];
#pragma unroll
        for (int j = 0; j < 8; ++j) { qv[j] = 0.f; kv[j] = 0.f; }
        if (lane < 48) unpack8(*(const u32x4*)(lr + lane * 8), qv);
        if (lane < 32) unpack8(*(const u32x4*)(lr + 384 + lane * 8), kv);
        float sq = 0.f, sk = 0.f;
#pragma unroll
        for (int j = 0; j < 8; ++j) { sq += qv[j] * qv[j]; sk += kv[j] * kv[j]; }
        sq = wave_sum(sq); sk = wave_sum(sk);
        const float rq = rsqrtf(sq * (1.f / 384.f) + EPS), rk = rsqrtf(sk * (1.f / 256.f) + EPS);
        float x1 = 0.f, x2 = 0.f, dtv = 0.f;
        if (lane < 16) { x1 = bf2f(lr[640 + lane]); x2 = bf2f(lr[656 + lane]); }
        if (lane < 32) dtv = dt[(size_t)row * 32 + lane];
        asm volatile("s_waitcnt vmcnt(0)" ::: "memory");
        if (lane < 48) { float o[8];
#pragma unroll
            for (int j = 0; j < 8; ++j) o[j] = qv[j] * rq * P.q_a_norm[lane * 8 + j];
            *(u32x4*)(lr + lane * 8) = pack8(o); }
        if (lane < 32) { float o[8];
#pragma unroll
            for (int j = 0; j < 8; ++j) o[j] = kv[j] * rk * P.kv_a_norm[lane * 8 + j];
            *(u32x4*)(lr + 384 + lane * 8) = pack8(o); }
        if (lane < 16) { const float c = tab[((size_t)posof(row) * 16 + lane) * 2], s = tab[((size_t)posof(row) * 16 + lane) * 2 + 1];
            *(unsigned*)(lr + 640 + 2 * lane) = pk2(x1 * c - x2 * s, x2 * c + x1 * s); }
        if (lane < 32) { const float b = lane < 16 ? P.dt_bias_f[lane] : P.dt_bias_b[lane - 16]; const float v = dtv + b;
            dt[(size_t)row * 32 + lane] = fmaxf(v, 0.f) + log1pf(__expf(-fabsf(v))); }
    }
    const bf16_t* xbc = (const bf16_t*)(P.ws + WS_XBC); bf16_t* xbc2 = (bf16_t*)(P.ws + WS_XBC2);
    for (int idx = gt; idx < T * 160; idx += NGT) {
        const int row = idx / 160, c0 = (idx - row * 160) * 8; const int pos = posof(row), L = lenof(row);
        float cur[8], prv[8], nxt[8];
        unpack8(*(const u32x4*)(xbc + (size_t)row * NXBC + c0), cur);
        if (pos > 0) unpack8(*(const u32x4*)(xbc + (size_t)(row - 1) * NXBC + c0), prv); else {
#pragma unroll
            for (int j = 0; j < 8; ++j) prv[j] = 0.f; }
        if (pos < L - 1) unpack8(*(const u32x4*)(xbc + (size_t)(row + 1) * NXBC + c0), nxt); else {
#pragma unroll
            for (int j = 0; j < 8; ++j) nxt[j] = 0.f; }
        float o[8];
#pragma unroll
        for (int j = 0; j < 8; ++j) { const float v = P.conv_w[c0 + j] * prv[j] + P.conv_w[NXBC + c0 + j] * cur[j] + P.conv_w[2 * NXBC + c0 + j] * nxt[j] + P.conv_b[c0 + j]; o[j] = silu(v); }
        *(u32x4*)(xbc2 + (size_t)row * NXBC + c0) = pack8(o);
    }
}

constexpr int BCROW = 144, SSD_BT = 0, SSD_CT = 128 * BCROW, SSD_WAVE = 2 * 128 * BCROW, SSD_WSZ = 8192 + 2048, SSD_RED = SSD_WAVE + 8 * SSD_WSZ;
constexpr size_t WS_DEC = 352 * MiB;
DI float wave_incl_scan(float v, int lane) {
#pragma unroll
    for (int o = 1; o < 64; o <<= 1) { const float n = __shfl_up(v, o); if (lane >= o) v += n; }
    return v;
}
DI bf16x8 tr_frag(const LAS uchar* p, int rowstride) {
    const s16x4 lo = __builtin_bit_cast(s16x4, __builtin_amdgcn_ds_read_tr16_b64_v4i16((LAS s16x4*)p));
    const s16x4 hh = __builtin_bit_cast(s16x4, __builtin_amdgcn_ds_read_tr16_b64_v4i16((LAS s16x4*)(p + 8 * rowstride)));
    return __builtin_shufflevector(lo, hh, 0, 1, 2, 3, 4, 5, 6, 7);
}
DI void ssd_chunk_prologue(const Params& P, LAS uchar* lds, int cg, int g) {
    const int tid = threadIdx.x, lane = tid & 63, wave = tid >> 6;
    const bf16_t* xbc2 = (const bf16_t*)(P.ws + WS_XBC2); const float* dtg = (const float*)(P.ws + WS_DT);
    const int row0 = cg * 128, head = g * 8 + wave;
    __syncthreads();
#pragma unroll
    for (int k = 0; k < 2; ++k) { const int c = tid + 512 * k, row = c >> 3, c16 = c & 7;
        const bf16_t* src = xbc2 + (size_t)(row0 + row) * NXBC + 1024 + g * 64 + c16 * 8;
        *(LAS u32x4*)(lds + SSD_BT + row * BCROW + c16 * 16) = *(const u32x4*)src;
        *(LAS u32x4*)(lds + SSD_CT + row * BCROW + c16 * 16) = *(const u32x4*)(src + 128); }
    LAS float* arr = (LAS float*)(lds + SSD_WAVE + wave * SSD_WSZ + 8192);
    const float Af = -__expf(P.a_log_f[head]), Ab = -__expf(P.a_log_b[head]);
    const float df0 = dtg[(size_t)(row0 + lane) * 32 + head], df1 = dtg[(size_t)(row0 + 64 + lane) * 32 + head];
    const float db0 = dtg[(size_t)(row0 + lane) * 32 + 16 + head], db1 = dtg[(size_t)(row0 + 64 + lane) * 32 + 16 + head];
    float p0 = wave_incl_scan(Af * df0, lane); const float tot0 = __shfl(p0, 63); float p1 = wave_incl_scan(Af * df1, lane) + tot0;
    float q0 = wave_incl_scan(Ab * db0, lane); const float qt0 = __shfl(q0, 63); float q1 = wave_incl_scan(Ab * db1, lane) + qt0; const float qtot = __shfl(q1, 63);
    arr[lane] = df0; arr[64 + lane] = df1; arr[128 + lane] = db0; arr[192 + lane] = db1;
    arr[256 + lane] = p0; arr[320 + lane] = p1;
    arr[384 + lane] = qtot - q0 + Ab * db0; arr[448 + lane] = qtot - q1 + Ab * db1;
    __syncthreads();
}
DI void ssd_stage_x(const Params& P, LAS uchar* xb, int row0, int sb, int head, int lane) {
    const bf16_t* xbc2 = (const bf16_t*)(P.ws + WS_XBC2);
    u32x4 v[4];
#pragma unroll
    for (int i = 0; i < 4; ++i) { const int c = lane + 64 * i, row = c >> 3, c16 = c & 7; v[i] = *(const u32x4*)(xbc2 + (size_t)(row0 + 32 * sb + row) * NXBC + head * 64 + c16 * 8); }
#pragma unroll
    for (int i = 0; i < 4; ++i) { const int c = lane + 64 * i, row = c >> 3, c16 = c & 7; *(LAS u32x4*)(xb + row * 128 + c16 * 16) = v[i]; }
}
DI void p3_s1_states(const Params& P, LAS uchar* lds) {
    const int tid = threadIdx.x, lane = tid & 63, wave = tid >> 6, r32 = lane & 31, hi = lane >> 5;
    const int i16 = lane & 15, qq = i16 >> 2, pp = i16 & 3, blk = (lane >> 4) & 1;
    float* st = P.out; float* dec = (float*)(P.ws + WS_DEC);
    LAS uchar* xbuf = lds + SSD_WAVE + wave * SSD_WSZ; const LAS float* arr = (const LAS float*)(xbuf + 8192);
    for (int item = blockIdx.x; item < 1280; item += gridDim.x) {
        const int cg = item >> 1, g = item & 1, row0 = cg * 128, head = g * 8 + wave;
        ssd_chunk_prologue(P, lds, cg, g);
#pragma unroll 1
        for (int dir = 0; dir < 2; ++dir) {
            f32x16 acc[2][2];
#pragma unroll
            for (int a = 0; a < 2; ++a)
#pragma unroll
                for (int b = 0; b < 2; ++b)
#pragma unroll
                    for (int r = 0; r < 16; ++r) acc[a][b][r] = 0.f;
            const LAS float* dta = arr + dir * 128; const LAS float* cs = arr + 256 + dir * 128;
            const float wlast = dir == 0 ? cs[127] : cs[0];
#pragma unroll 1
            for (int sb = 0; sb < 4; ++sb) {
                LAS uchar* xb = xbuf + (sb & 1) * 4096;
                ssd_stage_x(P, xb, row0, sb, head, lane);
#pragma unroll
                for (int k2 = 0; k2 < 2; ++k2) {
                    const int sbase = 32 * sb + 16 * k2 + 4 * hi;
                    const f32x4 a0 = *(const LAS f32x4*)(cs + sbase), a1 = *(const LAS f32x4*)(cs + sbase + 8);
                    const f32x4 d0 = *(const LAS f32x4*)(dta + sbase), d1 = *(const LAS f32x4*)(dta + sbase + 8);
                    float w[8];
#pragma unroll
                    for (int j = 0; j < 4; ++j) { w[j] = __expf(wlast - a0[j]) * d0[j]; w[4 + j] = __expf(wlast - a1[j]) * d1[j]; }
                    bf16x8 xs[2];
#pragma unroll
                    for (int pb = 0; pb < 2; ++pb) {
                        const bf16x8 xf = tr_frag(xb + (16 * k2 + 4 * hi + qq) * 128 + (32 * pb + 16 * blk + 4 * pp) * 2, 128);
                        float f[8]; unpack8(__builtin_bit_cast(u32x4, xf), f);
#pragma unroll
                        for (int j = 0; j < 8; ++j) f[j] *= w[j];
                        xs[pb] = __builtin_bit_cast(bf16x8, pack8(f));
                    }
#pragma unroll
                    for (int nb = 0; nb < 2; ++nb) {
                        const bf16x8 bf = tr_frag(lds + SSD_BT + (32 * sb + 16 * k2 + 4 * hi + qq) * BCROW + (32 * nb + 16 * blk + 4 * pp) * 2, BCROW);
#pragma unroll
                        for (int pb = 0; pb < 2; ++pb) acc[pb][nb] = __builtin_amdgcn_mfma_f32_32x32x16_bf16(xs[pb], bf, acc[pb][nb], 0, 0, 0);
                    }
                }
            }
            float* so = st + ((size_t)(cg * 2 + dir) * 16 + head) * 4096;
#pragma unroll
            for (int pb = 0; pb < 2; ++pb)
#pragma unroll
                for (int nb = 0; nb < 2; ++nb)
#pragma unroll
                    for (int r = 0; r < 16; ++r) so[(32 * pb + (r & 3) + 8 * (r >> 2) + 4 * hi) * 64 + 32 * nb + r32] = acc[pb][nb][r];
            if (lane == 0) dec[(cg * 2 + dir) * 16 + head] = __expf(wlast);
        }
    }
}
DI void p3_s2_scan(const Params& P) {
    float* st = P.out; const float* dec = (const float*)(P.ws + WS_DEC);
    for (int e = blockIdx.x * 512 + threadIdx.x; e < 131072; e += gridDim.x * 512) {
        const int dir = e >> 16, dh = e >> 12;
        for (int seq = 0; seq < 33; ++seq) {
            const int c0 = seq * 16, nc = seq < 32 ? 16 : 128;
            float hp = 0.f;
            for (int b = 0; b < nc; b += 16) {
                float s[16], d[16];
#pragma unroll
                for (int i = 0; i < 16; ++i) { const int c = dir == 0 ? c0 + b + i : c0 + nc - 1 - b - i; s[i] = st[(size_t)c * 131072 + e]; d[i] = dec[c * 32 + dh]; }
#pragma unroll
                for (int i = 0; i < 16; ++i) { const float t = s[i]; s[i] = hp; hp = hp * d[i] + t; }
#pragma unroll
                for (int i = 0; i < 16; ++i) { const int c = dir == 0 ? c0 + b + i : c0 + nc - 1 - b - i; st[(size_t)c * 131072 + e] = s[i]; }
            }
        }
    }
}
DI void p3_s3_output(const Params& P, LAS uchar* lds) {
    const int tid = threadIdx.x, lane = tid & 63, wave = tid >> 6, r32 = lane & 31, hi = lane >> 5;
    const int i16 = lane & 15, qq = i16 >> 2, pp = i16 & 3, blk = (lane >> 4) & 1;
    const float* st = P.out; const bf16_t* zb = (const bf16_t*)(P.ws + WS_Z); bf16_t* mix = (bf16_t*)(P.ws + WS_MIX);
    LAS uchar* xbuf = lds + SSD_WAVE + wave * SSD_WSZ; const LAS float* arr = (const LAS float*)(xbuf + 8192);
    LAS float* red = (LAS float*)(lds + SSD_RED);
    for (int item = blockIdx.x; item < 1280; item += gridDim.x) {
        const int cg = item >> 1, g = item & 1, row0 = cg * 128, head = g * 8 + wave;
        ssd_chunk_prologue(P, lds, cg, g);
        const float Dk = P.d_skip[head];
        const float* Hf = st + ((size_t)(cg * 2 + 0) * 16 + head) * 4096; const float* Hb = st + ((size_t)(cg * 2 + 1) * 16 + head) * 4096;
#pragma unroll 1
        for (int tb = 0; tb < 4; ++tb) {
            const int t = 32 * tb + r32;
            const float af_t = arr[256 + t], rb_t = arr[384 + t];
            const float ef = __expf(af_t), eb = __expf(rb_t);
            bf16x8 cfr[4];
#pragma unroll
            for (int ks = 0; ks < 4; ++ks) cfr[ks] = *(const LAS bf16x8*)(lds + SSD_CT + t * BCROW + ks * 32 + hi * 16);
            f32x16 acc[2];
#pragma unroll
            for (int dir = 0; dir < 2; ++dir) {
                const float* H = dir == 0 ? Hf : Hb;
                f32x16 tmp[2];
#pragma unroll
                for (int pb = 0; pb < 2; ++pb)
#pragma unroll
                    for (int r = 0; r < 16; ++r) tmp[pb][r] = 0.f;
#pragma unroll
                for (int ks = 0; ks < 4; ++ks)
#pragma unroll
                    for (int pb = 0; pb < 2; ++pb) {
                        const float* hp = H + (32 * pb + r32) * 64 + 16 * ks + 8 * hi;
                        const f32x4 h0 = *(const f32x4*)hp, h1 = *(const f32x4*)(hp + 4);
                        u32x4 w; w.x = pk2(h0[0], h0[1]); w.y = pk2(h0[2], h0[3]); w.z = pk2(h1[0], h1[1]); w.w = pk2(h1[2], h1[3]);
                        tmp[pb] = __builtin_amdgcn_mfma_f32_32x32x16_bf16(__builtin_bit_cast(bf16x8, w), cfr[ks], tmp[pb], 0, 0, 0);
                    }
                const float e = dir == 0 ? ef : eb;
#pragma unroll
                for (int pb = 0; pb < 2; ++pb)
#pragma unroll
                    for (int r = 0; r < 16; ++r) acc[pb][r] = dir == 0 ? e * tmp[pb][r] : acc[pb][r] + e * tmp[pb][r];
            }
#pragma unroll 1
            for (int sb = 0; sb < 4; ++sb) {
                LAS uchar* xb = xbuf + (sb & 1) * 4096;
                ssd_stage_x(P, xb, row0, sb, head, lane);
                f32x16 X;
#pragma unroll
                for (int r = 0; r < 16; ++r) X[r] = 0.f;
#pragma unroll
                for (int ks = 0; ks < 4; ++ks) {
                    const bf16x8 bfa = *(const LAS bf16x8*)(lds + SSD_BT + (32 * sb + r32) * BCROW + ks * 32 + hi * 16);
                    X = __builtin_amdgcn_mfma_f32_32x32x16_bf16(bfa, cfr[ks], X, 0, 0, 0);
                }
#pragma unroll
                for (int gq = 0; gq < 4; ++gq) {
                    const int s0 = 32 * sb + 8 * gq + 4 * hi;
                    const f32x4 dfv = *(const LAS f32x4*)(arr + s0), dbv = *(const LAS f32x4*)(arr + 128 + s0);
                    const f32x4 afv = *(const LAS f32x4*)(arr + 256 + s0), rbv = *(const LAS f32x4*)(arr + 384 + s0);
#pragma unroll
                    for (int j = 0; j < 4; ++j) {
                        const int s = s0 + j;
                        float coef = 0.f;
                        if (s <= t) coef = __expf(af_t - afv[j]) * dfv[j];
                        if (s >= t) coef += __expf(rb_t - rbv[j]) * dbv[j];
                        float v = X[4 * gq + j] * coef;
                        if (s == t) v += Dk;
                        X[4 * gq + j] = v;
                    }
                }
#pragma unroll
                for (int s2 = 0; s2 < 2; ++s2) {
                    u32x4 pw;
                    if (s2 == 0) { pw.x = pk2(X[0], X[1]); pw.y = pk2(X[2], X[3]); pw.z = pk2(X[4], X[5]); pw.w = pk2(X[6], X[7]); }
                    else { pw.x = pk2(X[8], X[9]); pw.y = pk2(X[10], X[11]); pw.z = pk2(X[12], X[13]); pw.w = pk2(X[14], X[15]); }
                    const bf16x8 pbk = __builtin_bit_cast(bf16x8, pw);
#pragma unroll
                    for (int pb = 0; pb < 2; ++pb) {
                        const bf16x8 xf = tr_frag(xb + (16 * s2 + 4 * hi + qq) * 128 + (32 * pb + 16 * blk + 4 * pp) * 2, 128);
                        acc[pb] = __builtin_amdgcn_mfma_f32_32x32x16_bf16(xf, pbk, acc[pb], 0, 0, 0);
                    }
                }
            }
            const int row = row0 + t; const int cbase = g * 512 + wave * 64;
            float ssum = 0.f;
#pragma unroll
            for (int pb = 0; pb < 2; ++pb)
#pragma unroll
                for (int gq = 0; gq < 4; ++gq) {
                    const int p0 = 32 * pb + 8 * gq + 4 * hi;
                    const u32x2 zw = *(const u32x2*)(zb + (size_t)row * DM + cbase + p0);
                    const float z0 = __uint_as_float(zw.x << 16), z1 = __uint_as_float(zw.x & 0xffff0000u), z2 = __uint_as_float(zw.y << 16), z3 = __uint_as_float(zw.y & 0xffff0000u);
                    float v0 = acc[pb][4 * gq] * silu(z0), v1 = acc[pb][4 * gq + 1] * silu(z1), v2 = acc[pb][4 * gq + 2] * silu(z2), v3 = acc[pb][4 * gq + 3] * silu(z3);
                    acc[pb][4 * gq] = v0; acc[pb][4 * gq + 1] = v1; acc[pb][4 * gq + 2] = v2; acc[pb][4 * gq + 3] = v3;
                    ssum += (v0 * v0 + v1 * v1) + (v2 * v2 + v3 * v3);
                }
            ssum += __shfl_xor(ssum, 32);
            LAS float* rd = red + (tb & 1) * 256;
            if (hi == 0) rd[wave * 32 + r32] = ssum;
            __syncthreads();
            float tot = 0.f;
#pragma unroll
            for (int w = 0; w < 8; ++w) tot += rd[w * 32 + r32];
            const float rs = rsqrtf(tot * (1.f / 512.f) + EPS);
#pragma unroll
            for (int pb = 0; pb < 2; ++pb)
#pragma unroll
                for (int gq = 0; gq < 4; ++gq) {
                    const int p0 = 32 * pb + 8 * gq + 4 * hi;
                    const f32x4 nw = *(const f32x4*)(P.ssm_norm + cbase + p0);
                    u32x2 o; o.x = pk2(acc[pb][4 * gq] * rs * nw[0], acc[pb][4 * gq + 1] * rs * nw[1]); o.y = pk2(acc[pb][4 * gq + 2] * rs * nw[2], acc[pb][4 * gq + 3] * rs * nw[3]);
                    *(u32x2*)(mix + (size_t)row * 2048 + 1024 + cbase + p0) = o;
                }
        }
    }
}

constexpr int KROW = 208, VROW = 192, KTILE = 64 * KROW, VTILE = 64 * VROW;
DI void attn_unit(const Params& P, LAS uchar* lds, int rowbase, int L, int h, int qb) {
    const int tid = threadIdx.x, lane = tid & 63, wid = tid >> 6, r32 = lane & 31, hi = lane >> 5;
    const bf16_t* qbuf = (const bf16_t*)P.out; const bf16_t* kvb = (const bf16_t*)(P.ws + WS_KV); const bf16_t* lat = (const bf16_t*)(P.ws + WS_LAT);
    bf16_t* mix = (bf16_t*)(P.ws + WS_MIX);
    const int qrow = rowbase + qb * 256 + wid * 32 + r32;
    bf16x8 qf[6];
    { const bf16_t* Qg = qbuf + (size_t)qrow * NQ;
#pragma unroll
      for (int ks = 0; ks < 4; ++ks) qf[ks] = *(const bf16x8*)(Qg + h * 64 + ks * 16 + hi * 8);
#pragma unroll
      for (int ks = 0; ks < 2; ++ks) { float f[8], o[8]; unpack8(*(const u32x4*)(Qg + 1024 + h * 32 + ks * 16 + hi * 8), f);
          const float* tp = (const float*)(P.ws + WS_TAB) + ((size_t)(qrow - rowbase) * 16 + 8 * ks + 4 * hi) * 2;
          const f32x4 c0 = *(const f32x4*)tp, c1 = *(const f32x4*)(tp + 4);
          o[0] = f[0] * c0[0] - f[1] * c0[1]; o[1] = f[1] * c0[0] + f[0] * c0[1]; o[2] = f[2] * c0[2] - f[3] * c0[3]; o[3] = f[3] * c0[2] + f[2] * c0[3];
          o[4] = f[4] * c1[0] - f[5] * c1[1]; o[5] = f[5] * c1[0] + f[4] * c1[1]; o[6] = f[6] * c1[2] - f[7] * c1[3]; o[7] = f[7] * c1[2] + f[6] * c1[3];
          qf[4 + ks] = __builtin_bit_cast(bf16x8, pack8(o)); } }
    LAS uchar* Kb0 = lds; LAS uchar* Vb0 = lds + 2 * KTILE;
    const int skey = tid >> 3, sch = tid & 7, rkey = (tid >> 2) & 63, rch = tid & 3;
    const bf16_t* kn_src = kvb + (size_t)(rowbase + skey) * NKV + h * 64 + sch * 8;
    const bf16_t* v_src = kn_src + 1024;
    const bf16_t* kr_src = lat + (size_t)(rowbase + rkey) * NLAT + 640 + rch * 8;
    u32x4 rkn, rv, rkr;
    rkn = *(const u32x4*)kn_src; rv = *(const u32x4*)v_src; if (tid < 256) rkr = *(const u32x4*)kr_src;
    *(LAS u32x4*)(Kb0 + skey * KROW + sch * 16) = rkn; *(LAS u32x4*)(Vb0 + skey * VROW + sch * 16) = rv; if (tid < 256) *(LAS u32x4*)(Kb0 + rkey * KROW + 128 + rch * 16) = rkr;
    __syncthreads();
    float mrun = -1e30f, lrun = 0.f; f32x16 o0, o1;
#pragma unroll
    for (int r = 0; r < 16; ++r) { o0[r] = 0.f; o1[r] = 0.f; }
    const int NT = L / 64;
    const int i16 = lane & 15, qq = i16 >> 2, pp = i16 & 3, blk = (lane >> 4) & 1;
    const int vtr_off = (4 * hi + qq) * VROW + (16 * blk + 4 * pp) * 2;
    for (int kt = 0; kt < NT; ++kt) {
        const int cur = kt & 1;
        if (kt + 1 < NT) { const size_t adv = (size_t)(kt + 1) * 64; rkn = *(const u32x4*)(kn_src + adv * NKV); rv = *(const u32x4*)(v_src + adv * NKV); if (tid < 256) rkr = *(const u32x4*)(kr_src + adv * NLAT); }
        const LAS uchar* Kb = Kb0 + cur * KTILE; const LAS uchar* Vb = Vb0 + cur * VTILE;
        f32x16 p0, p1;
#pragma unroll
        for (int r = 0; r < 16; ++r) { p0[r] = 0.f; p1[r] = 0.f; }
#pragma unroll
        for (int ks = 0; ks < 6; ++ks) {
            const bf16x8 k0 = *(const LAS bf16x8*)(Kb + r32 * KROW + ks * 32 + hi * 16);
            const bf16x8 k1 = *(const LAS bf16x8*)(Kb + (32 + r32) * KROW + ks * 32 + hi * 16);
            p0 = __builtin_amdgcn_mfma_f32_32x32x16_bf16(k0, qf[ks], p0, 0, 0, 0);
            p1 = __builtin_amdgcn_mfma_f32_32x32x16_bf16(k1, qf[ks], p1, 0, 0, 0);
        }
        float mx = fmaxf(p0[0], p1[0]);
#pragma unroll
        for (int r = 1; r < 16; ++r) mx = fmaxf(mx, fmaxf(p0[r], p1[r]));
        mx = fmaxf(mx, __shfl_xor(mx, 32));
        const float mnew = fmaxf(mrun, mx);
        if (__any(mnew > mrun)) { const float al = __builtin_amdgcn_exp2f(mrun - mnew); lrun *= al;
#pragma unroll
            for (int r = 0; r < 16; ++r) { o0[r] *= al; o1[r] *= al; } }
        mrun = mnew;
        float ls = 0.f;
#pragma unroll
        for (int r = 0; r < 16; ++r) { p0[r] = __builtin_amdgcn_exp2f(p0[r] - mnew); p1[r] = __builtin_amdgcn_exp2f(p1[r] - mnew); ls += p0[r] + p1[r]; }
        lrun += ls;
#pragma unroll
        for (int s = 0; s < 4; ++s) {
            u32x4 pw;
            if (s == 0) { pw.x = pk2(p0[0], p0[1]); pw.y = pk2(p0[2], p0[3]); pw.z = pk2(p0[4], p0[5]); pw.w = pk2(p0[6], p0[7]); }
            else if (s == 1) { pw.x = pk2(p0[8], p0[9]); pw.y = pk2(p0[10], p0[11]); pw.z = pk2(p0[12], p0[13]); pw.w = pk2(p0[14], p0[15]); }
            else if (s == 2) { pw.x = pk2(p1[0], p1[1]); pw.y = pk2(p1[2], p1[3]); pw.z = pk2(p1[4], p1[5]); pw.w = pk2(p1[6], p1[7]); }
            else { pw.x = pk2(p1[8], p1[9]); pw.y = pk2(p1[10], p1[11]); pw.z = pk2(p1[12], p1[13]); pw.w = pk2(p1[14], p1[15]); }
            const bf16x8 pb = __builtin_bit_cast(bf16x8, pw);
#pragma unroll
            for (int db = 0; db < 2; ++db) {
                const LAS uchar* vp = Vb + vtr_off + s * 16 * VROW + db * 64;
                const s16x4 lo = __builtin_bit_cast(s16x4, __builtin_amdgcn_ds_read_tr16_b64_v4i16((LAS s16x4*)vp));
                const s16x4 hh = __builtin_bit_cast(s16x4, __builtin_amdgcn_ds_read_tr16_b64_v4i16((LAS s16x4*)(vp + 8 * VROW)));
                const bf16x8 va = __builtin_shufflevector(lo, hh, 0, 1, 2, 3, 4, 5, 6, 7);
                if (db == 0) o0 = __builtin_amdgcn_mfma_f32_32x32x16_bf16(va, pb, o0, 0, 0, 0);
                else o1 = __builtin_amdgcn_mfma_f32_32x32x16_bf16(va, pb, o1, 0, 0, 0);
            }
        }
        if (kt + 1 < NT) { LAS uchar* Kn = Kb0 + (cur ^ 1) * KTILE; LAS uchar* Vn = Vb0 + (cur ^ 1) * VTILE;
            *(LAS u32x4*)(Kn + skey * KROW + sch * 16) = rkn; *(LAS u32x4*)(Vn + skey * VROW + sch * 16) = rv; if (tid < 256) *(LAS u32x4*)(Kn + rkey * KROW + 128 + rch * 16) = rkr; }
        __syncthreads();
    }
    const float ltot = lrun + __shfl_xor(lrun, 32); const float inv = 1.f / ltot;
    bf16_t* op = mix + (size_t)qrow * 2048 + h * 64 + 4 * hi;
#pragma unroll
    for (int g = 0; g < 4; ++g) {
        u32x2 w0, w1;
        w0.x = pk2(o0[4 * g] * inv, o0[4 * g + 1] * inv); w0.y = pk2(o0[4 * g + 2] * inv, o0[4 * g + 3] * inv);
        w1.x = pk2(o1[4 * g] * inv, o1[4 * g + 1] * inv); w1.y = pk2(o1[4 * g + 2] * inv, o1[4 * g + 3] * inv);
        *(u32x2*)(op + 8 * g) = w0; *(u32x2*)(op + 32 + 8 * g) = w1;
    }
}
DI void p5_attention(const Params& P, LAS uchar* lds) {
    const int G = gridDim.x, bx = blockIdx.x; const int vcu = (G % 8 == 0) ? (bx % 8) * (G / 8) + bx / 8 : bx;
    const int perS = (1024 + G - 1) / G, perP = (4096 + G - 1) / G;
    for (int i = 0; i < perS; ++i) { const int s = vcu * perS + i; if (s < 1024) attn_unit(P, lds, TP, LS, s >> 6, s & 63); }
    for (int i = 0; i < perP; ++i) { const int s = vcu * perP + i; if (s < 4096) { const int b = s >> 7, rem = s & 127; attn_unit(P, lds, b * LP, LP, rem >> 3, rem & 7); } }
}

DI void p8_act(const Params& P, int rows, int row_off) {
    const int gt = blockIdx.x * 512 + threadIdx.x, NGT = gridDim.x * 512;
    const bf16_t* g = (const bf16_t*)(P.ws + WS_G); bf16_t* uo = (bf16_t*)(P.ws + WS_U);
    for (int idx = gt; idx < rows * 352; idx += NGT) {
        const int lrow = idx / 352, c0 = (idx - lrow * 352) * 8; const int row = row_off + lrow; const int pos = posof(row), L = lenof(row);
        float cur[8], prv[8], nxt[8], uu[8];
        unpack8(*(const u32x4*)(g + (size_t)lrow * DFF + c0), cur); unpack8(*(const u32x4*)(uo + (size_t)lrow * DFF + c0), uu);
        if (pos > 0) unpack8(*(const u32x4*)(g + (size_t)(lrow - 1) * DFF + c0), prv); else {
#pragma unroll
            for (int j = 0; j < 8; ++j) prv[j] = 0.f; }
        if (pos < L - 1) unpack8(*(const u32x4*)(g + (size_t)(lrow + 1) * DFF + c0), nxt); else {
#pragma unroll
            for (int j = 0; j < 8; ++j) nxt[j] = 0.f; }
        float o[8];
#pragma unroll
        for (int j = 0; j < 8; ++j) { const float v = P.ffn_conv_w[c0 + j] * prv[j] + P.ffn_conv_w[DFF + c0 + j] * cur[j] + P.ffn_conv_w[2 * DFF + c0 + j] * nxt[j] + P.ffn_conv_b[c0 + j]; o[j] = silu(v) * uu[j]; }
        *(u32x4*)(uo + (size_t)lrow * DFF + c0) = pack8(o);
    }
}
DI void p_final(const Params& P) {
    const int gt = blockIdx.x * 512 + threadIdx.x, NGT = gridDim.x * 512;
    const float* ss2 = (const float*)(P.ws + WS_SS) + T;
    for (int idx = gt; idx < T * 256; idx += NGT) { const int row = idx >> 8, c4 = idx & 255;
        const float rs = rsqrtf(ss2[row] * (1.f / DM) + EPS); const f32x4 w = ((const f32x4*)P.final_norm)[c4];
        f32x4 v = ((f32x4*)P.out)[idx]; v = v * rs * w; ((f32x4*)P.out)[idx] = v; }
}

#define XB_TMO      128
#define XB_XCNT(j)  (256  + 64 * (j))
#define XB_XSUB(j)  (1280 + 64 * (j))
#define XB_XGEN(j)  (2304 + 64 * (j))
#define XB_TOP      3328
#define XB_TOPGEN   3392
#define XCD_BAR_WORDS 3456
#define XB_SPIN_CAP (1u << 18)

__device__ __forceinline__ unsigned xb_ld(unsigned* p)              { return __hip_atomic_load(p, __ATOMIC_RELAXED, __HIP_MEMORY_SCOPE_AGENT); }
__device__ __forceinline__ unsigned xb_add(unsigned* p, unsigned v) { return __hip_atomic_fetch_add(p, v, __ATOMIC_RELAXED, __HIP_MEMORY_SCOPE_AGENT); }
__device__ __forceinline__ unsigned xb_xcc_id() { return (unsigned)__builtin_amdgcn_s_getreg((3 << 11) | 20) & 0xFu; }
#define XB_SPIN(cond, bar) do { unsigned _sp = 0; while (cond) { __builtin_amdgcn_s_sleep(1); \
    if ((++_sp & 255u) == 0u) { if (xb_ld(&(bar)[XB_TMO])) break; if (_sp > XB_SPIN_CAP) { atomicAdd(&(bar)[XB_TMO], 1u); break; } } } } while (0)

struct XcdBarrier {
    unsigned* bar; unsigned x;
    volatile LAS unsigned* st;
};

__device__ __forceinline__ XcdBarrier xcd_barrier_post(unsigned* bar, volatile LAS unsigned* st) {
    XcdBarrier b; b.bar = bar; b.x = xb_xcc_id(); b.st = st;
    if (threadIdx.x == 0) (void)xb_add(&bar[XB_XCNT(b.x)], 1u);
    return b;
}
__device__ __forceinline__ void xcd_barrier_complete(unsigned* bar, unsigned x, unsigned& nloc, unsigned& nx) {
    const unsigned G = gridDim.x * gridDim.y * gridDim.z;
    unsigned sum, cnt, mine, sp = 0u;
    for (;;) {
        sum = 0u; cnt = 0u; mine = 0u;
#pragma unroll
        for (unsigned j = 0; j < 16; ++j) { const unsigned c = xb_ld(&bar[XB_XCNT(j)]); sum += c; cnt += (c > 0u) ? 1u : 0u; mine = (j == x) ? c : mine; }
        if (sum == G) break;
        __builtin_amdgcn_s_sleep(1);
        if ((++sp & 255u) == 0u) { if (xb_ld(&bar[XB_TMO])) break; if (sp > XB_SPIN_CAP) { atomicAdd(&bar[XB_TMO], 1u); break; } }
    }
    nloc = mine > 0u ? mine : 1u; nx = cnt > 0u ? cnt : 1u;
}

__device__ __forceinline__ void xcd_barrier(const XcdBarrier& b) {
    asm volatile("s_waitcnt vmcnt(0)" ::: "memory");
    __syncthreads();
    if (threadIdx.x == 0) {
        unsigned* bar = b.bar;
        __builtin_amdgcn_s_waitcnt(0);
        unsigned nloc = b.st[0], nx = b.st[1];
        if (nloc == 0u) { xcd_barrier_complete(bar, b.x, nloc, nx); b.st[0] = nloc; b.st[1] = nx; }
        const unsigned old = xb_add(&bar[XB_XSUB(b.x)], 1u);
        const unsigned gen = old / nloc;
        if (old + 1u == (gen + 1u) * nloc) {
            __builtin_amdgcn_fence(__ATOMIC_RELEASE, "agent");
            asm volatile("s_waitcnt vmcnt(0)" ::: "memory");
            const unsigned og = xb_add(&bar[XB_TOP], 1u);
            const unsigned tg = og / nx;
            if (og + 1u == (tg + 1u) * nx) xb_add(&bar[XB_TOPGEN], 1u);
            else XB_SPIN(xb_ld(&bar[XB_TOPGEN]) == tg, bar);
            __builtin_amdgcn_fence(__ATOMIC_ACQUIRE, "agent");
            xb_add(&bar[XB_XGEN(b.x)], 1u);
            asm volatile("s_waitcnt vmcnt(0)" ::: "memory");
        } else {
            XB_SPIN(xb_ld(&bar[XB_XGEN(b.x)]) == gen, bar);
            __builtin_amdgcn_fence(__ATOMIC_ACQUIRE, "agent");
            asm volatile("s_waitcnt vmcnt(0)" ::: "memory");
        }
    }
    __syncthreads();
}

constexpr int LDS_BYTES = 147456;
template <class Epi> DI void run_gemm(LAS uchar* lds, const bf16_t* A, int lda, const bf16_t* Bt, int M, int N, int K, const Epi& E) {
    pg8::Gemm g{A, Bt, M, N, K, lda}; pg8::StaticOrder S; S.init(M, N, (int)gridDim.x, (int)blockIdx.x);
    pg8::gemm_phase<Epi, pg8::StaticOrder, true, true>(lds, g, S, E);
}
__global__ void __launch_bounds__(512, 2) mega(Params P) {
    extern __shared__ __attribute__((aligned(16))) uchar lds_[];
    LAS uchar* lds = (LAS uchar*)lds_;
    cg::grid_group grid = cg::this_grid();
    uchar* ws = P.ws;
    volatile LAS unsigned* bst = (volatile LAS unsigned*)(lds + LDS_BYTES - 16);
    if (threadIdx.x < 4) bst[threadIdx.x] = 0u;
    __syncthreads();
    const XcdBarrier bar = xcd_barrier_post((unsigned*)(ws + WS_BAR), bst);
    bf16_t* lat = (bf16_t*)(ws + WS_LAT); float* ss = (float*)(ws + WS_SS);
    p0_prologue(P, lds);
    grid.sync();
    { EpiIn E{(bf16_t*)(ws + WS_Z), (bf16_t*)(ws + WS_XBC), lat, (float*)(ws + WS_DT)};
      run_gemm(lds, (const bf16_t*)(ws + WS_H), DM, (const bf16_t*)(ws + WS_WIN), T, DINP, DM, E); }
    xcd_barrier(bar);
    p2_prep(P);
    xcd_barrier(bar);
    p3_s1_states(P, lds);
    xcd_barrier(bar);
    p3_s2_scan(P);
    xcd_barrier(bar);
    p3_s3_output(P, lds);
    xcd_barrier(bar);
    { EpiPlain E{(bf16_t*)P.out, NQ, QSCALE};
      run_gemm(lds, lat, NLAT, (const bf16_t*)(ws + WS_WQB), T, NQ, 384, E); }
    __syncthreads();
    { EpiPlain E{(bf16_t*)(ws + WS_KV), NKV, 1.0f};
      run_gemm(lds, lat + 384, NLAT, (const bf16_t*)(ws + WS_WKVB), T, NKV, 256, E); }
    xcd_barrier(bar);
    p5_attention(P, lds);
    xcd_barrier(bar);
    { EpiRes E{P.xp, P.xs, P.out, (bf16_t*)(ws + WS_X1B), ss, 0};
      run_gemm(lds, (const bf16_t*)(ws + WS_MIX), 2048, (const bf16_t*)(ws + WS_WOUT), T, DM, 2048, E); }
    xcd_barrier(bar);
#pragma unroll 1
    for (int ch = 0; ch < 2; ++ch) {
        const int r0 = ch == 0 ? 0 : CH0_ROWS, rows = ch == 0 ? CH0_ROWS : CH1_ROWS;
        { EpiGU E{(bf16_t*)(ws + WS_G), (bf16_t*)(ws + WS_U), ss, r0};
          run_gemm(lds, (const bf16_t*)(ws + WS_X1B) + (size_t)r0 * DM, DM, (const bf16_t*)(ws + WS_WGU), rows, NGU, DM, E); }
        xcd_barrier(bar);
        p8_act(P, rows, r0);
        xcd_barrier(bar);
        { EpiRes E{P.out, P.out + (size_t)TP * DM, P.out, nullptr, ss + T, r0};
          run_gemm(lds, (const bf16_t*)(ws + WS_U), DFF, (const bf16_t*)(ws + WS_WDN), rows, DM, DFF, E); }
        xcd_barrier(bar);
    }
    p_final(P);
}

extern "C" void kernel_launch(void* const* d_in, const int* in_sizes, int n_in, void* d_out, int out_size, void* d_ws, size_t ws_size, hipStream_t stream) {
    static int grid = 0;
    if (grid == 0) {
        int dev = 0, cus = 0, per_cu = 0;
        hipGetDevice(&dev); hipDeviceGetAttribute(&cus, hipDeviceAttributeMultiprocessorCount, dev);
        hipFuncSetAttribute((const void*)mega, hipFuncAttributeMaxDynamicSharedMemorySize, LDS_BYTES);
        if (hipOccupancyMaxActiveBlocksPerMultiprocessor(&per_cu, (const void*)mega, 512, LDS_BYTES) != hipSuccess || per_cu < 1) per_cu = 1;
        (void)hipGetLastError();
        grid = cus * per_cu;
        if (ws_size < 1020 * MiB) fprintf(stderr, "kernel_launch: workspace too small: %zu\n", ws_size);
    }
    (void)hipMemsetAsync((char*)d_ws + WS_BAR, 0, 16384, stream);
    Params p{};
    const float** pf = (const float**)&p;
    for (int i = 0; i < 24; ++i) pf[i] = (const float*)d_in[i];
    p.out = (float*)d_out; p.ws = (uchar*)d_ws;
    void* args[] = {&p};
    hipError_t e = hipLaunchCooperativeKernel((const void*)mega, dim3(grid), dim3(512), args, LDS_BYTES, stream);
    if (e != hipSuccess) fprintf(stderr, "cooperative launch failed: %s (grid %d)\n", hipGetErrorString(e), grid);
}
```

```cpp
#include <hip/hip_runtime.h>
#include <hip/hip_cooperative_groups.h>
#include <cstdio>
#include <cstdint>
namespace cg = cooperative_groups;
namespace pg8 {
#define PG8_LAS __attribute__((address_space(3)))
typedef unsigned short bf16_t;
typedef short bf16x8 __attribute__((ext_vector_type(8)));
typedef float f32x4 __attribute__((ext_vector_type(4)));
typedef unsigned u32x4 __attribute__((ext_vector_type(4)));
constexpr int BM = 256, BK = 64, HALF = 128, HTB = HALF * BK * 2  , STAGE_BYTES = 8 * HTB, NXCD = 8, WGM = 8;
__host__ __device__ __forceinline__ int lds_byte(int r, int c) { const int st = (r >> 4) * 2 + (c >> 5), rr = r & 15, cc = c & 31, ob = rr * 64 + cc * 2; return st * 1024 + (ob ^ (((ob >> 9) & 1) << 5)); }
__host__ __device__ __forceinline__ void stage_rc(int b, int& R, int& C) { const int st = b / 1024, sb = b % 1024, swz = sb ^ (((sb >> 9) & 1) << 5); R = (st >> 1) * 16 + swz / 64; C = (st & 1) * 32 + (swz % 64) / 2; }
__host__ __device__ __forceinline__ int perm32(int rho) { const int n = rho >> 4, i = rho & 15; return 8 * (i >> 2) + 4 * n + (i & 3); }
struct Unit { int pm, pn; };
struct Gemm { const bf16_t* A; const bf16_t* Bt; int M, N, K, lda; };
struct StaticOrder {
    int nM, nN, nwg, G, c;
    __host__ __device__ void init(int M, int N, int G_, int c_) { nM = M / BM; nN = N / BM; nwg = nM * nN; G = G_; c = c_; }
    __host__ __device__ bool next(int i, Unit& u) const {
        const long L = (long)i * G + c; if (L >= nwg) return false;
        int wgid = (int)L; { const int q = nwg / NXCD, r = nwg % NXCD, xcd = wgid % NXCD, off = wgid / NXCD; wgid = (xcd < r ? xcd * (q + 1) : r * (q + 1) + (xcd - r) * q) + off; }
        const int nig = WGM * nN, gid = wgid / nig, fm = gid * WGM, gsz = (nM - fm) < WGM ? (nM - fm) : WGM;
        u.pm = fm + ((wgid % nig) % gsz); u.pn = (wgid % nig) / gsz; return true;
    }
    __device__ __forceinline__ void a_ready(const Unit&) const {}
    __device__ __forceinline__ void done(const Unit&) const {}
};
template <class Epi, class Sched, bool ALIGN_EPI = false, bool SP2 = false>
__device__ __forceinline__ void gemm_phase(PG8_LAS unsigned char* lds, const Gemm g, const Sched& S, const Epi& E) {
    int tid_ = threadIdx.x; asm volatile("" : "+v"(tid_)); const int tid = tid_, wid = __builtin_amdgcn_readfirstlane(tid >> 6), lane = tid & 63, wr = wid >> 2, wc = wid & 3, fr = lane & 15, fq = lane >> 4;
    const int K = g.K, nt = K / BK;
    unsigned voffA[2], voffB[2];
#pragma unroll
    for (int i = 0; i < 2; ++i) { int R, C; stage_rc(tid * 16 + i * 8192, R, C); const int Rb = Epi::PERM ? ((R & ~31) + perm32(R & 31)) : R;
        voffA[i] = (unsigned)(R * g.lda + C) * 2u; voffB[i] = (unsigned)(Rb * K + C) * 2u; }
    const size_t kstep = (size_t)(BK * 2);
    const size_t hstepB = (size_t)HALF * K * 2, hstepA = (size_t)HALF * g.lda * 2;
    const size_t tstepA = 2 * hstepA, tstepB = 2 * hstepB;
    const unsigned ldsw = (unsigned)wid * 1024u;
    const int aoff = lds_byte(wr * 64 + fr, fq * 8), boff = lds_byte(wc * 32 + fr, fq * 8);
#define PG8_SA(b, h) (((b) * 2 + (h)) * HTB)
#define PG8_SB(b, h) ((4 + (b) * 2 + (h)) * HTB)
#define PG8_STAGE(bufoff, gbase, voff) do { _Pragma("unroll") for (int _i = 0; _i < 2; ++_i) \
        __builtin_amdgcn_global_load_lds((const unsigned*)((const char*)(gbase) + (voff)[_i]), (PG8_LAS unsigned*)(lds + (bufoff) + ldsw + _i * 8192), 16, 0, 0); } while (0)
#define PG8_LDA(dst, b, h) do { _Pragma("unroll") for (int m = 0; m < 4; ++m) _Pragma("unroll") for (int k = 0; k < 2; ++k) dst[m][k] = *(const PG8_LAS bf16x8*)(lds + PG8_SA(b, h) + aoff + m * 2048 + k * 1024); } while (0)
#define PG8_LDB(dst, b, h) do { _Pragma("unroll") for (int n = 0; n < 2; ++n) _Pragma("unroll") for (int k = 0; k < 2; ++k) dst[n][k] = *(const PG8_LAS bf16x8*)(lds + PG8_SB(b, h) + boff + n * 2048 + k * 1024); } while (0)
#define PG8_MMA(ai, bj, At, Bt) do { __builtin_amdgcn_s_setprio(1); _Pragma("unroll") for (int m = 0; m < 4; ++m) _Pragma("unroll") for (int n = 0; n < 2; ++n) _Pragma("unroll") for (int k = 0; k < 2; ++k) \
        acc[ai][bj][m][n] = __builtin_amdgcn_mfma_f32_16x16x32_bf16(Bt[n][k], At[m][k], acc[ai][bj][m][n], 0, 0, 0); __builtin_amdgcn_s_setprio(0); } while (0)
#define PG8_WAIT_V(n) asm volatile("s_waitcnt vmcnt(" #n ")" ::: "memory")
#define PG8_WAIT_L(n) asm volatile("s_waitcnt lgkmcnt(" #n ")" ::: "memory")
#define PG8_BAR __builtin_amdgcn_s_barrier()
#define PG8_SCHED __builtin_amdgcn_sched_barrier(0)
    Unit cur, nxt; int ui = 0;
    if (!S.next(0, cur)) return;
    f32x4 acc[2][2][4][2];
#pragma unroll
    for (int a = 0; a < 2; ++a)
#pragma unroll
        for (int b = 0; b < 2; ++b)
#pragma unroll
            for (int m = 0; m < 4; ++m)
#pragma unroll
                for (int n = 0; n < 2; ++n) acc[a][b][m][n] = (f32x4){0.f, 0.f, 0.f, 0.f};
    bf16x8 At[4][2], B0[2][2], B1[2][2];
    const char* cA = (const char*)g.A + (size_t)cur.pm * tstepA; const char* cB = (const char*)g.Bt + (size_t)cur.pn * tstepB;
    S.a_ready(cur);
    if constexpr (SP2) {
        PG8_STAGE(PG8_SB(0, 0), cB, voffB); PG8_STAGE(PG8_SB(0, 1), cB + hstepB, voffB); PG8_STAGE(PG8_SA(0, 0), cA, voffA); PG8_STAGE(PG8_SA(0, 1), cA + hstepA, voffA);
        if (wr == 1) PG8_BAR;
        PG8_WAIT_V(2); PG8_BAR;
        PG8_STAGE(PG8_SB(1, 0), cB + kstep, voffB); PG8_STAGE(PG8_SA(1, 0), cA + kstep, voffA); PG8_STAGE(PG8_SB(1, 1), cB + hstepB + kstep, voffB);
        PG8_WAIT_V(6); PG8_BAR;
    } else {
        PG8_STAGE(PG8_SB(0, 0), cB, voffB); PG8_STAGE(PG8_SA(0, 0), cA, voffA); PG8_STAGE(PG8_SB(0, 1), cB + hstepB, voffB); PG8_STAGE(PG8_SA(0, 1), cA + hstepA, voffA);
        if (wr == 1) PG8_BAR;
        PG8_WAIT_V(4); PG8_BAR;
        PG8_STAGE(PG8_SB(1, 0), cB + kstep, voffB); PG8_STAGE(PG8_SA(1, 0), cA + kstep, voffA); PG8_STAGE(PG8_SB(1, 1), cB + hstepB + kstep, voffB);
        PG8_WAIT_V(6); PG8_BAR;
    }
    for (;;) {
        const bool has_next = S.next(ui + 1, nxt);
        const char* nA = has_next ? (const char*)g.A + (size_t)nxt.pm * tstepA : cA; const char* nB = has_next ? (const char*)g.Bt + (size_t)nxt.pn * tstepB : cB;
        for (int t = 0; t < nt; t += 2) {
            const bool last = (t == nt - 2);
            const char* a1 = cA + (size_t)(t + 1) * kstep;
            const char* a2 = last ? nA : cA + (size_t)(t + 2) * kstep; const char* b2 = last ? nB : cB + (size_t)(t + 2) * kstep;
            const char* a3 = a2 + kstep; const char* b3 = b2 + kstep;
            if (last && has_next) S.a_ready(nxt);
            if constexpr (SP2) {
            PG8_LDB(B0, 0, 0); PG8_LDB(B1, 0, 1); PG8_SCHED; PG8_LDA(At, 0, 0); PG8_STAGE(PG8_SA(1, 1), a1 + hstepA, voffA);
            PG8_WAIT_V(8); PG8_WAIT_L(0); PG8_BAR; PG8_MMA(0, 0, At, B0); PG8_MMA(0, 1, At, B1); PG8_BAR; PG8_SCHED;
            PG8_LDA(At, 0, 1); PG8_STAGE(PG8_SB(0, 0), b2, voffB); PG8_STAGE(PG8_SB(0, 1), b2 + hstepB, voffB); PG8_STAGE(PG8_SA(0, 0), a2, voffA);
            PG8_WAIT_V(8); PG8_WAIT_L(0); PG8_BAR; PG8_MMA(1, 0, At, B0); PG8_MMA(1, 1, At, B1); PG8_BAR; PG8_SCHED;
            PG8_LDB(B0, 1, 0); PG8_LDB(B1, 1, 1); PG8_SCHED; PG8_LDA(At, 1, 0); PG8_STAGE(PG8_SA(0, 1), a2 + hstepA, voffA);
            PG8_WAIT_V(8); PG8_WAIT_L(0); PG8_BAR; PG8_MMA(0, 0, At, B0); PG8_MMA(0, 1, At, B1); PG8_BAR; PG8_SCHED;
            PG8_LDA(At, 1, 1); PG8_STAGE(PG8_SB(1, 0), b3, voffB); PG8_STAGE(PG8_SB(1, 1), b3 + hstepB, voffB); PG8_STAGE(PG8_SA(1, 0), a3, voffA);
            PG8_WAIT_V(8); PG8_WAIT_L(0); PG8_BAR; PG8_MMA(1, 0, At, B0); PG8_MMA(1, 1, At, B1); PG8_BAR; PG8_SCHED;
            } else {
            PG8_LDB(B0, 0, 0); PG8_SCHED; PG8_LDA(At, 0, 0); PG8_STAGE(PG8_SA(1, 1), a1 + hstepA, voffA);
            PG8_WAIT_L(8); PG8_BAR; PG8_WAIT_L(0); PG8_MMA(0, 0, At, B0); PG8_BAR; PG8_SCHED;
            PG8_LDB(B1, 0, 1); PG8_STAGE(PG8_SB(0, 0), b2, voffB);
            PG8_BAR; PG8_WAIT_L(0); PG8_MMA(0, 1, At, B1); PG8_BAR;
            PG8_LDA(At, 0, 1); PG8_STAGE(PG8_SA(0, 0), a2, voffA);
            PG8_BAR; PG8_WAIT_L(0); PG8_MMA(1, 0, At, B0); PG8_BAR; PG8_SCHED;
            PG8_STAGE(PG8_SB(0, 1), b2 + hstepB, voffB);
            PG8_WAIT_V(6); PG8_BAR; PG8_MMA(1, 1, At, B1); PG8_BAR;
            PG8_LDB(B0, 1, 0); PG8_SCHED; PG8_LDA(At, 1, 0); PG8_STAGE(PG8_SA(0, 1), a2 + hstepA, voffA);
            PG8_WAIT_L(8); PG8_BAR; PG8_WAIT_L(0); PG8_MMA(0, 0, At, B0); PG8_BAR; PG8_SCHED;
            PG8_LDB(B1, 1, 1); PG8_STAGE(PG8_SB(1, 0), b3, voffB);
            PG8_BAR; PG8_WAIT_L(0); PG8_MMA(0, 1, At, B1); PG8_BAR;
            PG8_LDA(At, 1, 1); PG8_STAGE(PG8_SA(1, 0), a3, voffA);
            PG8_BAR; PG8_WAIT_L(0); PG8_MMA(1, 0, At, B0); PG8_BAR; PG8_SCHED;
            PG8_STAGE(PG8_SB(1, 1), b3 + hstepB, voffB);
            PG8_WAIT_V(6); PG8_BAR; PG8_MMA(1, 1, At, B1); PG8_BAR;
            }
        }
        if constexpr (ALIGN_EPI) { if (wr == 0) PG8_BAR; }
        if constexpr (!Epi::AFTER_DRAIN) { E(acc, cur, wr, wc, fr, fq); S.done(cur); }
        if (!has_next) break;
#pragma unroll
        for (int a = 0; a < 2; ++a)
#pragma unroll
            for (int b = 0; b < 2; ++b)
#pragma unroll
                for (int m = 0; m < 4; ++m)
#pragma unroll
                    for (int n = 0; n < 2; ++n) acc[a][b][m][n] = (f32x4){0.f, 0.f, 0.f, 0.f};
        cur = nxt; cA = nA; cB = nB; ++ui;
        if constexpr (ALIGN_EPI) { if (wr == 1) PG8_BAR; }
    }
    PG8_WAIT_V(0);
    if constexpr (!ALIGN_EPI) { if (wr == 0) PG8_BAR; }
    PG8_BAR;
    if constexpr (Epi::AFTER_DRAIN) { E.fused(acc, cur, wr, wc, fr, fq, lds, wid, lane); S.done(cur); }
#undef PG8_SA
#undef PG8_SB
#undef PG8_STAGE
#undef PG8_LDA
#undef PG8_LDB
#undef PG8_MMA
#undef PG8_WAIT_V
#undef PG8_WAIT_L
#undef PG8_BAR
#undef PG8_SCHED
}
}

#define DI __device__ __forceinline__
#define LAS __attribute__((address_space(3)))
typedef unsigned short bf16_t;
typedef unsigned char uchar;
typedef short bf16x8 __attribute__((ext_vector_type(8)));
typedef short s16x4 __attribute__((ext_vector_type(4)));
typedef float f32x4 __attribute__((ext_vector_type(4)));
typedef float f32x16 __attribute__((ext_vector_type(16)));
typedef unsigned u32x4 __attribute__((ext_vector_type(4)));
typedef unsigned u32x2 __attribute__((ext_vector_type(2)));
typedef float f32x2_t __attribute__((ext_vector_type(2)));
typedef __bf16 bf16x2_t __attribute__((ext_vector_type(2)));

constexpr int T = 81920, TP = 65536, DM = 1024;
constexpr int LP = 2048, LS = 16384;
constexpr int DIN = 3008, DINP = 3072;
constexpr int NQ = 1536, NKV = 2048, NLAT = 768, NXBC = 1280;
constexpr int DFF = 2816, NGU = 5632;
constexpr float EPS = 1e-6f;
constexpr float QSCALE = 0.10206207261596575f * 1.4426950408889634f;
constexpr int CH0_ROWS = 49152, CH1_ROWS = 32768;

constexpr size_t MiB = 1u << 20;
constexpr size_t WS_WIN = 0, WS_WQB = 6 * MiB, WS_WKVB = 8 * MiB, WS_WOUT = 9 * MiB, WS_WGU = 13 * MiB, WS_WDN = 24 * MiB;
constexpr size_t WS_TAB = 30 * MiB;
constexpr size_t WS_H = 32 * MiB;
constexpr size_t WS_XBC = 192 * MiB;
constexpr size_t WS_MIX = 32 * MiB;
constexpr size_t WS_Z = 392 * MiB;
constexpr size_t WS_LAT = 552 * MiB;
constexpr size_t WS_DT = 672 * MiB;
constexpr size_t WS_XBC2 = 682 * MiB;
constexpr size_t WS_KV = 682 * MiB;
constexpr size_t WS_X1B = 352 * MiB;
constexpr size_t WS_SS = 1004 * MiB;
constexpr size_t WS_BAR = 1006 * MiB;
constexpr size_t WS_G = 32 * MiB;
constexpr size_t WS_U = 512 * MiB;
constexpr size_t WS_ACT = 512 * MiB;
constexpr size_t WS_HALO = 32 * MiB;
constexpr size_t WS_HALO2 = 890 * MiB;
constexpr int XCH_OFF = 131072;
static_assert(WS_XBC2 + (size_t)T * NXBC * 2 <= WS_SS && WS_KV + (size_t)T * NKV * 2 <= WS_SS, "ws map");
static_assert(WS_G + (size_t)CH0_ROWS * DFF * 2 <= WS_X1B && WS_X1B + (size_t)T * DM * 2 <= WS_U && WS_U + (size_t)CH0_ROWS * DFF * 2 <= WS_SS, "ws map 2");
static_assert(WS_MIX + (size_t)T * 2048 * 2 <= WS_X1B, "ws map 3");
static_assert(WS_ACT + (size_t)T * DFF * 2 <= WS_SS && WS_HALO + (size_t)3 * 320 * 2 * DFF * 4 <= WS_X1B, "ws map 4");

struct Params {
    const float *xp, *xs, *norm1, *w_in, *q_a_norm, *kv_a_norm, *w_q_b, *w_kv_b, *conv_w, *conv_b, *dt_bias_f, *dt_bias_b, *a_log_f, *a_log_b,
        *d_skip, *ssm_norm, *w_out, *norm2, *w_gate, *w_up, *ffn_conv_w, *ffn_conv_b, *w_down, *final_norm;
    float* out; uchar* ws;
};

DI int otid() { int t = threadIdx.x; asm volatile("" : "+v"(t)); return t; }
#ifndef PROBE_MASK
#define PROBE_MASK 0u
#endif
#define PROBE_K 1
#define PB(id) do { if (PROBE_MASK && blockIdx.x == 0 && ((PROBE_MASK >> (id)) & 1u)) tA_ = __builtin_amdgcn_s_memrealtime(); } while (0)
#define PE(id) do { if (PROBE_MASK && blockIdx.x == 0 && ((PROBE_MASK >> (id)) & 1u)) tacc_ += __builtin_amdgcn_s_memrealtime() - tA_; } while (0)
DI float bf2f(bf16_t v) { return __uint_as_float((unsigned)v << 16); }
DI unsigned pk2(float lo, float hi) { f32x2_t v = {lo, hi}; bf16x2_t b = __builtin_convertvector(v, bf16x2_t); return __builtin_bit_cast(unsigned, b); }
DI void unpack8(const u32x4 w, float (&f)[8]) {
#pragma unroll
    for (int i = 0; i < 4; ++i) { f[2 * i] = __uint_as_float(w[i] << 16); f[2 * i + 1] = __uint_as_float(w[i] & 0xffff0000u); }
}
DI u32x4 pack8(const float (&f)[8]) { u32x4 w; w.x = pk2(f[0], f[1]); w.y = pk2(f[2], f[3]); w.z = pk2(f[4], f[5]); w.w = pk2(f[6], f[7]); return w; }
DI float wave_sum(float v) {
#pragma unroll
    for (int o = 1; o < 64; o <<= 1) v += __shfl_xor(v, o);
    return v;
}
DI const float* xrow(const Params& P, int row) { return row < TP ? P.xp + (size_t)row * DM : P.xs + (size_t)(row - TP) * DM; }
DI int posof(int row) { return row < TP ? (row & (LP - 1)) : row - TP; }
DI int lenof(int row) { return row < TP ? LP : LS; }
DI float silu(float v) { return v * __builtin_amdgcn_rcpf(1.f + __builtin_amdgcn_exp2f(v * -1.4426950408889634f)); }

#define EPI_LOOP_BEGIN \
    _Pragma("unroll") for (int ai = 0; ai < 2; ++ai) _Pragma("unroll") for (int m = 0; m < 4; ++m) { const int row = u.pm * 256 + ai * 128 + wr * 64 + m * 16 + fr; \
    _Pragma("unroll") for (int bj = 0; bj < 2; ++bj) { const f32x4 v0 = acc[ai][bj][m][0], v1 = acc[ai][bj][m][1];
#define EPI_LOOP_END } }

DI float dpp_ror1(float v) { return __builtin_bit_cast(float, __builtin_amdgcn_update_dpp(0, __builtin_bit_cast(int, v), 0x121, 0xf, 0xf, false)); }
DI float dpp_ror15(float v) { return __builtin_bit_cast(float, __builtin_amdgcn_update_dpp(0, __builtin_bit_cast(int, v), 0x12F, 0xf, 0xf, false)); }
struct EpiIn2 {
    static constexpr bool PERM = true, AFTER_DRAIN = false;
    bf16_t *z, *xbc2, *lat; float* dt; float *ssq, *ssk; const float* tab; const float* cw; const float* cb; float* halo; LAS float* xch; const float *dtbf, *dtbb;
    DI void operator()(const f32x4 (&acc)[2][2][4][2], const pg8::Unit& u, int wr, int wc, int fr, int fq) const {
        const int lane = fr + 16 * fq;
        if (u.pn < 4) {
            const int col0 = u.pn * 256 + wc * 32 + 8 * fq;
            EPI_LOOP_BEGIN
                u32x4 w; w.x = pk2(v0[0], v0[1]); w.y = pk2(v0[2], v0[3]); w.z = pk2(v1[0], v1[1]); w.w = pk2(v1[2], v1[3]);
                *(u32x4*)(z + (size_t)row * DM + col0 + bj * 128) = w;
            EPI_LOOP_END
        } else if (u.pn < 9) {
            int cl_ = wc * 32 + 8 * fq; asm volatile("" : "+v"(cl_)); const int cl = cl_;
            LAS float* wtab = xch + 2048;
            { const int tid_ = (wr * 4 + wc) * 64 + lane;
              if (tid_ < 256) { const int ch = (u.pn - 4) * 256 + tid_; wtab[tid_] = cw[ch]; wtab[256 + tid_] = cw[NXBC + ch]; wtab[512 + tid_] = cw[2 * NXBC + ch]; wtab[768 + tid_] = cb[ch]; } }
#pragma unroll
            for (int ai = 0; ai < 2; ++ai)
#pragma unroll
                for (int bj = 0; bj < 2; ++bj) {
                    LAS float* xs = xch + (ai * 2 + wr) * 512 + bj * 128 + cl;
                    if (fr == 0) { *(LAS f32x4*)xs = acc[ai][bj][0][0]; *(LAS f32x4*)(xs + 4) = acc[ai][bj][0][1]; }
                    if (fr == 15) { *(LAS f32x4*)(xs + 256) = acc[ai][bj][3][0]; *(LAS f32x4*)(xs + 260) = acc[ai][bj][3][1]; }
                }
            asm volatile("s_waitcnt lgkmcnt(0)" ::: "memory"); __builtin_amdgcn_s_barrier(); asm volatile("" ::: "memory");
            const f32x4 zero4 = {0.f, 0.f, 0.f, 0.f};
#pragma unroll
            for (int bj = 0; bj < 2; ++bj)
#pragma unroll
                for (int ai = 0; ai < 2; ++ai) {
                    const int strip = ai * 2 + wr; const int tl0 = bj * 128 + cl, chg = (u.pn - 4) * 256 + tl0;
#pragma unroll
                    for (int m = 0; m < 4; ++m) {
                        const int row = u.pm * 256 + ai * 128 + wr * 64 + m * 16 + fr;
                        const bool first = (strip == 0 && m == 0 && fr == 0), last = (strip == 3 && m == 3 && fr == 15);
                        u32x2 ob[2];
#pragma unroll
                        for (int jh = 0; jh < 2; ++jh) {
                            const LAS float* wp = wtab + tl0 + 4 * jh;
                            const f32x4 w0 = *(const LAS f32x4*)wp, w1 = *(const LAS f32x4*)(wp + 256), w2 = *(const LAS f32x4*)(wp + 512), bb = *(const LAS f32x4*)(wp + 768);
                            const f32x4 en = (m == 3 && strip < 3) ? *(const LAS f32x4*)(xch + (strip + 1) * 512 + tl0 + 4 * jh) : zero4;
                            const f32x4 ep = (m == 0 && strip > 0) ? *(const LAS f32x4*)(xch + (strip - 1) * 512 + 256 + tl0 + 4 * jh) : zero4;
                            f32x4 dnc, dnq, upn, upc;
#pragma unroll
                            for (int k = 0; k < 4; ++k) { dnc[k] = dpp_ror1(acc[ai][bj][m][jh][k]); dnq[k] = m > 0 ? dpp_ror1(acc[ai][bj][m > 0 ? m - 1 : 0][jh][k]) : ep[k];
                                upc[k] = dpp_ror15(acc[ai][bj][m][jh][k]); upn[k] = m < 3 ? dpp_ror15(acc[ai][bj][m < 3 ? m + 1 : 3][jh][k]) : en[k]; }
                            const f32x4 prev = fr == 0 ? dnq : dnc;
                            const f32x4 next = fr == 15 ? upn : upc;
                            const f32x4 part = w0 * prev + w1 * acc[ai][bj][m][jh] + w2 * next + bb;
                            ob[jh].x = pk2(silu(part[0]), silu(part[1])); ob[jh].y = pk2(silu(part[2]), silu(part[3]));
                            if (first || last) { const size_t ho = ((size_t)u.pm * 2 + (last ? 1 : 0)) * NXBC + chg + 4 * jh; *(f32x4*)(halo + ho) = part; *(f32x4*)(halo + (size_t)320 * 2 * NXBC + ho) = acc[ai][bj][m][jh]; }
                        }
                        *(u32x4*)(xbc2 + (size_t)row * NXBC + chg) = (u32x4){ob[0].x, ob[0].y, ob[1].x, ob[1].y};
                    }
                }
            asm volatile("s_waitcnt lgkmcnt(0)" ::: "memory"); __builtin_amdgcn_s_barrier(); asm volatile("" ::: "memory");
        } else {
            const int colt = (u.pn - 9) * 256, col0 = colt + wc * 32 + 8 * fq;
#pragma unroll
            for (int ai = 0; ai < 2; ++ai)
#pragma unroll
                for (int m = 0; m < 4; ++m) {
                    const int row = u.pm * 256 + ai * 128 + wr * 64 + m * 16 + fr;
#pragma unroll
                    for (int bj = 0; bj < 2; ++bj) {
                        const f32x4 v0 = acc[ai][bj][m][0], v1 = acc[ai][bj][m][1];
                        const int c = col0 + bj * 128;
                        if (c < 640) {
                            u32x4 w; w.x = pk2(v0[0], v0[1]); w.y = pk2(v0[2], v0[3]); w.z = pk2(v1[0], v1[1]); w.w = pk2(v1[2], v1[3]);
                            *(u32x4*)(lat + (size_t)row * NLAT + c) = w;
                            float sq = (v0[0] * v0[0] + v0[1] * v0[1]) + (v0[2] * v0[2] + v0[3] * v0[3]) + (v1[0] * v1[0] + v1[1] * v1[1]) + (v1[2] * v1[2] + v1[3] * v1[3]);
                            sq += __shfl_xor(sq, 16); sq += __shfl_xor(sq, 32);
                            if (fq == 0) atomicAdd((c < 384 ? ssq : ssk) + row, sq);
                        } else if (c < 672) {
                            const float* tp = tab + ((size_t)posof(row) * 16 + 4 * fq) * 2;
                            const f32x4 c0 = *(const f32x4*)tp, c1 = *(const f32x4*)(tp + 4);
                            u32x4 w;
                            w.x = pk2(v0[0] * c0[0] - v0[1] * c0[1], v0[1] * c0[0] + v0[0] * c0[1]); w.y = pk2(v0[2] * c0[2] - v0[3] * c0[3], v0[3] * c0[2] + v0[2] * c0[3]);
                            w.z = pk2(v1[0] * c1[0] - v1[1] * c1[1], v1[1] * c1[0] + v1[0] * c1[1]); w.w = pk2(v1[2] * c1[2] - v1[3] * c1[3], v1[3] * c1[2] + v1[2] * c1[3]);
                            *(u32x4*)(lat + (size_t)row * NLAT + c) = w;
                        } else if (c < 704) {
                            const float* bp = (fq < 2 ? dtbf + 8 * fq : dtbb + 8 * (fq - 2));
                            const f32x4 b0 = *(const f32x4*)bp, b1 = *(const f32x4*)(bp + 4);
                            f32x4 o0, o1;
#pragma unroll
                            for (int k = 0; k < 4; ++k) { const float a = v0[k] + b0[k], b = v1[k] + b1[k]; o0[k] = fmaxf(a, 0.f) + __logf(1.f + __expf(-fabsf(a))); o1[k] = fmaxf(b, 0.f) + __logf(1.f + __expf(-fabsf(b))); }
                            float* d = dt + (size_t)row * 32 + 8 * fq; *(f32x4*)d = o0; *(f32x4*)(d + 4) = o1;
                        }
                    }
                }
        }
    }
};
struct EpiIn {
    static constexpr bool PERM = true, AFTER_DRAIN = false;
    bf16_t *z, *xbc, *lat; float* dt;
    DI void operator()(const f32x4 (&acc)[2][2][4][2], const pg8::Unit& u, int wr, int wc, int fr, int fq) const {
        bf16_t* base; int ld, colt;
        if (u.pn < 4) { base = z; ld = DM; colt = u.pn * 256; } else if (u.pn < 9) { base = xbc; ld = NXBC; colt = (u.pn - 4) * 256; } else { base = lat; ld = NLAT; colt = (u.pn - 9) * 256; }
        const int col0 = colt + wc * 32 + 8 * fq;
        EPI_LOOP_BEGIN
            u32x4 w; w.x = pk2(v0[0], v0[1]); w.y = pk2(v0[2], v0[3]); w.z = pk2(v1[0], v1[1]); w.w = pk2(v1[2], v1[3]);
            *(u32x4*)(base + (size_t)row * ld + col0 + bj * 128) = w;
            if (u.pn == 11 && bj == 1 && wc == 1) { float* d = dt + (size_t)row * 32 + 8 * fq; *(f32x4*)d = v0; *(f32x4*)(d + 4) = v1; }
        EPI_LOOP_END
    }
};
struct EpiPlain {
    static constexpr bool PERM = true, AFTER_DRAIN = false;
    bf16_t* o; int ld; float sc0; const float* ssr; float invn;
    DI void operator()(const f32x4 (&acc)[2][2][4][2], const pg8::Unit& u, int wr, int wc, int fr, int fq) const {
        const int col0 = u.pn * 256 + wc * 32 + 8 * fq;
        EPI_LOOP_BEGIN
            const float sc = sc0 * rsqrtf(ssr[row] * invn + EPS);
            u32x4 w; w.x = pk2(v0[0] * sc, v0[1] * sc); w.y = pk2(v0[2] * sc, v0[3] * sc); w.z = pk2(v1[0] * sc, v1[1] * sc); w.w = pk2(v1[2] * sc, v1[3] * sc);
            *(u32x4*)(o + (size_t)row * ld + col0 + bj * 128) = w;
        EPI_LOOP_END
    }
};
struct EpiRes {
    static constexpr bool PERM = true, AFTER_DRAIN = false;
    const float* resp; const float* ress; float* xo; bf16_t* xb; float* ss; int row_off; const bf16_t* resb;
    DI void operator()(const f32x4 (&acc)[2][2][4][2], const pg8::Unit& u, int wr, int wc, int fr, int fq) const {
        const int col0 = u.pn * 256 + wc * 32 + 8 * fq;
#pragma unroll
        for (int ai = 0; ai < 2; ++ai)
#pragma unroll
            for (int m = 0; m < 4; ++m) {
                const int row = row_off + u.pm * 256 + ai * 128 + wr * 64 + m * 16 + fr;
                const float* rp = (row < TP ? resp + (size_t)row * DM : ress + (size_t)(row - TP) * DM) + col0;
                float s = 0.f;
#pragma unroll
                for (int bj = 0; bj < 2; ++bj) {
                    f32x4 r0, r1;
                    if (resb) { float rf[8]; unpack8(*(const u32x4*)(resb + (size_t)row * DM + col0 + bj * 128), rf); r0 = (f32x4){rf[0], rf[1], rf[2], rf[3]}; r1 = (f32x4){rf[4], rf[5], rf[6], rf[7]}; }
                    else { r0 = *(const f32x4*)(rp + bj * 128); r1 = *(const f32x4*)(rp + bj * 128 + 4); }
                    const f32x4 a = acc[ai][bj][m][0] + r0, b = acc[ai][bj][m][1] + r1;
                    if (xo) { float* op = xo + (size_t)row * DM + col0 + bj * 128; *(f32x4*)op = a; *(f32x4*)(op + 4) = b; }
                    if (xb) { u32x4 w; w.x = pk2(a[0], a[1]); w.y = pk2(a[2], a[3]); w.z = pk2(b[0], b[1]); w.w = pk2(b[2], b[3]); *(u32x4*)(xb + (size_t)row * DM + col0 + bj * 128) = w; }
                    s += (a[0] * a[0] + a[1] * a[1]) + (a[2] * a[2] + a[3] * a[3]) + (b[0] * b[0] + b[1] * b[1]) + (b[2] * b[2] + b[3] * b[3]);
                }
                s += __shfl_xor(s, 16); s += __shfl_xor(s, 32);
                if (fq == 0) atomicAdd(ss + row, s);
            }
    }
};
struct EpiGU2 {
    static constexpr bool PERM = true, AFTER_DRAIN = false;
    bf16_t* act; const float* ss; const float* cw; const float* cb; float* halo; LAS float* xch;
    DI void operator()(const f32x4 (&acc)[2][2][4][2], const pg8::Unit& u, int wr, int wc, int fr, int fq) const {
        const int lane = fr + 16 * fq;
        int cl_ = wc * 32 + 8 * fq; asm volatile("" : "+v"(cl_)); const int cl = cl_, ch0 = u.pn * 128 + cl;
        float rs[2][4];
#pragma unroll
        for (int ai = 0; ai < 2; ++ai)
#pragma unroll
            for (int m = 0; m < 4; ++m) rs[ai][m] = rsqrtf(ss[u.pm * 256 + ai * 128 + wr * 64 + m * 16 + fr] * (1.f / DM) + EPS);
        LAS float* wtab = xch + 1024;
        { const int tid_ = (wr * 4 + wc) * 64 + lane;
          if (tid_ < 128) { const int ch = u.pn * 128 + tid_; wtab[tid_] = cw[ch]; wtab[128 + tid_] = cw[DFF + ch]; wtab[256 + tid_] = cw[2 * DFF + ch]; wtab[384 + tid_] = cb[ch]; } }
#pragma unroll
        for (int ai = 0; ai < 2; ++ai) {
            LAS float* xs = xch + (ai * 2 + wr) * 256 + cl;
            if (fr == 0) { *(LAS f32x4*)xs = acc[ai][0][0][0] * rs[ai][0]; *(LAS f32x4*)(xs + 4) = acc[ai][0][0][1] * rs[ai][0]; }
            if (fr == 15) { *(LAS f32x4*)(xs + 128) = acc[ai][0][3][0] * rs[ai][3]; *(LAS f32x4*)(xs + 132) = acc[ai][0][3][1] * rs[ai][3]; }
        }
        asm volatile("s_waitcnt lgkmcnt(0)" ::: "memory"); __builtin_amdgcn_s_barrier(); asm volatile("" ::: "memory");
        const f32x4 zero4 = {0.f, 0.f, 0.f, 0.f};
#pragma unroll
        for (int ai = 0; ai < 2; ++ai) {
            const int strip = ai * 2 + wr;
            f32x4 gc[2], dnp[2], upc[2];
#pragma unroll
            for (int jh = 0; jh < 2; ++jh) {
                gc[jh] = acc[ai][0][0][jh] * rs[ai][0];
                dnp[jh] = strip > 0 ? *(const LAS f32x4*)(xch + (strip - 1) * 256 + 128 + cl + 4 * jh) : zero4;
#pragma unroll
                for (int k = 0; k < 4; ++k) upc[jh][k] = dpp_ror15(gc[jh][k]);
            }
#pragma unroll
            for (int m = 0; m < 4; ++m) {
                const int row = u.pm * 256 + ai * 128 + wr * 64 + m * 16 + fr;
                const bool first = (strip == 0 && m == 0 && fr == 0), last = (strip == 3 && m == 3 && fr == 15);
                u32x2 ob[2];
#pragma unroll
                for (int jh = 0; jh < 2; ++jh) {
                    const LAS float* wp = wtab + cl + 4 * jh;
                    const f32x4 w0 = *(const LAS f32x4*)wp, w1 = *(const LAS f32x4*)(wp + 128), w2 = *(const LAS f32x4*)(wp + 256), bb = *(const LAS f32x4*)(wp + 384);
                    f32x4 dnc, upn, gn = gc[jh];
                    if (m < 3) gn = acc[ai][0][m < 3 ? m + 1 : 3][jh] * rs[ai][m < 3 ? m + 1 : 3];
                    const f32x4 en = (m == 3 && strip < 3) ? *(const LAS f32x4*)(xch + (strip + 1) * 256 + cl + 4 * jh) : zero4;
#pragma unroll
                    for (int k = 0; k < 4; ++k) { dnc[k] = dpp_ror1(gc[jh][k]); upn[k] = m < 3 ? dpp_ror15(gn[k]) : en[k]; }
                    const f32x4 prev = fr == 0 ? dnp[jh] : dnc;
                    const f32x4 next = fr == 15 ? upn : upc[jh];
                    const f32x4 part = w0 * prev + w1 * gc[jh] + w2 * next + bb;
                    const f32x4 uq = acc[ai][1][m][jh] * rs[ai][m];
                    ob[jh].x = pk2(silu(part[0]) * uq[0], silu(part[1]) * uq[1]); ob[jh].y = pk2(silu(part[2]) * uq[2], silu(part[3]) * uq[3]);
                    if (first || last) {
                        const size_t ho = ((size_t)u.pm * 2 + (last ? 1 : 0)) * DFF + ch0 + 4 * jh; const size_t hs = (size_t)320 * 2 * DFF;
                        *(f32x4*)(halo + ho) = part; *(f32x4*)(halo + hs + ho) = uq; *(f32x4*)(halo + 2 * hs + ho) = gc[jh];
                    }
                    dnp[jh] = dnc; upc[jh] = upn; gc[jh] = gn;
                }
                *(u32x4*)(act + (size_t)row * DFF + ch0) = (u32x4){ob[0].x, ob[0].y, ob[1].x, ob[1].y};
            }
        }
        asm volatile("s_waitcnt lgkmcnt(0)" ::: "memory"); __builtin_amdgcn_s_barrier(); asm volatile("" ::: "memory");
    }
};
struct EpiGU {
    static constexpr bool PERM = true, AFTER_DRAIN = false;
    bf16_t *g, *uo; const float* ss; int row_off;
    DI void operator()(const f32x4 (&acc)[2][2][4][2], const pg8::Unit& u, int wr, int wc, int fr, int fq) const {
        const int col0 = u.pn * 128 + wc * 32 + 8 * fq;
#pragma unroll
        for (int ai = 0; ai < 2; ++ai)
#pragma unroll
            for (int m = 0; m < 4; ++m) {
                const int lrow = u.pm * 256 + ai * 128 + wr * 64 + m * 16 + fr;
                const float rs = rsqrtf(ss[row_off + lrow] * (1.f / DM) + EPS);
#pragma unroll
                for (int bj = 0; bj < 2; ++bj) {
                    const f32x4 a = acc[ai][bj][m][0] * rs, b = acc[ai][bj][m][1] * rs;
                    u32x4 w; w.x = pk2(a[0], a[1]); w.y = pk2(a[2], a[3]); w.z = pk2(b[0], b[1]); w.w = pk2(b[2], b[3]);
                    *(u32x4*)((bj == 0 ? g : uo) + (size_t)lrow * DFF + col0) = w;
                }
            }
    }
};

template <class F> DI void transpose_item(const float* W, int K, int N, bf16_t* WT, LAS float* scr, int item, int lane, F destrow, const float* kscale) {
    const int nblk = N / 32, kb = item / nblk, nb = item % nblk, k0 = 64 * kb, n0 = 32 * nb;
    { f32x4 wv[8];
#pragma unroll
      for (int i = 0; i < 8; ++i) { const int kk = 8 * i + (lane >> 3); wv[i] = *(const f32x4*)(W + (size_t)(k0 + kk) * N + n0 + (lane & 7) * 4); }
#pragma unroll
      for (int i = 0; i < 8; ++i) { const int kk = 8 * i + (lane >> 3); const float ks = kscale ? kscale[k0 + kk] : 1.f; LAS float* d = scr + kk * 33 + (lane & 7) * 4; d[0] = wv[i][0] * ks; d[1] = wv[i][1] * ks; d[2] = wv[i][2] * ks; d[3] = wv[i][3] * ks; } }
    asm volatile("s_waitcnt lgkmcnt(0)" ::: "memory");
    const int c = lane & 7;
#pragma unroll
    for (int j = 0; j < 4; ++j) { const int n = (lane >> 3) + 8 * j; const LAS float* s = scr + (8 * c) * 33 + n;
        u32x4 o; o.x = pk2(s[0 * 33], s[1 * 33]); o.y = pk2(s[2 * 33], s[3 * 33]); o.z = pk2(s[4 * 33], s[5 * 33]); o.w = pk2(s[6 * 33], s[7 * 33]);
        *(u32x4*)(WT + (size_t)destrow(n0 + n) * K + k0 + 8 * c) = o; }
    asm volatile("s_waitcnt lgkmcnt(0)" ::: "memory");
}
struct DestIn { DI int operator()(int c) const { if (c >= 640 && c < 672) { const int i = c - 640; return 2304 + 640 + (i < 16 ? 2 * i : 2 * (i - 16) + 1); } return c < 672 ? 2304 + c : (c < 1696 ? c - 672 : (c < 2976 ? 1024 + (c - 1696) : 2304 + 672 + (c - 2976))); } };
struct DestQb { DI int operator()(int c) const { const int h = c / 96, j = c % 96; if (j < 64) return h * 64 + j; const int i = j - 64; return 1024 + h * 32 + (i < 16 ? 2 * i : 2 * (i - 16) + 1); } };
struct DestKvb { DI int operator()(int c) const { const int h = c >> 7, j = c & 127; return j < 64 ? h * 64 + j : 1024 + h * 64 + (j - 64); } };
struct DestId { DI int operator()(int c) const { return c; } };
struct DestGate { DI int operator()(int c) const { return 256 * (c >> 7) + (c & 127); } };
struct DestUp { DI int operator()(int c) const { return 256 * (c >> 7) + 128 + (c & 127); } };

DI void p0_prologue(const Params& P, LAS uchar* lds) {
    const int tid = otid(), lane = tid & 63, wave = tid >> 6, G = gridDim.x;
    const int gw = blockIdx.x * 8 + wave, NGW = G * 8;
    const int gt = blockIdx.x * 512 + tid, NGT = G * 512;
    LAS float* scr = (LAS float*)(lds + wave * 16384);
    bf16_t* Win = (bf16_t*)(P.ws + WS_WIN); bf16_t* Wqb = (bf16_t*)(P.ws + WS_WQB); bf16_t* Wkvb = (bf16_t*)(P.ws + WS_WKVB);
    bf16_t* Wout = (bf16_t*)(P.ws + WS_WOUT); bf16_t* Wgu = (bf16_t*)(P.ws + WS_WGU); bf16_t* Wdn = (bf16_t*)(P.ws + WS_WDN);
    constexpr int I_IN = 16 * 94, I_QB = 6 * 48, I_KVB = 4 * 64, I_OUT = 32 * 32, I_G = 16 * 88, I_DN = 44 * 32;
    constexpr int NITEMS = I_IN + I_QB + I_KVB + I_OUT + 2 * I_G + I_DN;
    for (int it = gw; it < NITEMS; it += NGW) {
        int r = it;
        if (r < I_IN) { transpose_item(P.w_in, 1024, DIN, Win, scr, r, lane, DestIn(), nullptr); continue; } r -= I_IN;
        if (r < I_QB) { transpose_item(P.w_q_b, 384, NQ, Wqb, scr, r, lane, DestQb(), P.q_a_norm); continue; } r -= I_QB;
        if (r < I_KVB) { transpose_item(P.w_kv_b, 256, NKV, Wkvb, scr, r, lane, DestKvb(), P.kv_a_norm); continue; } r -= I_KVB;
        if (r < I_OUT) { transpose_item(P.w_out, 2048, DM, Wout, scr, r, lane, DestId(), nullptr); continue; } r -= I_OUT;
        if (r < I_G) { transpose_item(P.w_gate, 1024, DFF, Wgu, scr, r, lane, DestGate(), P.norm2); continue; } r -= I_G;
        if (r < I_G) { transpose_item(P.w_up, 1024, DFF, Wgu, scr, r, lane, DestUp(), P.norm2); continue; } r -= I_G;
        transpose_item(P.w_down, DFF, DM, Wdn, scr, r, lane, DestId(), nullptr);
    }
    for (int i = gt; i < 64 * 1024 / 8; i += NGT) *(u32x4*)(Win + (size_t)3008 * 1024 + (size_t)i * 8) = (u32x4){0u, 0u, 0u, 0u};
    float* tab = (float*)(P.ws + WS_TAB);
    for (int i = gt; i < LS * 16; i += NGT) { const int pos = i >> 4, k = i & 15; const float inv = powf(10000.0f, -(float)(2 * k) / 32.0f); const float ang = (float)pos * inv; float s, c; sincosf(ang, &s, &c); tab[2 * i] = c; tab[2 * i + 1] = s; }
    float* ss = (float*)(P.ws + WS_SS);
    for (int i = gt; i < 4 * T; i += NGT) ss[i] = 0.f;
    bf16_t* hb = (bf16_t*)(P.ws + WS_H);
    for (int row = gw; row < T; row += NGW) {
        const f32x4* xr = (const f32x4*)xrow(P, row) + lane;
        f32x4 v[4]; float s = 0.f;
#pragma unroll
        for (int j = 0; j < 4; ++j) { v[j] = __builtin_nontemporal_load(xr + 64 * j); s += (v[j][0] * v[j][0] + v[j][1] * v[j][1]) + (v[j][2] * v[j][2] + v[j][3] * v[j][3]); }
        const float rs = rsqrtf(wave_sum(s) * (1.f / DM) + EPS);
        u32x2* o = (u32x2*)(hb + (size_t)row * DM) + lane;
#pragma unroll
        for (int j = 0; j < 4; ++j) { const f32x4 w = ((const f32x4*)P.norm1)[lane + 64 * j]; u32x2 pk; pk.x = pk2(v[j][0] * rs * w[0], v[j][1] * rs * w[1]); pk.y = pk2(v[j][2] * rs * w[2], v[j][3] * rs * w[3]); o[64 * j] = pk; }
    }
}

DI float gsum16(float v) { v += __shfl_xor(v, 1); v += __shfl_xor(v, 2); v += __shfl_xor(v, 4); v += __shfl_xor(v, 8); return v; }
template <bool ACT> DI void conv8_item(const bf16_t* src, bf16_t* dst, int ld, int lrow0, int grow0, int c0, const float* cw, const float* cb) {
    float w0[8], w1[8], w2[8], bb[8];
    { const f32x4 a0 = *(const f32x4*)(cw + c0), a1 = *(const f32x4*)(cw + c0 + 4), b0 = *(const f32x4*)(cw + ld + c0), b1 = *(const f32x4*)(cw + ld + c0 + 4);
      const f32x4 c0v = *(const f32x4*)(cw + 2 * ld + c0), c1v = *(const f32x4*)(cw + 2 * ld + c0 + 4), d0 = *(const f32x4*)(cb + c0), d1 = *(const f32x4*)(cb + c0 + 4);
#pragma unroll
      for (int j = 0; j < 4; ++j) { w0[j] = a0[j]; w0[4 + j] = a1[j]; w1[j] = b0[j]; w1[4 + j] = b1[j]; w2[j] = c0v[j]; w2[4 + j] = c1v[j]; bb[j] = d0[j]; bb[4 + j] = d1[j]; } }
    const int pos0 = posof(grow0), L = lenof(grow0);
    u32x4 raw[10], ur[8];
    const u32x4 zero4 = {0u, 0u, 0u, 0u};
    raw[0] = pos0 > 0 ? *(const u32x4*)(src + (size_t)(lrow0 - 1) * ld + c0) : zero4;
#pragma unroll
    for (int i = 0; i < 8; ++i) raw[1 + i] = *(const u32x4*)(src + (size_t)(lrow0 + i) * ld + c0);
    raw[9] = pos0 + 8 < L ? *(const u32x4*)(src + (size_t)(lrow0 + 8) * ld + c0) : zero4;
    if (ACT) {
#pragma unroll
        for (int i = 0; i < 8; ++i) ur[i] = *(const u32x4*)(dst + (size_t)(lrow0 + i) * ld + c0);
    }
    float prv[8], cur[8], nxt[8];
    unpack8(raw[0], prv); unpack8(raw[1], cur);
#pragma unroll
    for (int i = 0; i < 8; ++i) {
        unpack8(raw[2 + i], nxt);
        float o[8];
#pragma unroll
        for (int j = 0; j < 8; ++j) o[j] = silu(w0[j] * prv[j] + w1[j] * cur[j] + w2[j] * nxt[j] + bb[j]);
        if (ACT) { float uu[8]; unpack8(ur[i], uu);
#pragma unroll
            for (int j = 0; j < 8; ++j) o[j] *= uu[j]; }
        *(u32x4*)(dst + (size_t)(lrow0 + i) * ld + c0) = pack8(o);
#pragma unroll
        for (int j = 0; j < 8; ++j) { prv[j] = cur[j]; cur[j] = nxt[j]; }
    }
}
DI void p2_prep(const Params& P) {
    const int tid = otid(), lane = tid & 63, wave = tid >> 6, G = gridDim.x;
    const int gw = blockIdx.x * 8 + wave, NGW = G * 8;
    const int gt = blockIdx.x * 512 + tid, NGT = G * 512;
    bf16_t* lat = (bf16_t*)(P.ws + WS_LAT); float* dt = (float*)(P.ws + WS_DT); const float* tab = (const float*)(P.ws + WS_TAB);
    const int gl = lane >> 4, li = lane & 15;
    for (int row = gw * 4 + gl; row < T; row += NGW * 4) {
        bf16_t* lr = lat + (size_t)row * NLAT;
        u32x4 qr[3], kr[2];
#pragma unroll
        for (int j = 0; j < 3; ++j) qr[j] = *(const u32x4*)(lr + (li + 16 * j) * 8);
#pragma unroll
        for (int j = 0; j < 2; ++j) kr[j] = *(const u32x4*)(lr + 384 + (li + 16 * j) * 8);
        const float x1 = bf2f(lr[640 + li]), x2 = bf2f(lr[656 + li]);
        const float dv0 = dt[(size_t)row * 32 + li], dv1 = dt[(size_t)row * 32 + 16 + li];
        float qv[3][8], kv[2][8]; float sq = 0.f, sk = 0.f;
#pragma unroll
        for (int j = 0; j < 3; ++j) { unpack8(qr[j], qv[j]);
#pragma unroll
            for (int e = 0; e < 8; ++e) sq += qv[j][e] * qv[j][e]; }
#pragma unroll
        for (int j = 0; j < 2; ++j) { unpack8(kr[j], kv[j]);
#pragma unroll
            for (int e = 0; e < 8; ++e) sk += kv[j][e] * kv[j][e]; }
        sq = gsum16(sq); sk = gsum16(sk);
        const float rq = rsqrtf(sq * (1.f / 384.f) + EPS), rk = rsqrtf(sk * (1.f / 256.f) + EPS);
#pragma unroll
        for (int j = 0; j < 3; ++j) { float o[8]; const int c = (li + 16 * j) * 8;
#pragma unroll
            for (int e = 0; e < 8; ++e) o[e] = qv[j][e] * rq * P.q_a_norm[c + e];
            *(u32x4*)(lr + c) = pack8(o); }
#pragma unroll
        for (int j = 0; j < 2; ++j) { float o[8]; const int c = (li + 16 * j) * 8;
#pragma unroll
            for (int e = 0; e < 8; ++e) o[e] = kv[j][e] * rk * P.kv_a_norm[c + e];
            *(u32x4*)(lr + 384 + c) = pack8(o); }
        { const float c = tab[((size_t)posof(row) * 16 + li) * 2], s = tab[((size_t)posof(row) * 16 + li) * 2 + 1];
          *(unsigned*)(lr + 640 + 2 * li) = pk2(x1 * c - x2 * s, x2 * c + x1 * s); }
        { const float v0 = dv0 + P.dt_bias_f[li], v1 = dv1 + P.dt_bias_b[li];
          dt[(size_t)row * 32 + li] = fmaxf(v0, 0.f) + log1pf(__expf(-fabsf(v0)));
          dt[(size_t)row * 32 + 16 + li] = fmaxf(v1, 0.f) + log1pf(__expf(-fabsf(v1))); }
    }
    const bf16_t* xbc = (const bf16_t*)(P.ws + WS_XBC); bf16_t* xbc2 = (bf16_t*)(P.ws + WS_XBC2);
    for (int idx = gt; idx < (T / 8) * 160; idx += NGT) { const int rb = idx / 160, c0 = (idx - rb * 160) * 8; conv8_item<false>(xbc, xbc2, NXBC, rb * 8, rb * 8, c0, P.conv_w, P.conv_b); }
}

constexpr int BCROW = 144, SSD_BT = 0, SSD_CT = 128 * BCROW, SSD_WAVE = 2 * 128 * BCROW, SSD_WSZ = 8192 + 2048, SSD_RED = SSD_WAVE + 8 * SSD_WSZ;
constexpr size_t WS_DEC = 352 * MiB;
DI float wave_incl_scan(float v, int lane) {
#pragma unroll
    for (int o = 1; o < 64; o <<= 1) { const float n = __shfl_up(v, o); if (lane >= o) v += n; }
    return v;
}
DI bf16x8 tr_frag(const LAS uchar* p, int rowstride) {
    const s16x4 lo = __builtin_bit_cast(s16x4, __builtin_amdgcn_ds_read_tr16_b64_v4i16((LAS s16x4*)p));
    const s16x4 hh = __builtin_bit_cast(s16x4, __builtin_amdgcn_ds_read_tr16_b64_v4i16((LAS s16x4*)(p + 8 * rowstride)));
    return __builtin_shufflevector(lo, hh, 0, 1, 2, 3, 4, 5, 6, 7);
}
DI void ssd_chunk_prologue(const Params& P, LAS uchar* lds, int cg, int g) {
    const int tid = otid(), lane = tid & 63, wave = tid >> 6;
    const bf16_t* xbc2 = (const bf16_t*)(P.ws + WS_XBC2); const float* dtg = (const float*)(P.ws + WS_DT);
    const int row0 = cg * 128, head = g * 8 + wave;
    __syncthreads();
#pragma unroll
    for (int k = 0; k < 2; ++k) { const int c = tid + 512 * k, row = c >> 3, c16 = c & 7;
        const bf16_t* src = xbc2 + (size_t)(row0 + row) * NXBC + 1024 + g * 64 + c16 * 8;
        *(LAS u32x4*)(lds + SSD_BT + row * BCROW + c16 * 16) = *(const u32x4*)src;
        *(LAS u32x4*)(lds + SSD_CT + row * BCROW + c16 * 16) = *(const u32x4*)(src + 128); }
    LAS float* arr = (LAS float*)(lds + SSD_WAVE + wave * SSD_WSZ + 8192);
    const float Af = -__expf(P.a_log_f[head]), Ab = -__expf(P.a_log_b[head]);
    const float df0 = dtg[(size_t)(row0 + lane) * 32 + head], df1 = dtg[(size_t)(row0 + 64 + lane) * 32 + head];
    const float db0 = dtg[(size_t)(row0 + lane) * 32 + 16 + head], db1 = dtg[(size_t)(row0 + 64 + lane) * 32 + 16 + head];
    float p0 = wave_incl_scan(Af * df0, lane); const float tot0 = __shfl(p0, 63); float p1 = wave_incl_scan(Af * df1, lane) + tot0;
    float q0 = wave_incl_scan(Ab * db0, lane); const float qt0 = __shfl(q0, 63); float q1 = wave_incl_scan(Ab * db1, lane) + qt0; const float qtot = __shfl(q1, 63);
    arr[lane] = df0; arr[64 + lane] = df1; arr[128 + lane] = db0; arr[192 + lane] = db1;
    arr[256 + lane] = p0; arr[320 + lane] = p1;
    arr[384 + lane] = qtot - q0 + Ab * db0; arr[448 + lane] = qtot - q1 + Ab * db1;
    __syncthreads();
}
DI void ssd_xload(const Params& P, u32x4 (&v)[4], int row0, int sb, int head, int lane) {
    const bf16_t* xbc2 = (const bf16_t*)(P.ws + WS_XBC2);
#pragma unroll
    for (int i = 0; i < 4; ++i) { const int c = lane + 64 * i, row = c >> 3, c16 = c & 7; v[i] = *(const u32x4*)(xbc2 + (size_t)(row0 + 32 * sb + row) * NXBC + head * 64 + c16 * 8); }
}
DI void ssd_xstore(LAS uchar* xb, const u32x4 (&v)[4], int lane) {
#pragma unroll
    for (int i = 0; i < 4; ++i) { const int c = lane + 64 * i, row = c >> 3, c16 = c & 7; *(LAS u32x4*)(xb + row * 128 + c16 * 16) = v[i]; }
}
DI void p3_s1_states(const Params& P, LAS uchar* lds) {
    const int tid = otid(), lane = tid & 63, wave = tid >> 6, r32 = lane & 31, hi = lane >> 5;
    const int i16 = lane & 15, qq = i16 >> 2, pp = i16 & 3, blk = (lane >> 4) & 1;
    bf16_t* st = (bf16_t*)P.out; float* dec = (float*)(P.ws + WS_DEC);
    LAS uchar* xbuf = lds + SSD_WAVE + wave * SSD_WSZ; const LAS float* arr = (const LAS float*)(xbuf + 8192);
    for (int item = blockIdx.x; item < 1280; item += gridDim.x) {
        const int cg = item >> 1, g = item & 1, row0 = cg * 128, head = g * 8 + wave;
        u32x4 xr[4]; ssd_xload(P, xr, row0, 0, head, lane);
        ssd_chunk_prologue(P, lds, cg, g);
        f32x16 acc[2][2][2];
#pragma unroll
        for (int d = 0; d < 2; ++d)
#pragma unroll
            for (int a = 0; a < 2; ++a)
#pragma unroll
                for (int b = 0; b < 2; ++b)
#pragma unroll
                    for (int r = 0; r < 16; ++r) acc[d][a][b][r] = 0.f;
        const float wlf = arr[256 + 127], wlb = arr[384];
#pragma unroll 1
        for (int sb = 0; sb < 4; ++sb) {
            LAS uchar* xb = xbuf + (sb & 1) * 4096;
            ssd_xstore(xb, xr, lane);
            if (sb < 3) ssd_xload(P, xr, row0, sb + 1, head, lane);
#pragma unroll
            for (int k2 = 0; k2 < 2; ++k2) {
                const int sbase = 32 * sb + 16 * k2 + 4 * hi;
                float wf[8], wb[8];
                { const f32x4 a0 = *(const LAS f32x4*)(arr + 256 + sbase), a1 = *(const LAS f32x4*)(arr + 256 + sbase + 8), d0 = *(const LAS f32x4*)(arr + sbase), d1 = *(const LAS f32x4*)(arr + sbase + 8);
#pragma unroll
                  for (int j = 0; j < 4; ++j) { wf[j] = __expf(wlf - a0[j]) * d0[j]; wf[4 + j] = __expf(wlf - a1[j]) * d1[j]; } }
                { const f32x4 a0 = *(const LAS f32x4*)(arr + 384 + sbase), a1 = *(const LAS f32x4*)(arr + 384 + sbase + 8), d0 = *(const LAS f32x4*)(arr + 128 + sbase), d1 = *(const LAS f32x4*)(arr + 128 + sbase + 8);
#pragma unroll
                  for (int j = 0; j < 4; ++j) { wb[j] = __expf(wlb - a0[j]) * d0[j]; wb[4 + j] = __expf(wlb - a1[j]) * d1[j]; } }
                bf16x8 xsf[2], xsb[2];
#pragma unroll
                for (int pb = 0; pb < 2; ++pb) {
                    const bf16x8 xf = tr_frag(xb + (16 * k2 + 4 * hi + qq) * 128 + (32 * pb + 16 * blk + 4 * pp) * 2, 128);
                    float f[8], f2[8]; unpack8(__builtin_bit_cast(u32x4, xf), f);
#pragma unroll
                    for (int j = 0; j < 8; ++j) { f2[j] = f[j] * wb[j]; f[j] *= wf[j]; }
                    xsf[pb] = __builtin_bit_cast(bf16x8, pack8(f)); xsb[pb] = __builtin_bit_cast(bf16x8, pack8(f2));
                }
#pragma unroll
                for (int nb = 0; nb < 2; ++nb) {
                    const bf16x8 bf = tr_frag(lds + SSD_BT + (32 * sb + 16 * k2 + 4 * hi + qq) * BCROW + (32 * nb + 16 * blk + 4 * pp) * 2, BCROW);
#pragma unroll
                    for (int pb = 0; pb < 2; ++pb) {
                        acc[0][nb][pb] = __builtin_amdgcn_mfma_f32_32x32x16_bf16(bf, xsf[pb], acc[0][nb][pb], 0, 0, 0);
                        acc[1][nb][pb] = __builtin_amdgcn_mfma_f32_32x32x16_bf16(bf, xsb[pb], acc[1][nb][pb], 0, 0, 0);
                    }
                }
            }
        }
#pragma unroll
        for (int d = 0; d < 2; ++d) {
            bf16_t* so = st + ((size_t)(cg * 2 + d) * 16 + head) * 4096;
#pragma unroll
            for (int nb = 0; nb < 2; ++nb)
#pragma unroll
                for (int pb = 0; pb < 2; ++pb)
#pragma unroll
                    for (int gq = 0; gq < 4; ++gq) { u32x2 o; o.x = pk2(acc[d][nb][pb][4 * gq], acc[d][nb][pb][4 * gq + 1]); o.y = pk2(acc[d][nb][pb][4 * gq + 2], acc[d][nb][pb][4 * gq + 3]);
                        *(u32x2*)(so + (32 * pb + r32) * 64 + 32 * nb + 8 * gq + 4 * hi) = o; }
        }
        if (lane == 0) { dec[(cg * 2 + 0) * 16 + head] = __expf(wlf); dec[(cg * 2 + 1) * 16 + head] = __expf(wlb); }
    }
}
DI void p3_s2_scan(const Params& P) {
    unsigned* st = (unsigned*)P.out; const float* dec = (const float*)(P.ws + WS_DEC);
    for (int e = blockIdx.x * 512 + otid(); e < 65536; e += gridDim.x * 512) {
        const int dir = e >> 15, dh = e >> 11;
        for (int seq = 0; seq < 33; ++seq) {
            const int c0 = seq * 16, nc = seq < 32 ? 16 : 128;
            float h0 = 0.f, h1 = 0.f;
            for (int b = 0; b < nc; b += 16) {
                unsigned s[16]; float d[16];
#pragma unroll
                for (int i = 0; i < 16; ++i) { const int c = dir == 0 ? c0 + b + i : c0 + nc - 1 - b - i; s[i] = st[(size_t)c * 65536 + e]; d[i] = dec[c * 32 + dh]; }
#pragma unroll
                for (int i = 0; i < 16; ++i) { const float t0 = __uint_as_float(s[i] << 16), t1 = __uint_as_float(s[i] & 0xffff0000u); s[i] = pk2(h0, h1); h0 = h0 * d[i] + t0; h1 = h1 * d[i] + t1; }
#pragma unroll
                for (int i = 0; i < 16; ++i) { const int c = dir == 0 ? c0 + b + i : c0 + nc - 1 - b - i; st[(size_t)c * 65536 + e] = s[i]; }
            }
        }
    }
}
DI void p3_s3_output(const Params& P, LAS uchar* lds, unsigned long long& tacc_) {
    unsigned long long tA_ = 0;
    const int tid = otid(), lane = tid & 63, wave = tid >> 6, r32 = lane & 31, hi = lane >> 5;
    const int i16 = lane & 15, qq = i16 >> 2, pp = i16 & 3, blk = (lane >> 4) & 1;
    const bf16_t* st = (const bf16_t*)P.out; const bf16_t* zb = (const bf16_t*)(P.ws + WS_Z); bf16_t* mix = (bf16_t*)(P.ws + WS_MIX);
    LAS uchar* xbuf = lds + SSD_WAVE + wave * SSD_WSZ; const LAS float* arr = (const LAS float*)(xbuf + 8192);
    LAS float* red = (LAS float*)(lds + SSD_RED);
    for (int item = blockIdx.x; item < 1280; item += gridDim.x) {
        const int cg = item >> 1, g = item & 1, row0 = cg * 128, head = g * 8 + wave;
        PB(13);
        bf16x8 hfr[2][4][2];
#pragma unroll
        for (int d = 0; d < 2; ++d) { const bf16_t* H = st + ((size_t)(cg * 2 + d) * 16 + head) * 4096;
#pragma unroll
            for (int ks = 0; ks < 4; ++ks)
#pragma unroll
                for (int pb = 0; pb < 2; ++pb) hfr[d][ks][pb] = *(const bf16x8*)(H + (32 * pb + r32) * 64 + 16 * ks + 8 * hi); }
        u32x4 xr[4]; ssd_xload(P, xr, row0, 0, head, lane);
        ssd_chunk_prologue(P, lds, cg, g);
        const float Dk = P.d_skip[head];
        PE(13);
#pragma unroll 1
        for (int tb = 0; tb < 4; ++tb) {
            PB(14);
            const int t = 32 * tb + r32;
            const float af_t = arr[256 + t], rb_t = arr[384 + t];
            const float ef = __expf(af_t), eb = __expf(rb_t);
            bf16x8 cfr[4];
#pragma unroll
            for (int ks = 0; ks < 4; ++ks) cfr[ks] = *(const LAS bf16x8*)(lds + SSD_CT + t * BCROW + ks * 32 + hi * 16);
            const int row = row0 + t; const int cbase = g * 512 + wave * 64;
            f32x16 acc[2];
#pragma unroll
            for (int dir = 0; dir < 2; ++dir) {
                f32x16 tmp[2];
#pragma unroll
                for (int pb = 0; pb < 2; ++pb)
#pragma unroll
                    for (int r = 0; r < 16; ++r) tmp[pb][r] = 0.f;
#pragma unroll
                for (int ks = 0; ks < 4; ++ks)
#pragma unroll
                    for (int pb = 0; pb < 2; ++pb) tmp[pb] = __builtin_amdgcn_mfma_f32_32x32x16_bf16(hfr[dir][ks][pb], cfr[ks], tmp[pb], 0, 0, 0);
                const float e = dir == 0 ? ef : eb;
#pragma unroll
                for (int pb = 0; pb < 2; ++pb)
#pragma unroll
                    for (int r = 0; r < 16; ++r) acc[pb][r] = dir == 0 ? e * tmp[pb][r] : acc[pb][r] + e * tmp[pb][r];
            }
            PE(14); PB(15);
            u32x2 zw[2][4];
#pragma unroll
            for (int pb = 0; pb < 2; ++pb)
#pragma unroll
                for (int gq = 0; gq < 4; ++gq) zw[pb][gq] = *(const u32x2*)(zb + (size_t)row * DM + cbase + 32 * pb + 8 * gq + 4 * hi);
#pragma unroll 1
            for (int sb = 0; sb < 4; ++sb) {
                LAS uchar* xb = xbuf + (sb & 1) * 4096;
                ssd_xstore(xb, xr, lane);
                if (sb < 3 || tb < 3) ssd_xload(P, xr, row0, (sb + 1) & 3, head, lane);
                f32x16 X;
#pragma unroll
                for (int r = 0; r < 16; ++r) X[r] = 0.f;
#pragma unroll
                for (int ks = 0; ks < 4; ++ks) {
                    const bf16x8 bfa = *(const LAS bf16x8*)(lds + SSD_BT + (32 * sb + r32) * BCROW + ks * 32 + hi * 16);
                    const bf16x8 cfk = *(const LAS bf16x8*)(lds + SSD_CT + t * BCROW + ks * 32 + hi * 16);
                    X = __builtin_amdgcn_mfma_f32_32x32x16_bf16(bfa, cfk, X, 0, 0, 0);
                }
                constexpr float L2E = 1.4426950408889634f;
                if (sb < tb) {
                    const float a2 = af_t * L2E;
#pragma unroll
                    for (int gq = 0; gq < 4; ++gq) { const int s0 = 32 * sb + 8 * gq + 4 * hi;
                        const f32x4 dfv = *(const LAS f32x4*)(arr + s0), afv = *(const LAS f32x4*)(arr + 256 + s0);
#pragma unroll
                        for (int j = 0; j < 4; ++j) X[4 * gq + j] *= __builtin_amdgcn_exp2f(a2 - afv[j] * L2E) * dfv[j]; }
                } else if (sb > tb) {
                    const float b2 = rb_t * L2E;
#pragma unroll
                    for (int gq = 0; gq < 4; ++gq) { const int s0 = 32 * sb + 8 * gq + 4 * hi;
                        const f32x4 dbv = *(const LAS f32x4*)(arr + 128 + s0), rbv = *(const LAS f32x4*)(arr + 384 + s0);
#pragma unroll
                        for (int j = 0; j < 4; ++j) X[4 * gq + j] *= __builtin_amdgcn_exp2f(b2 - rbv[j] * L2E) * dbv[j]; }
                } else {
#pragma unroll
                    for (int gq = 0; gq < 4; ++gq) {
                        const int s0 = 32 * sb + 8 * gq + 4 * hi;
                        const f32x4 dfv = *(const LAS f32x4*)(arr + s0), dbv = *(const LAS f32x4*)(arr + 128 + s0);
                        const f32x4 afv = *(const LAS f32x4*)(arr + 256 + s0), rbv = *(const LAS f32x4*)(arr + 384 + s0);
#pragma unroll
                        for (int j = 0; j < 4; ++j) {
                            const int s = s0 + j;
                            float coef = 0.f;
                            if (s <= t) coef = __expf(af_t - afv[j]) * dfv[j];
                            if (s >= t) coef += __expf(rb_t - rbv[j]) * dbv[j];
                            float v = X[4 * gq + j] * coef;
                            if (s == t) v += Dk;
                            X[4 * gq + j] = v;
                        }
                    }
                }
#pragma unroll
                for (int s2 = 0; s2 < 2; ++s2) {
                    u32x4 pw;
                    if (s2 == 0) { pw.x = pk2(X[0], X[1]); pw.y = pk2(X[2], X[3]); pw.z = pk2(X[4], X[5]); pw.w = pk2(X[6], X[7]); }
                    else { pw.x = pk2(X[8], X[9]); pw.y = pk2(X[10], X[11]); pw.z = pk2(X[12], X[13]); pw.w = pk2(X[14], X[15]); }
                    const bf16x8 pbk = __builtin_bit_cast(bf16x8, pw);
#pragma unroll
                    for (int pb = 0; pb < 2; ++pb) {
                        const bf16x8 xf = tr_frag(xb + (16 * s2 + 4 * hi + qq) * 128 + (32 * pb + 16 * blk + 4 * pp) * 2, 128);
                        acc[pb] = __builtin_amdgcn_mfma_f32_32x32x16_bf16(xf, pbk, acc[pb], 0, 0, 0);
                    }
                }
            }
            PE(15); PB(16);
            float ssum = 0.f;
#pragma unroll
            for (int pb = 0; pb < 2; ++pb)
#pragma unroll
                for (int gq = 0; gq < 4; ++gq) {
                    const u32x2 zz = zw[pb][gq];
                    const float z0 = __uint_as_float(zz.x << 16), z1 = __uint_as_float(zz.x & 0xffff0000u), z2 = __uint_as_float(zz.y << 16), z3 = __uint_as_float(zz.y & 0xffff0000u);
                    float v0 = acc[pb][4 * gq] * silu(z0), v1 = acc[pb][4 * gq + 1] * silu(z1), v2 = acc[pb][4 * gq + 2] * silu(z2), v3 = acc[pb][4 * gq + 3] * silu(z3);
                    acc[pb][4 * gq] = v0; acc[pb][4 * gq + 1] = v1; acc[pb][4 * gq + 2] = v2; acc[pb][4 * gq + 3] = v3;
                    ssum += (v0 * v0 + v1 * v1) + (v2 * v2 + v3 * v3);
                }
            ssum += __shfl_xor(ssum, 32);
            LAS float* rd = red + (tb & 1) * 256;
            if (hi == 0) rd[wave * 32 + r32] = ssum;
            __syncthreads();
            float tot = 0.f;
#pragma unroll
            for (int w = 0; w < 8; ++w) tot += rd[w * 32 + r32];
            const float rs = rsqrtf(tot * (1.f / 512.f) + EPS);
#pragma unroll
            for (int pb = 0; pb < 2; ++pb)
#pragma unroll
                for (int gq = 0; gq < 4; ++gq) {
                    const int p0 = 32 * pb + 8 * gq + 4 * hi;
                    const f32x4 nw = *(const f32x4*)(P.ssm_norm + cbase + p0);
                    u32x2 o; o.x = pk2(acc[pb][4 * gq] * rs * nw[0], acc[pb][4 * gq + 1] * rs * nw[1]); o.y = pk2(acc[pb][4 * gq + 2] * rs * nw[2], acc[pb][4 * gq + 3] * rs * nw[3]);
                    *(u32x2*)(mix + (size_t)row * 2048 + 1024 + cbase + p0) = o;
                }
            PE(16);
        }
    }
}

DI float max3f(float a, float b, float c) { float r; asm("v_max3_f32 %0, %1, %2, %3" : "=v"(r) : "v"(a), "v"(b), "v"(c)); return r; }
DI float fadd_s(float a, float b) { float r; asm("v_add_f32_e32 %0, %1, %2" : "=v"(r) : "v"(a), "v"(b)); return r; }
constexpr int KROW = 208, VROW = 192, KTILE = 64 * KROW, VTILE = 64 * VROW;
DI void attn_unit(const Params& P, LAS uchar* lds, int rowbase, int L, int h, int qb) {
    const int tid = otid(), lane = tid & 63, wid = __builtin_amdgcn_readfirstlane(tid >> 6), r32 = lane & 31, hi = lane >> 5;
    const bf16_t* qbuf = (const bf16_t*)P.out; const bf16_t* kvb = (const bf16_t*)(P.ws + WS_KV); const bf16_t* lat = (const bf16_t*)(P.ws + WS_LAT);
    bf16_t* mix = (bf16_t*)(P.ws + WS_MIX);
    const int qrow0 = rowbase + qb * 512 + wid * 64 + r32;
    bf16x8 qf[2][6];
#pragma unroll
    for (int j = 0; j < 2; ++j) { const bf16_t* Qg = qbuf + (size_t)(qrow0 + 32 * j) * NQ;
#pragma unroll
      for (int ks = 0; ks < 4; ++ks) qf[j][ks] = *(const bf16x8*)(Qg + h * 64 + ks * 16 + hi * 8);
#pragma unroll
      for (int ks = 0; ks < 2; ++ks) { float f[8], o[8]; unpack8(*(const u32x4*)(Qg + 1024 + h * 32 + ks * 16 + hi * 8), f);
          const float* tp = (const float*)(P.ws + WS_TAB) + ((size_t)(qrow0 + 32 * j - rowbase) * 16 + 8 * ks + 4 * hi) * 2;
          const f32x4 c0 = *(const f32x4*)tp, c1 = *(const f32x4*)(tp + 4);
          o[0] = f[0] * c0[0] - f[1] * c0[1]; o[1] = f[1] * c0[0] + f[0] * c0[1]; o[2] = f[2] * c0[2] - f[3] * c0[3]; o[3] = f[3] * c0[2] + f[2] * c0[3];
          o[4] = f[4] * c1[0] - f[5] * c1[1]; o[5] = f[5] * c1[0] + f[4] * c1[1]; o[6] = f[6] * c1[2] - f[7] * c1[3]; o[7] = f[7] * c1[2] + f[6] * c1[3];
          qf[j][4 + ks] = __builtin_bit_cast(bf16x8, pack8(o)); } }
    LAS uchar* Kb0 = lds; LAS uchar* Vb0 = lds + 2 * KTILE;
    const int skey = tid >> 3, sch = tid & 7, rkey = (tid >> 2) & 63, rch = tid & 3;
    const bf16_t* kn_src = kvb + (size_t)(rowbase + skey) * NKV + h * 64 + sch * 8;
    const bf16_t* v_src = kn_src + 1024;
    const bf16_t* kr_src = lat + (size_t)(rowbase + rkey) * NLAT + 640 + rch * 8;
    u32x4 rkn, rv, rkr = {0u, 0u, 0u, 0u};
    rkn = *(const u32x4*)kn_src; rv = *(const u32x4*)v_src; if (tid < 256) rkr = *(const u32x4*)kr_src;
    *(LAS u32x4*)(Kb0 + skey * KROW + sch * 16) = rkn; *(LAS u32x4*)(Vb0 + skey * VROW + sch * 16) = rv; if (tid < 256) *(LAS u32x4*)(Kb0 + rkey * KROW + 128 + rch * 16) = rkr;
    { const size_t adv = 64; rkn = *(const u32x4*)(kn_src + adv * NKV); rv = *(const u32x4*)(v_src + adv * NKV); if (tid < 256) rkr = *(const u32x4*)(kr_src + adv * NLAT); }
    __syncthreads();
    if (wid >= 4) __builtin_amdgcn_s_barrier();
    bf16x8 kaug, qaug[2];
    { const short one = hi == 0 ? (short)0x3F80 : (short)0; kaug = (bf16x8){one, 0, 0, 0, 0, 0, 0, 0}; }
    {
        f32x16 p[2][2];
#pragma unroll
        for (int j = 0; j < 2; ++j)
#pragma unroll
            for (int hh = 0; hh < 2; ++hh)
#pragma unroll
                for (int r = 0; r < 16; ++r) p[j][hh][r] = 0.f;
#pragma unroll
        for (int ks = 0; ks < 6; ++ks) {
            const bf16x8 k0 = *(const LAS bf16x8*)(Kb0 + r32 * KROW + ks * 32 + hi * 16);
            const bf16x8 k1 = *(const LAS bf16x8*)(Kb0 + (32 + r32) * KROW + ks * 32 + hi * 16);
#pragma unroll
            for (int j = 0; j < 2; ++j) {
                p[j][0] = __builtin_amdgcn_mfma_f32_32x32x16_bf16(k0, qf[j][ks], p[j][0], 0, 0, 0);
                p[j][1] = __builtin_amdgcn_mfma_f32_32x32x16_bf16(k1, qf[j][ks], p[j][1], 0, 0, 0);
            }
        }
        asm volatile("s_nop 15\n\ts_nop 7" : "+v"(p[0][0]), "+v"(p[0][1]), "+v"(p[1][0]), "+v"(p[1][1]));
#pragma unroll
        for (int j = 0; j < 2; ++j) {
            float mxa = max3f(p[j][0][0], p[j][0][1], p[j][1][0]), mxb = max3f(p[j][0][2], p[j][0][3], p[j][1][1]);
            mxa = max3f(mxa, p[j][1][2], p[j][1][3]);
#pragma unroll
            for (int r = 4; r < 16; r += 4) { mxa = max3f(mxa, p[j][0][r], p[j][0][r + 1]); mxb = max3f(mxb, p[j][0][r + 2], p[j][0][r + 3]); mxa = max3f(mxa, p[j][1][r], p[j][1][r + 1]); mxb = max3f(mxb, p[j][1][r + 2], p[j][1][r + 3]); }
            float mx = max3f(mxa, mxb, mxa); mx = fmaxf(mx, __shfl_xor(mx, 32));
            const short nb = hi == 0 ? (short)(pk2(-mx, 0.f) & 0xffffu) : (short)0;
            qaug[j] = (bf16x8){nb, 0, 0, 0, 0, 0, 0, 0};
        }
    }
    float lrun[2] = {0.f, 0.f}; f32x16 o[2][2];
#pragma unroll
    for (int j = 0; j < 2; ++j)
#pragma unroll
        for (int d = 0; d < 2; ++d)
#pragma unroll
            for (int r = 0; r < 16; ++r) o[j][d][r] = 0.f;
    const int NT = L / 64;
    const int i16 = lane & 15, qq = i16 >> 2, pp = i16 & 3, blk = (lane >> 4) & 1;
    const int vtr_off = (4 * hi + qq) * VROW + (16 * blk + 4 * pp) * 2;
    for (int kt = 0; kt < NT; ++kt) {
        const int cur = kt & 1;
        const LAS uchar* Kb = Kb0 + cur * KTILE; const LAS uchar* Vb = Vb0 + cur * VTILE;
        f32x16 p[2][2];
#pragma unroll
        for (int j = 0; j < 2; ++j)
#pragma unroll
            for (int hh = 0; hh < 2; ++hh)
#pragma unroll
                for (int r = 0; r < 16; ++r) p[j][hh][r] = 0.f;
#pragma unroll
        for (int ks = 0; ks < 6; ++ks) {
            const bf16x8 k0 = *(const LAS bf16x8*)(Kb + r32 * KROW + ks * 32 + hi * 16);
            const bf16x8 k1 = *(const LAS bf16x8*)(Kb + (32 + r32) * KROW + ks * 32 + hi * 16);
#pragma unroll
            for (int j = 0; j < 2; ++j) {
                p[j][0] = __builtin_amdgcn_mfma_f32_32x32x16_bf16(k0, qf[j][ks], p[j][0], 0, 0, 0);
                p[j][1] = __builtin_amdgcn_mfma_f32_32x32x16_bf16(k1, qf[j][ks], p[j][1], 0, 0, 0);
            }
        }
#pragma unroll
        for (int j = 0; j < 2; ++j) { p[j][0] = __builtin_amdgcn_mfma_f32_32x32x16_bf16(kaug, qaug[j], p[j][0], 0, 0, 0); p[j][1] = __builtin_amdgcn_mfma_f32_32x32x16_bf16(kaug, qaug[j], p[j][1], 0, 0, 0); }
        if (kt + 1 < NT) { LAS uchar* Kn = Kb0 + (cur ^ 1) * KTILE;
            *(LAS u32x4*)(Kn + skey * KROW + sch * 16) = rkn; if (tid < 256) *(LAS u32x4*)(Kn + rkey * KROW + 128 + rch * 16) = rkr; }
        __builtin_amdgcn_sched_barrier(0);
        asm volatile("s_waitcnt lgkmcnt(0)" ::: "memory"); __builtin_amdgcn_s_barrier(); asm volatile("" ::: "memory");
        __builtin_amdgcn_sched_barrier(0);
        __builtin_amdgcn_s_setprio(1);
#pragma unroll
        for (int s = 0; s < 4; ++s) {
            bf16x8 va[2];
#pragma unroll
            for (int db = 0; db < 2; ++db) {
                const LAS uchar* vp = Vb + vtr_off + s * 16 * VROW + db * 64;
                const s16x4 lo = __builtin_bit_cast(s16x4, __builtin_amdgcn_ds_read_tr16_b64_v4i16((LAS s16x4*)vp));
                const s16x4 hh = __builtin_bit_cast(s16x4, __builtin_amdgcn_ds_read_tr16_b64_v4i16((LAS s16x4*)(vp + 8 * VROW)));
                va[db] = __builtin_shufflevector(lo, hh, 0, 1, 2, 3, 4, 5, 6, 7);
            }
#pragma unroll
            for (int j = 0; j < 2; ++j) {
                const f32x16& pp_ = p[j][s >> 1]; const int b = 8 * (s & 1);
                float e[8];
#pragma unroll
                for (int i = 0; i < 8; ++i) e[i] = __builtin_amdgcn_exp2f(pp_[b + i]);
                lrun[j] = fadd_s(lrun[j], fadd_s(fadd_s(fadd_s(e[0], e[1]), fadd_s(e[2], e[3])), fadd_s(fadd_s(e[4], e[5]), fadd_s(e[6], e[7]))));
                u32x4 pw; pw.x = pk2(e[0], e[1]); pw.y = pk2(e[2], e[3]); pw.z = pk2(e[4], e[5]); pw.w = pk2(e[6], e[7]);
                const bf16x8 pbj = __builtin_bit_cast(bf16x8, pw);
                o[j][0] = __builtin_amdgcn_mfma_f32_32x32x16_bf16(va[0], pbj, o[j][0], 0, 0, 0);
                o[j][1] = __builtin_amdgcn_mfma_f32_32x32x16_bf16(va[1], pbj, o[j][1], 0, 0, 0);
                __builtin_amdgcn_sched_barrier(0);
            }
        }
        __builtin_amdgcn_s_setprio(0);
        if (kt + 1 < NT) { LAS uchar* Vn = Vb0 + (cur ^ 1) * VTILE; *(LAS u32x4*)(Vn + skey * VROW + sch * 16) = rv; }
        if (kt + 2 < NT) { const size_t adv = (size_t)(kt + 2) * 64; rkn = *(const u32x4*)(kn_src + adv * NKV); rv = *(const u32x4*)(v_src + adv * NKV); if (tid < 256) rkr = *(const u32x4*)(kr_src + adv * NLAT); }
        asm volatile("s_waitcnt lgkmcnt(0)" ::: "memory"); __builtin_amdgcn_s_barrier(); asm volatile("" ::: "memory");
    }
    if (wid < 4) __builtin_amdgcn_s_barrier();
#pragma unroll
    for (int j = 0; j < 2; ++j) {
        const float ltot = lrun[j] + __shfl_xor(lrun[j], 32); const float inv = 1.f / ltot;
        bf16_t* op = mix + (size_t)(qrow0 + 32 * j) * 2048 + h * 64 + 4 * hi;
#pragma unroll
        for (int g = 0; g < 4; ++g) {
            u32x2 w0, w1;
            w0.x = pk2(o[j][0][4 * g] * inv, o[j][0][4 * g + 1] * inv); w0.y = pk2(o[j][0][4 * g + 2] * inv, o[j][0][4 * g + 3] * inv);
            w1.x = pk2(o[j][1][4 * g] * inv, o[j][1][4 * g + 1] * inv); w1.y = pk2(o[j][1][4 * g + 2] * inv, o[j][1][4 * g + 3] * inv);
            *(u32x2*)(op + 8 * g) = w0; *(u32x2*)(op + 32 + 8 * g) = w1;
        }
    }
}
DI void p5_attention(const Params& P, LAS uchar* lds) {
    const int G = gridDim.x, bx = blockIdx.x; const int vcu = (G % 8 == 0) ? (bx % 8) * (G / 8) + bx / 8 : bx;
    const int perS = (512 + G - 1) / G, perP = (2048 + G - 1) / G;
    for (int i = 0; i < perS; ++i) { const int s = vcu * perS + i; if (s < 512) attn_unit(P, lds, TP, LS, s >> 5, s & 31); }
    for (int i = 0; i < perP; ++i) { const int s = vcu * perP + i; if (s < 2048) { const int b = s >> 6, rem = s & 63; attn_unit(P, lds, b * LP, LP, rem >> 2, rem & 3); } }
}

DI void p8_act(const Params& P, int rows, int row_off) {
    const int gt = blockIdx.x * 512 + otid(), NGT = gridDim.x * 512;
    const bf16_t* g = (const bf16_t*)(P.ws + WS_G); bf16_t* uo = (bf16_t*)(P.ws + WS_U);
    for (int idx = gt; idx < (rows / 8) * 352; idx += NGT) { const int rb = idx / 352, c0 = (idx - rb * 352) * 8; conv8_item<true>(g, uo, DFF, rb * 8, row_off + rb * 8, c0, P.ffn_conv_w, P.ffn_conv_b); }
}
DI void p2_fixup(const Params& P) {
    const int gt = blockIdx.x * 512 + otid(), NGT = gridDim.x * 512;
    const float* halo = (const float*)(P.ws + WS_HALO2); bf16_t* xbc2 = (bf16_t*)(P.ws + WS_XBC2); const size_t hs = (size_t)320 * 2 * NXBC;
    for (int idx = gt; idx < 320 * 2 * NXBC; idx += NGT) {
        const int ch = idx % NXBC, r2 = idx / NXBC, pm = r2 >> 1, lastrow = r2 & 1;
        const int row = pm * 256 + (lastrow ? 255 : 0); const int pos = posof(row), L = lenof(row);
        const float part = halo[(size_t)r2 * NXBC + ch];
        float gn = 0.f, w;
        if (!lastrow) { w = P.conv_w[ch]; if (pos > 0) gn = halo[hs + ((size_t)(pm - 1) * 2 + 1) * NXBC + ch]; }
        else { w = P.conv_w[2 * NXBC + ch]; if (pos < L - 1) gn = halo[hs + ((size_t)(pm + 1) * 2 + 0) * NXBC + ch]; }
        xbc2[(size_t)row * NXBC + ch] = (unsigned short)(pk2(silu(part + w * gn), 0.f) & 0xffffu);
    }
}
DI void p_fixup(const Params& P) {
    const int gt = blockIdx.x * 512 + otid(), NGT = gridDim.x * 512;
    const float* halo = (const float*)(P.ws + WS_HALO); bf16_t* act = (bf16_t*)(P.ws + WS_ACT);
    for (int idx = gt; idx < 320 * 2 * DFF; idx += NGT) {
        const int ch = idx % DFF, r2 = idx / DFF, pm = r2 >> 1, lastrow = r2 & 1;
        const int row = pm * 256 + (lastrow ? 255 : 0); const int pos = posof(row), L = lenof(row);
        const float part = halo[((size_t)(0 * 320 + pm) * 2 + lastrow) * DFF + ch], uv = halo[((size_t)(1 * 320 + pm) * 2 + lastrow) * DFF + ch];
        float gn = 0.f, w;
        if (!lastrow) { w = P.ffn_conv_w[ch]; if (pos > 0) gn = halo[((size_t)(2 * 320 + pm - 1) * 2 + 1) * DFF + ch]; }
        else { w = P.ffn_conv_w[2 * DFF + ch]; if (pos < L - 1) gn = halo[((size_t)(2 * 320 + pm + 1) * 2 + 0) * DFF + ch]; }
        const float v = part + w * gn;
        const unsigned short ob = (unsigned short)(pk2(silu(v) * uv, 0.f) & 0xffffu);
        act[(size_t)row * DFF + ch] = ob;
    }
}
DI void p_final(const Params& P) {
    const int gt = blockIdx.x * 512 + otid(), NGT = gridDim.x * 512;
    const float* ss2 = (const float*)(P.ws + WS_SS) + T;
    for (int idx = gt; idx < T * 256; idx += 4 * NGT) {
        f32x4 v[4]; float rs[4];
#pragma unroll
        for (int k = 0; k < 4; ++k) { const int i = idx + k * NGT; if (i < T * 256) { v[k] = ((const f32x4*)P.out)[i]; rs[k] = ss2[i >> 8]; } }
#pragma unroll
        for (int k = 0; k < 4; ++k) { const int i = idx + k * NGT; if (i < T * 256) { const f32x4 w = ((const f32x4*)P.final_norm)[i & 255]; __builtin_nontemporal_store(v[k] * rsqrtf(rs[k] * (1.f / DM) + EPS) * w, (f32x4*)P.out + i); } }
    }
}

#define XB_TMO      128
#define XB_XCNT(j)  (256  + 64 * (j))
#define XB_XSUB(j)  (1280 + 64 * (j))
#define XB_XGEN(j)  (2304 + 64 * (j))
#define XB_TOP      3328
#define XB_TOPGEN   3392
#define XCD_BAR_WORDS 3456
#define XB_SPIN_CAP (1u << 18)

__device__ __forceinline__ unsigned xb_ld(unsigned* p)              { return __hip_atomic_load(p, __ATOMIC_RELAXED, __HIP_MEMORY_SCOPE_AGENT); }
__device__ __forceinline__ unsigned xb_add(unsigned* p, unsigned v) { return __hip_atomic_fetch_add(p, v, __ATOMIC_RELAXED, __HIP_MEMORY_SCOPE_AGENT); }
__device__ __forceinline__ unsigned xb_xcc_id() { return (unsigned)__builtin_amdgcn_s_getreg((3 << 11) | 20) & 0xFu; }
#define XB_SPIN(cond, bar) do { unsigned _sp = 0; while (cond) { __builtin_amdgcn_s_sleep(1); \
    if ((++_sp & 255u) == 0u) { if (xb_ld(&(bar)[XB_TMO])) break; if (_sp > XB_SPIN_CAP) { atomicAdd(&(bar)[XB_TMO], 1u); break; } } } } while (0)

struct XcdBarrier {
    unsigned* bar; unsigned x;
    volatile LAS unsigned* st;
};

__device__ __forceinline__ XcdBarrier xcd_barrier_post(unsigned* bar, volatile LAS unsigned* st) {
    XcdBarrier b; b.bar = bar; b.x = xb_xcc_id(); b.st = st;
    if (threadIdx.x == 0) (void)xb_add(&bar[XB_XCNT(b.x)], 1u);
    return b;
}
__device__ __forceinline__ void xcd_barrier_complete(unsigned* bar, unsigned x, unsigned& nloc, unsigned& nx) {
    const unsigned G = gridDim.x * gridDim.y * gridDim.z;
    unsigned sum, cnt, mine, sp = 0u;
    for (;;) {
        sum = 0u; cnt = 0u; mine = 0u;
#pragma unroll
        for (unsigned j = 0; j < 16; ++j) { const unsigned c = xb_ld(&bar[XB_XCNT(j)]); sum += c; cnt += (c > 0u) ? 1u : 0u; mine = (j == x) ? c : mine; }
        if (sum == G) break;
        __builtin_amdgcn_s_sleep(1);
        if ((++sp & 255u) == 0u) { if (xb_ld(&bar[XB_TMO])) break; if (sp > XB_SPIN_CAP) { atomicAdd(&bar[XB_TMO], 1u); break; } }
    }
    nloc = mine > 0u ? mine : 1u; nx = cnt > 0u ? cnt : 1u;
}

__device__ __forceinline__ void xcd_barrier(const XcdBarrier& b) {
    asm volatile("s_waitcnt vmcnt(0)" ::: "memory");
    __syncthreads();
    if (threadIdx.x == 0) {
        unsigned* bar = b.bar; const unsigned bx_ = xb_xcc_id();
        __builtin_amdgcn_s_waitcnt(0);
        unsigned nloc = b.st[0], nx = b.st[1];
        if (nloc == 0u) { xcd_barrier_complete(bar, bx_, nloc, nx); b.st[0] = nloc; b.st[1] = nx; }
        const unsigned old = xb_add(&bar[XB_XSUB(bx_)], 1u);
        const unsigned gen = old / nloc;
        if (old + 1u == (gen + 1u) * nloc) {
            __builtin_amdgcn_fence(__ATOMIC_RELEASE, "agent");
            asm volatile("s_waitcnt vmcnt(0)" ::: "memory");
            const unsigned og = xb_add(&bar[XB_TOP], 1u);
            const unsigned tg = og / nx;
            if (og + 1u == (tg + 1u) * nx) xb_add(&bar[XB_TOPGEN], 1u);
            else XB_SPIN(xb_ld(&bar[XB_TOPGEN]) == tg, bar);
            __builtin_amdgcn_fence(__ATOMIC_ACQUIRE, "agent");
            xb_add(&bar[XB_XGEN(bx_)], 1u);
            asm volatile("s_waitcnt vmcnt(0)" ::: "memory");
        } else {
            XB_SPIN(xb_ld(&bar[XB_XGEN(bx_)]) == gen, bar);
            __builtin_amdgcn_fence(__ATOMIC_ACQUIRE, "agent");
            asm volatile("s_waitcnt vmcnt(0)" ::: "memory");
        }
    }
    __syncthreads();
}

constexpr int LDS_BYTES = 147456;
template <class Epi> DI void run_gemm(LAS uchar* lds, const bf16_t* A, int lda, const bf16_t* Bt, int M, int N, int K, const Epi& E) {
    pg8::Gemm g{A, Bt, M, N, K, lda}; pg8::StaticOrder S; S.init(M, N, (int)gridDim.x, (int)blockIdx.x);
    pg8::gemm_phase<Epi, pg8::StaticOrder, true, true>(lds, g, S, E);
}
__global__ void __launch_bounds__(512, 2) mega(Params P) {
    extern __shared__ __attribute__((aligned(16))) uchar lds_[];
    LAS uchar* lds = (LAS uchar*)lds_;
    cg::grid_group grid = cg::this_grid();
    uchar* ws = P.ws;
    volatile LAS unsigned* bst = (volatile LAS unsigned*)(lds + LDS_BYTES - 16);
    if (threadIdx.x < 4) bst[threadIdx.x] = 0u;
    __syncthreads();
    const XcdBarrier bar = xcd_barrier_post((unsigned*)(ws + WS_BAR), bst);
    bf16_t* lat = (bf16_t*)(ws + WS_LAT); float* ss = (float*)(ws + WS_SS);
    unsigned long long tA_ = 0, tacc_ = 0;
    PB(0); p0_prologue(P, lds);
    if (P.ws == nullptr) grid.sync();
    xcd_barrier(bar); PE(0);
    PB(1);
    { EpiIn2 E{(bf16_t*)(ws + WS_Z), (bf16_t*)(ws + WS_XBC2), lat, (float*)(ws + WS_DT), ss + 2 * T, ss + 3 * T, (const float*)(ws + WS_TAB), P.conv_w, P.conv_b, (float*)(ws + WS_HALO2), (LAS float*)(lds + XCH_OFF), P.dt_bias_f, P.dt_bias_b};
      run_gemm(lds, (const bf16_t*)(ws + WS_H), DM, (const bf16_t*)(ws + WS_WIN), T, DINP, DM, E); }
    xcd_barrier(bar); PE(1);
    PB(2); p2_fixup(P);
    xcd_barrier(bar); PE(2);
    PB(3); p3_s1_states(P, lds);
    xcd_barrier(bar); PE(3);
    PB(4); p3_s2_scan(P);
    xcd_barrier(bar); PE(4);
    PB(5); p3_s3_output(P, lds, tacc_);
    xcd_barrier(bar); PE(5);
    PB(6);
    { EpiPlain E{(bf16_t*)P.out, NQ, QSCALE, ss + 2 * T, 1.f / 384.f};
      run_gemm(lds, lat, NLAT, (const bf16_t*)(ws + WS_WQB), T, NQ, 384, E); }
    __syncthreads();
    { EpiPlain E{(bf16_t*)(ws + WS_KV), NKV, 1.0f, ss + 3 * T, 1.f / 256.f};
      run_gemm(lds, lat + 384, NLAT, (const bf16_t*)(ws + WS_WKVB), T, NKV, 256, E); }
    xcd_barrier(bar); PE(6);
    PB(7); p5_attention(P, lds);
    xcd_barrier(bar); PE(7);
    PB(8);
    { EpiRes E{P.xp, P.xs, nullptr, (bf16_t*)(ws + WS_X1B), ss, 0, nullptr};
      run_gemm(lds, (const bf16_t*)(ws + WS_MIX), 2048, (const bf16_t*)(ws + WS_WOUT), T, DM, 2048, E); }
    xcd_barrier(bar); PE(8);
    PB(9);
    { EpiGU2 E{(bf16_t*)(ws + WS_ACT), ss, P.ffn_conv_w, P.ffn_conv_b, (float*)(ws + WS_HALO), (LAS float*)(lds + XCH_OFF)};
      run_gemm(lds, (const bf16_t*)(ws + WS_X1B), DM, (const bf16_t*)(ws + WS_WGU), T, NGU, DM, E); }
    xcd_barrier(bar); PE(9);
    PB(10); p_fixup(P);
    xcd_barrier(bar); PE(10);
    PB(11);
    { EpiRes E{nullptr, nullptr, P.out, nullptr, ss + T, 0, (const bf16_t*)(ws + WS_X1B)};
      run_gemm(lds, (const bf16_t*)(ws + WS_ACT), DFF, (const bf16_t*)(ws + WS_WDN), T, DM, DFF, E); }
    xcd_barrier(bar); PE(11);
    PB(12); p_final(P); PE(12);
    if (PROBE_MASK && blockIdx.x == 0) { const unsigned long long t0_ = __builtin_amdgcn_s_memrealtime(); while (__builtin_amdgcn_s_memrealtime() - t0_ < (unsigned long long)PROBE_K * tacc_) __builtin_amdgcn_s_sleep(8); }
}

extern "C" void kernel_launch(void* const* d_in, const int* in_sizes, int n_in, void* d_out, int out_size, void* d_ws, size_t ws_size, hipStream_t stream) {
    static int grid = 0;
    if (grid == 0) {
        int dev = 0, cus = 0, per_cu = 0;
        hipGetDevice(&dev); hipDeviceGetAttribute(&cus, hipDeviceAttributeMultiprocessorCount, dev);
        hipFuncSetAttribute((const void*)mega, hipFuncAttributeMaxDynamicSharedMemorySize, LDS_BYTES);
        if (hipOccupancyMaxActiveBlocksPerMultiprocessor(&per_cu, (const void*)mega, 512, LDS_BYTES) != hipSuccess || per_cu < 1) per_cu = 1;
        (void)hipGetLastError();
        grid = cus * per_cu;
        if (ws_size < 1020 * MiB) fprintf(stderr, "kernel_launch: workspace too small: %zu\n", ws_size);
    }
    (void)hipMemsetAsync((char*)d_ws + WS_BAR, 0, 16384, stream);
    Params p{};
    const float** pf = (const float**)&p;
    for (int i = 0; i < 24; ++i) pf[i] = (const float*)d_in[i];
    p.out = (float*)d_out; p.ws = (uchar*)d_ws;
    void* args[] = {&p};
    hipError_t e = hipLaunchCooperativeKernel((const void*)mega, dim3(grid), dim3(512), args, LDS_BYTES, stream);
    if (e != hipSuccess) fprintf(stderr, "cooperative launch failed: %s (grid %d)\n", hipGetErrorString(e), grid);
}
```

```cpp
#include <hip/hip_runtime.h>
#include <hip/hip_cooperative_groups.h>
#include <cstdio>
#include <cstdint>
namespace cg = cooperative_groups;
namespace pg8 {
#define PG8_LAS __attribute__((address_space(3)))
typedef unsigned short bf16_t;
typedef short bf16x8 __attribute__((ext_vector_type(8)));
typedef float f32x4 __attribute__((ext_vector_type(4)));
typedef unsigned u32x4 __attribute__((ext_vector_type(4)));
constexpr int BM = 256, BK = 64, HALF = 128, HTB = HALF * BK * 2  , STAGE_BYTES = 8 * HTB, NXCD = 8, WGM = 8;
__host__ __device__ __forceinline__ int lds_byte(int r, int c) { const int st = (r >> 4) * 2 + (c >> 5), rr = r & 15, cc = c & 31, ob = rr * 64 + cc * 2; return st * 1024 + (ob ^ (((ob >> 9) & 1) << 5)); }
__host__ __device__ __forceinline__ void stage_rc(int b, int& R, int& C) { const int st = b / 1024, sb = b % 1024, swz = sb ^ (((sb >> 9) & 1) << 5); R = (st >> 1) * 16 + swz / 64; C = (st & 1) * 32 + (swz % 64) / 2; }
__host__ __device__ __forceinline__ int perm32(int rho) { const int n = rho >> 4, i = rho & 15; return 8 * (i >> 2) + 4 * n + (i & 3); }
struct Unit { int pm, pn; };
struct Gemm { const bf16_t* A; const bf16_t* Bt; int M, N, K, lda; };
struct StaticOrder {
    int nM, nN, nwg, G, c;
    __host__ __device__ void init(int M, int N, int G_, int c_) { nM = M / BM; nN = N / BM; nwg = nM * nN; G = G_; c = c_; }
    __host__ __device__ bool next(int i, Unit& u) const {
        const long L = (long)i * G + c; if (L >= nwg) return false;
        int wgid = (int)L; { const int q = nwg / NXCD, r = nwg % NXCD, xcd = wgid % NXCD, off = wgid / NXCD; wgid = (xcd < r ? xcd * (q + 1) : r * (q + 1) + (xcd - r) * q) + off; }
        const int nig = WGM * nN, gid = wgid / nig, fm = gid * WGM, gsz = (nM - fm) < WGM ? (nM - fm) : WGM;
        u.pm = fm + ((wgid % nig) % gsz); u.pn = (wgid % nig) / gsz; return true;
    }
    __device__ __forceinline__ void a_ready(const Unit&) const {}
    __device__ __forceinline__ void done(const Unit&) const {}
};
template <class Epi, class Sched, bool ALIGN_EPI = false, bool SP2 = false>
__device__ __forceinline__ void gemm_phase(PG8_LAS unsigned char* lds, const Gemm g, const Sched& S, const Epi& E) {
    int tid_ = threadIdx.x; asm volatile("" : "+v"(tid_)); const int tid = tid_, wid = __builtin_amdgcn_readfirstlane(tid >> 6), lane = tid & 63, wr = wid >> 2, wc = wid & 3, fr = lane & 15, fq = lane >> 4;
    const int K = g.K, nt = K / BK;
    unsigned voffA[2], voffB[2];
#pragma unroll
    for (int i = 0; i < 2; ++i) { int R, C; stage_rc(tid * 16 + i * 8192, R, C); const int Rb = Epi::PERM ? ((R & ~31) + perm32(R & 31)) : R;
        voffA[i] = (unsigned)(R * g.lda + C) * 2u; voffB[i] = (unsigned)(Rb * K + C) * 2u; }
    const size_t kstep = (size_t)(BK * 2);
    const size_t hstepB = (size_t)HALF * K * 2, hstepA = (size_t)HALF * g.lda * 2;
    const size_t tstepA = 2 * hstepA, tstepB = 2 * hstepB;
    const unsigned ldsw = (unsigned)wid * 1024u;
    const int aoff = lds_byte(wr * 64 + fr, fq * 8), boff = lds_byte(wc * 32 + fr, fq * 8);
#define PG8_SA(b, h) (((b) * 2 + (h)) * HTB)
#define PG8_SB(b, h) ((4 + (b) * 2 + (h)) * HTB)
#define PG8_STAGE(bufoff, gbase, voff) do { _Pragma("unroll") for (int _i = 0; _i < 2; ++_i) \
        __builtin_amdgcn_global_load_lds((const unsigned*)((const char*)(gbase) + (voff)[_i]), (PG8_LAS unsigned*)(lds + (bufoff) + ldsw + _i * 8192), 16, 0, 0); } while (0)
#define PG8_LDA(dst, b, h) do { _Pragma("unroll") for (int m = 0; m < 4; ++m) _Pragma("unroll") for (int k = 0; k < 2; ++k) dst[m][k] = *(const PG8_LAS bf16x8*)(lds + PG8_SA(b, h) + aoff + m * 2048 + k * 1024); } while (0)
#define PG8_LDB(dst, b, h) do { _Pragma("unroll") for (int n = 0; n < 2; ++n) _Pragma("unroll") for (int k = 0; k < 2; ++k) dst[n][k] = *(const PG8_LAS bf16x8*)(lds + PG8_SB(b, h) + boff + n * 2048 + k * 1024); } while (0)
#define PG8_MMA(ai, bj, At, Bt) do { __builtin_amdgcn_s_setprio(1); _Pragma("unroll") for (int m = 0; m < 4; ++m) _Pragma("unroll") for (int n = 0; n < 2; ++n) _Pragma("unroll") for (int k = 0; k < 2; ++k) \
        acc[ai][bj][m][n] = __builtin_amdgcn_mfma_f32_16x16x32_bf16(Bt[n][k], At[m][k], acc[ai][bj][m][n], 0, 0, 0); __builtin_amdgcn_s_setprio(0); } while (0)
#define PG8_WAIT_V(n) asm volatile("s_waitcnt vmcnt(" #n ")" ::: "memory")
#define PG8_WAIT_L(n) asm volatile("s_waitcnt lgkmcnt(" #n ")" ::: "memory")
#define PG8_BAR __builtin_amdgcn_s_barrier()
#define PG8_SCHED __builtin_amdgcn_sched_barrier(0)
    Unit cur, nxt; int ui = 0;
    if (!S.next(0, cur)) return;
    f32x4 acc[2][2][4][2];
#pragma unroll
    for (int a = 0; a < 2; ++a)
#pragma unroll
        for (int b = 0; b < 2; ++b)
#pragma unroll
            for (int m = 0; m < 4; ++m)
#pragma unroll
                for (int n = 0; n < 2; ++n) acc[a][b][m][n] = (f32x4){0.f, 0.f, 0.f, 0.f};
    bf16x8 At[4][2], B0[2][2], B1[2][2];
    const char* cA = (const char*)g.A + (size_t)cur.pm * tstepA; const char* cB = (const char*)g.Bt + (size_t)cur.pn * tstepB;
    S.a_ready(cur);
    if constexpr (SP2) {
        PG8_STAGE(PG8_SB(0, 0), cB, voffB); PG8_STAGE(PG8_SB(0, 1), cB + hstepB, voffB); PG8_STAGE(PG8_SA(0, 0), cA, voffA); PG8_STAGE(PG8_SA(0, 1), cA + hstepA, voffA);
        if (wr == 1) PG8_BAR;
        PG8_WAIT_V(2); PG8_BAR;
        PG8_STAGE(PG8_SB(1, 0), cB + kstep, voffB); PG8_STAGE(PG8_SA(1, 0), cA + kstep, voffA); PG8_STAGE(PG8_SB(1, 1), cB + hstepB + kstep, voffB);
        PG8_WAIT_V(6); PG8_BAR;
    } else {
        PG8_STAGE(PG8_SB(0, 0), cB, voffB); PG8_STAGE(PG8_SA(0, 0), cA, voffA); PG8_STAGE(PG8_SB(0, 1), cB + hstepB, voffB); PG8_STAGE(PG8_SA(0, 1), cA + hstepA, voffA);
        if (wr == 1) PG8_BAR;
        PG8_WAIT_V(4); PG8_BAR;
        PG8_STAGE(PG8_SB(1, 0), cB + kstep, voffB); PG8_STAGE(PG8_SA(1, 0), cA + kstep, voffA); PG8_STAGE(PG8_SB(1, 1), cB + hstepB + kstep, voffB);
        PG8_WAIT_V(6); PG8_BAR;
    }
    for (;;) {
        const bool has_next = S.next(ui + 1, nxt);
        const char* nA = has_next ? (const char*)g.A + (size_t)nxt.pm * tstepA : cA; const char* nB = has_next ? (const char*)g.Bt + (size_t)nxt.pn * tstepB : cB;
        for (int t = 0; t < nt; t += 2) {
            const bool last = (t == nt - 2);
            const char* a1 = cA + (size_t)(t + 1) * kstep;
            const char* a2 = last ? nA : cA + (size_t)(t + 2) * kstep; const char* b2 = last ? nB : cB + (size_t)(t + 2) * kstep;
            const char* a3 = a2 + kstep; const char* b3 = b2 + kstep;
            if (last && has_next) S.a_ready(nxt);
            if constexpr (SP2) {
            PG8_LDB(B0, 0, 0); PG8_LDB(B1, 0, 1); PG8_SCHED; PG8_LDA(At, 0, 0); PG8_STAGE(PG8_SA(1, 1), a1 + hstepA, voffA);
            PG8_WAIT_V(8); PG8_WAIT_L(0); PG8_BAR; PG8_MMA(0, 0, At, B0); PG8_MMA(0, 1, At, B1); PG8_BAR; PG8_SCHED;
            PG8_LDA(At, 0, 1); PG8_STAGE(PG8_SB(0, 0), b2, voffB); PG8_STAGE(PG8_SB(0, 1), b2 + hstepB, voffB); PG8_STAGE(PG8_SA(0, 0), a2, voffA);
            PG8_WAIT_V(8); PG8_WAIT_L(0); PG8_BAR; PG8_MMA(1, 0, At, B0); PG8_MMA(1, 1, At, B1); PG8_BAR; PG8_SCHED;
            PG8_LDB(B0, 1, 0); PG8_LDB(B1, 1, 1); PG8_SCHED; PG8_LDA(At, 1, 0); PG8_STAGE(PG8_SA(0, 1), a2 + hstepA, voffA);
            PG8_WAIT_V(8); PG8_WAIT_L(0); PG8_BAR; PG8_MMA(0, 0, At, B0); PG8_MMA(0, 1, At, B1); PG8_BAR; PG8_SCHED;
            PG8_LDA(At, 1, 1); PG8_STAGE(PG8_SB(1, 0), b3, voffB); PG8_STAGE(PG8_SB(1, 1), b3 + hstepB, voffB); PG8_STAGE(PG8_SA(1, 0), a3, voffA);
            PG8_WAIT_V(8); PG8_WAIT_L(0); PG8_BAR; PG8_MMA(1, 0, At, B0); PG8_MMA(1, 1, At, B1); PG8_BAR; PG8_SCHED;
            } else {
            PG8_LDB(B0, 0, 0); PG8_SCHED; PG8_LDA(At, 0, 0); PG8_STAGE(PG8_SA(1, 1), a1 + hstepA, voffA);
            PG8_WAIT_L(8); PG8_BAR; PG8_WAIT_L(0); PG8_MMA(0, 0, At, B0); PG8_BAR; PG8_SCHED;
            PG8_LDB(B1, 0, 1); PG8_STAGE(PG8_SB(0, 0), b2, voffB);
            PG8_BAR; PG8_WAIT_L(0); PG8_MMA(0, 1, At, B1); PG8_BAR;
            PG8_LDA(At, 0, 1); PG8_STAGE(PG8_SA(0, 0), a2, voffA);
            PG8_BAR; PG8_WAIT_L(0); PG8_MMA(1, 0, At, B0); PG8_BAR; PG8_SCHED;
            PG8_STAGE(PG8_SB(0, 1), b2 + hstepB, voffB);
            PG8_WAIT_V(6); PG8_BAR; PG8_MMA(1, 1, At, B1); PG8_BAR;
            PG8_LDB(B0, 1, 0); PG8_SCHED; PG8_LDA(At, 1, 0); PG8_STAGE(PG8_SA(0, 1), a2 + hstepA, voffA);
            PG8_WAIT_L(8); PG8_BAR; PG8_WAIT_L(0); PG8_MMA(0, 0, At, B0); PG8_BAR; PG8_SCHED;
            PG8_LDB(B1, 1, 1); PG8_STAGE(PG8_SB(1, 0), b3, voffB);
            PG8_BAR; PG8_WAIT_L(0); PG8_MMA(0, 1, At, B1); PG8_BAR;
            PG8_LDA(At, 1, 1); PG8_STAGE(PG8_SA(1, 0), a3, voffA);
            PG8_BAR; PG8_WAIT_L(0); PG8_MMA(1, 0, At, B0); PG8_BAR; PG8_SCHED;
            PG8_STAGE(PG8_SB(1, 1), b3 + hstepB, voffB);
            PG8_WAIT_V(6); PG8_BAR; PG8_MMA(1, 1, At, B1); PG8_BAR;
            }
        }
        if constexpr (ALIGN_EPI) { if (wr == 0) PG8_BAR; }
        if constexpr (!Epi::AFTER_DRAIN) { E(acc, cur, wr, wc, fr, fq); S.done(cur); }
        if (!has_next) break;
#pragma unroll
        for (int a = 0; a < 2; ++a)
#pragma unroll
            for (int b = 0; b < 2; ++b)
#pragma unroll
                for (int m = 0; m < 4; ++m)
#pragma unroll
                    for (int n = 0; n < 2; ++n) acc[a][b][m][n] = (f32x4){0.f, 0.f, 0.f, 0.f};
        cur = nxt; cA = nA; cB = nB; ++ui;
        if constexpr (ALIGN_EPI) { if (wr == 1) PG8_BAR; }
    }
    PG8_WAIT_V(0);
    if constexpr (!ALIGN_EPI) { if (wr == 0) PG8_BAR; }
    PG8_BAR;
    if constexpr (Epi::AFTER_DRAIN) { E.fused(acc, cur, wr, wc, fr, fq, lds, wid, lane); S.done(cur); }
#undef PG8_SA
#undef PG8_SB
#undef PG8_STAGE
#undef PG8_LDA
#undef PG8_LDB
#undef PG8_MMA
#undef PG8_WAIT_V
#undef PG8_WAIT_L
#undef PG8_BAR
#undef PG8_SCHED
}
}

#define DI __device__ __forceinline__
#define LAS __attribute__((address_space(3)))
typedef unsigned short bf16_t;
typedef unsigned char uchar;
typedef short bf16x8 __attribute__((ext_vector_type(8)));
typedef short s16x4 __attribute__((ext_vector_type(4)));
typedef float f32x4 __attribute__((ext_vector_type(4)));
typedef float f32x16 __attribute__((ext_vector_type(16)));
typedef unsigned u32x4 __attribute__((ext_vector_type(4)));
typedef unsigned u32x2 __attribute__((ext_vector_type(2)));
typedef float f32x2_t __attribute__((ext_vector_type(2)));
typedef __bf16 bf16x2_t __attribute__((ext_vector_type(2)));

constexpr int T = 81920, TP = 65536, DM = 1024;
constexpr int LP = 2048, LS = 16384;
constexpr int DIN = 3008, DINP = 3072;
constexpr int NQ = 1536, NKV = 2048, NLAT = 768, NXBC = 1280;
constexpr int DFF = 2816, NGU = 5632;
constexpr float EPS = 1e-6f;
constexpr float QSCALE = 0.10206207261596575f * 1.4426950408889634f;
constexpr int CH0_ROWS = 49152, CH1_ROWS = 32768;

constexpr size_t MiB = 1u << 20;
constexpr size_t WS_WIN = 0, WS_WQB = 6 * MiB, WS_WKVB = 8 * MiB, WS_WOUT = 9 * MiB, WS_WGU = 13 * MiB, WS_WDN = 24 * MiB;
constexpr size_t WS_TAB = 30 * MiB;
constexpr size_t WS_H = 32 * MiB;
constexpr size_t WS_XBC = 192 * MiB;
constexpr size_t WS_MIX = 32 * MiB;
constexpr size_t WS_Z = 392 * MiB;
constexpr size_t WS_LAT = 552 * MiB;
constexpr size_t WS_DT = 672 * MiB;
constexpr size_t WS_XBC2 = 682 * MiB;
constexpr size_t WS_KV = 682 * MiB;
constexpr size_t WS_X1B = 352 * MiB;
constexpr size_t WS_SS = 1004 * MiB;
constexpr size_t WS_BAR = 1006 * MiB;
constexpr size_t WS_G = 32 * MiB;
constexpr size_t WS_U = 512 * MiB;
constexpr size_t WS_ACT = 512 * MiB;
constexpr size_t WS_HALO = 32 * MiB;
constexpr size_t WS_HALO2 = 890 * MiB;
constexpr int XCH_OFF = 131072;
static_assert(WS_XBC2 + (size_t)T * NXBC * 2 <= WS_SS && WS_KV + (size_t)T * NKV * 2 <= WS_SS, "ws map");
static_assert(WS_G + (size_t)CH0_ROWS * DFF * 2 <= WS_X1B && WS_X1B + (size_t)T * DM * 2 <= WS_U && WS_U + (size_t)CH0_ROWS * DFF * 2 <= WS_SS, "ws map 2");
static_assert(WS_MIX + (size_t)T * 2048 * 2 <= WS_X1B, "ws map 3");
static_assert(WS_ACT + (size_t)T * DFF * 2 <= WS_SS && WS_HALO + (size_t)3 * 320 * 2 * DFF * 4 <= WS_X1B, "ws map 4");

struct Params {
    const float *xp, *xs, *norm1, *w_in, *q_a_norm, *kv_a_norm, *w_q_b, *w_kv_b, *conv_w, *conv_b, *dt_bias_f, *dt_bias_b, *a_log_f, *a_log_b,
        *d_skip, *ssm_norm, *w_out, *norm2, *w_gate, *w_up, *ffn_conv_w, *ffn_conv_b, *w_down, *final_norm;
    float* out; uchar* ws;
};

DI int otid() { int t = threadIdx.x; asm volatile("" : "+v"(t)); return t; }
#ifndef PROBE_MASK
#define PROBE_MASK 0u
#endif
#define PROBE_K 1
#define PB(id) do { if (PROBE_MASK && blockIdx.x == 0 && ((PROBE_MASK >> (id)) & 1u)) tA_ = __builtin_amdgcn_s_memrealtime(); } while (0)
#define PE(id) do { if (PROBE_MASK && blockIdx.x == 0 && ((PROBE_MASK >> (id)) & 1u)) tacc_ += __builtin_amdgcn_s_memrealtime() - tA_; } while (0)
DI float bf2f(bf16_t v) { return __uint_as_float((unsigned)v << 16); }
DI unsigned pk2(float lo, float hi) { f32x2_t v = {lo, hi}; bf16x2_t b = __builtin_convertvector(v, bf16x2_t); return __builtin_bit_cast(unsigned, b); }
DI void unpack8(const u32x4 w, float (&f)[8]) {
#pragma unroll
    for (int i = 0; i < 4; ++i) { f[2 * i] = __uint_as_float(w[i] << 16); f[2 * i + 1] = __uint_as_float(w[i] & 0xffff0000u); }
}
DI u32x4 pack8(const float (&f)[8]) { u32x4 w; w.x = pk2(f[0], f[1]); w.y = pk2(f[2], f[3]); w.z = pk2(f[4], f[5]); w.w = pk2(f[6], f[7]); return w; }
DI float wave_sum(float v) {
#pragma unroll
    for (int o = 1; o < 64; o <<= 1) v += __shfl_xor(v, o);
    return v;
}
DI const float* xrow(const Params& P, int row) { return row < TP ? P.xp + (size_t)row * DM : P.xs + (size_t)(row - TP) * DM; }
DI int posof(int row) { return row < TP ? (row & (LP - 1)) : row - TP; }
DI int lenof(int row) { return row < TP ? LP : LS; }
DI float silu(float v) { return v * __builtin_amdgcn_rcpf(1.f + __builtin_amdgcn_exp2f(v * -1.4426950408889634f)); }

#define EPI_LOOP_BEGIN \
    _Pragma("unroll") for (int ai = 0; ai < 2; ++ai) _Pragma("unroll") for (int m = 0; m < 4; ++m) { const int row = u.pm * 256 + ai * 128 + wr * 64 + m * 16 + fr; \
    _Pragma("unroll") for (int bj = 0; bj < 2; ++bj) { const f32x4 v0 = acc[ai][bj][m][0], v1 = acc[ai][bj][m][1];
#define EPI_LOOP_END } }

DI float dpp_ror1(float v) { return __builtin_bit_cast(float, __builtin_amdgcn_update_dpp(0, __builtin_bit_cast(int, v), 0x121, 0xf, 0xf, false)); }
DI float dpp_ror15(float v) { return __builtin_bit_cast(float, __builtin_amdgcn_update_dpp(0, __builtin_bit_cast(int, v), 0x12F, 0xf, 0xf, false)); }
struct EpiIn2 {
    static constexpr bool PERM = true, AFTER_DRAIN = false;
    bf16_t *z, *xbc2, *lat; float* dt; float *ssq, *ssk; const float* tab; const float* cw; const float* cb; float* halo; LAS float* xch; const float *dtbf, *dtbb;
    DI void operator()(const f32x4 (&acc)[2][2][4][2], const pg8::Unit& u, int wr, int wc, int fr, int fq) const {
        const int lane = fr + 16 * fq;
        if (u.pn < 4) {
            const int col0 = u.pn * 256 + wc * 32 + 8 * fq;
            EPI_LOOP_BEGIN
                u32x4 w; w.x = pk2(v0[0], v0[1]); w.y = pk2(v0[2], v0[3]); w.z = pk2(v1[0], v1[1]); w.w = pk2(v1[2], v1[3]);
                *(u32x4*)(z + (size_t)row * DM + col0 + bj * 128) = w;
            EPI_LOOP_END
        } else if (u.pn < 9) {
            int cl_ = wc * 32 + 8 * fq; asm volatile("" : "+v"(cl_)); const int cl = cl_;
#pragma unroll
            for (int ai = 0; ai < 2; ++ai)
#pragma unroll
                for (int bj = 0; bj < 2; ++bj) {
                    LAS float* xs = xch + (ai * 2 + wr) * 512 + bj * 128 + cl;
                    if (fr == 0) { *(LAS f32x4*)xs = acc[ai][bj][0][0]; *(LAS f32x4*)(xs + 4) = acc[ai][bj][0][1]; }
                    if (fr == 15) { *(LAS f32x4*)(xs + 256) = acc[ai][bj][3][0]; *(LAS f32x4*)(xs + 260) = acc[ai][bj][3][1]; }
                }
            asm volatile("s_waitcnt lgkmcnt(0)" ::: "memory"); __builtin_amdgcn_s_barrier(); asm volatile("" ::: "memory");
            const int ldn = (lane & 48) | ((fr + 15) & 15), lup = (lane & 48) | ((fr + 1) & 15);
            const f32x4 zero4 = {0.f, 0.f, 0.f, 0.f};
#pragma unroll
            for (int bj = 0; bj < 2; ++bj)
#pragma unroll
                for (int jh = 0; jh < 2; ++jh) {
                    const int tl = bj * 128 + cl + 4 * jh, chj = (u.pn - 4) * 256 + tl;
                    const f32x4 w0 = *(const f32x4*)(cw + chj), w1 = *(const f32x4*)(cw + NXBC + chj), w2 = *(const f32x4*)(cw + 2 * NXBC + chj), bb = *(const f32x4*)(cb + chj);
#pragma unroll
                    for (int ai = 0; ai < 2; ++ai) {
                        const int strip = ai * 2 + wr;
                        const f32x4 ep = strip > 0 ? *(const LAS f32x4*)(xch + (strip - 1) * 512 + 256 + tl) : zero4;
                        const f32x4 en = strip < 3 ? *(const LAS f32x4*)(xch + (strip + 1) * 512 + tl) : zero4;
                        f32x4 dnp = ep, upc, upn;
#pragma unroll
                        for (int k = 0; k < 4; ++k) upc[k] = dpp_ror15(acc[ai][bj][0][jh][k]);
#pragma unroll
                        for (int m = 0; m < 4; ++m) {
                            const int row = u.pm * 256 + ai * 128 + wr * 64 + m * 16 + fr;
                            f32x4 dnc;
#pragma unroll
                            for (int k = 0; k < 4; ++k) { dnc[k] = dpp_ror1(acc[ai][bj][m][jh][k]); upn[k] = m < 3 ? dpp_ror15(acc[ai][bj][m < 3 ? m + 1 : 3][jh][k]) : en[k]; }
                            const f32x4 prev = fr == 0 ? dnp : dnc;
                            const f32x4 next = fr == 15 ? upn : upc;
                            dnp = dnc;
                            const f32x4 part = w0 * prev + w1 * acc[ai][bj][m][jh] + w2 * next + bb;
                            u32x2 o; o.x = pk2(silu(part[0]), silu(part[1])); o.y = pk2(silu(part[2]), silu(part[3]));
                            *(u32x2*)(xbc2 + (size_t)row * NXBC + chj) = o;
                            const bool first = (strip == 0 && m == 0 && fr == 0), last = (strip == 3 && m == 3 && fr == 15);
                            if (first || last) { const size_t ho = ((size_t)u.pm * 2 + (last ? 1 : 0)) * NXBC + chj; *(f32x4*)(halo + ho) = part; *(f32x4*)(halo + (size_t)320 * 2 * NXBC + ho) = acc[ai][bj][m][jh]; }
                            upc = upn;
                        }
                    }
                }
            asm volatile("s_waitcnt lgkmcnt(0)" ::: "memory"); __builtin_amdgcn_s_barrier(); asm volatile("" ::: "memory");
        } else {
            const int colt = (u.pn - 9) * 256, col0 = colt + wc * 32 + 8 * fq;
#pragma unroll
            for (int ai = 0; ai < 2; ++ai)
#pragma unroll
                for (int m = 0; m < 4; ++m) {
                    const int row = u.pm * 256 + ai * 128 + wr * 64 + m * 16 + fr;
#pragma unroll
                    for (int bj = 0; bj < 2; ++bj) {
                        const f32x4 v0 = acc[ai][bj][m][0], v1 = acc[ai][bj][m][1];
                        const int c = col0 + bj * 128;
                        if (c < 640) {
                            u32x4 w; w.x = pk2(v0[0], v0[1]); w.y = pk2(v0[2], v0[3]); w.z = pk2(v1[0], v1[1]); w.w = pk2(v1[2], v1[3]);
                            *(u32x4*)(lat + (size_t)row * NLAT + c) = w;
                            float sq = (v0[0] * v0[0] + v0[1] * v0[1]) + (v0[2] * v0[2] + v0[3] * v0[3]) + (v1[0] * v1[0] + v1[1] * v1[1]) + (v1[2] * v1[2] + v1[3] * v1[3]);
                            sq += __shfl_xor(sq, 16); sq += __shfl_xor(sq, 32);
                            if (fq == 0) atomicAdd((c < 384 ? ssq : ssk) + row, sq);
                        } else if (c < 672) {
                            const float* tp = tab + ((size_t)posof(row) * 16 + 4 * fq) * 2;
                            const f32x4 c0 = *(const f32x4*)tp, c1 = *(const f32x4*)(tp + 4);
                            u32x4 w;
                            w.x = pk2(v0[0] * c0[0] - v0[1] * c0[1], v0[1] * c0[0] + v0[0] * c0[1]); w.y = pk2(v0[2] * c0[2] - v0[3] * c0[3], v0[3] * c0[2] + v0[2] * c0[3]);
                            w.z = pk2(v1[0] * c1[0] - v1[1] * c1[1], v1[1] * c1[0] + v1[0] * c1[1]); w.w = pk2(v1[2] * c1[2] - v1[3] * c1[3], v1[3] * c1[2] + v1[2] * c1[3]);
                            *(u32x4*)(lat + (size_t)row * NLAT + c) = w;
                        } else if (c < 704) {
                            const float* bp = (fq < 2 ? dtbf + 8 * fq : dtbb + 8 * (fq - 2));
                            const f32x4 b0 = *(const f32x4*)bp, b1 = *(const f32x4*)(bp + 4);
                            f32x4 o0, o1;
#pragma unroll
                            for (int k = 0; k < 4; ++k) { const float a = v0[k] + b0[k], b = v1[k] + b1[k]; o0[k] = fmaxf(a, 0.f) + __logf(1.f + __expf(-fabsf(a))); o1[k] = fmaxf(b, 0.f) + __logf(1.f + __expf(-fabsf(b))); }
                            float* d = dt + (size_t)row * 32 + 8 * fq; *(f32x4*)d = o0; *(f32x4*)(d + 4) = o1;
                        }
                    }
                }
        }
    }
};
struct EpiIn {
    static constexpr bool PERM = true, AFTER_DRAIN = false;
    bf16_t *z, *xbc, *lat; float* dt;
    DI void operator()(const f32x4 (&acc)[2][2][4][2], const pg8::Unit& u, int wr, int wc, int fr, int fq) const {
        bf16_t* base; int ld, colt;
        if (u.pn < 4) { base = z; ld = DM; colt = u.pn * 256; } else if (u.pn < 9) { base = xbc; ld = NXBC; colt = (u.pn - 4) * 256; } else { base = lat; ld = NLAT; colt = (u.pn - 9) * 256; }
        const int col0 = colt + wc * 32 + 8 * fq;
        EPI_LOOP_BEGIN
            u32x4 w; w.x = pk2(v0[0], v0[1]); w.y = pk2(v0[2], v0[3]); w.z = pk2(v1[0], v1[1]); w.w = pk2(v1[2], v1[3]);
            *(u32x4*)(base + (size_t)row * ld + col0 + bj * 128) = w;
            if (u.pn == 11 && bj == 1 && wc == 1) { float* d = dt + (size_t)row * 32 + 8 * fq; *(f32x4*)d = v0; *(f32x4*)(d + 4) = v1; }
        EPI_LOOP_END
    }
};
struct EpiPlain {
    static constexpr bool PERM = true, AFTER_DRAIN = false;
    bf16_t* o; int ld; float sc0; const float* ssr; float invn;
    DI void operator()(const f32x4 (&acc)[2][2][4][2], const pg8::Unit& u, int wr, int wc, int fr, int fq) const {
        const int col0 = u.pn * 256 + wc * 32 + 8 * fq;
        EPI_LOOP_BEGIN
            const float sc = sc0 * rsqrtf(ssr[row] * invn + EPS);
            u32x4 w; w.x = pk2(v0[0] * sc, v0[1] * sc); w.y = pk2(v0[2] * sc, v0[3] * sc); w.z = pk2(v1[0] * sc, v1[1] * sc); w.w = pk2(v1[2] * sc, v1[3] * sc);
            *(u32x4*)(o + (size_t)row * ld + col0 + bj * 128) = w;
        EPI_LOOP_END
    }
};
struct EpiRes {
    static constexpr bool PERM = true, AFTER_DRAIN = false;
    const float* resp; const float* ress; float* xo; bf16_t* xb; float* ss; int row_off; const bf16_t* resb;
    DI void operator()(const f32x4 (&acc)[2][2][4][2], const pg8::Unit& u, int wr, int wc, int fr, int fq) const {
        const int col0 = u.pn * 256 + wc * 32 + 8 * fq;
#pragma unroll
        for (int ai = 0; ai < 2; ++ai)
#pragma unroll
            for (int m = 0; m < 4; ++m) {
                const int row = row_off + u.pm * 256 + ai * 128 + wr * 64 + m * 16 + fr;
                const float* rp = (row < TP ? resp + (size_t)row * DM : ress + (size_t)(row - TP) * DM) + col0;
                float s = 0.f;
#pragma unroll
                for (int bj = 0; bj < 2; ++bj) {
                    f32x4 r0, r1;
                    if (resb) { float rf[8]; unpack8(*(const u32x4*)(resb + (size_t)row * DM + col0 + bj * 128), rf); r0 = (f32x4){rf[0], rf[1], rf[2], rf[3]}; r1 = (f32x4){rf[4], rf[5], rf[6], rf[7]}; }
                    else { r0 = *(const f32x4*)(rp + bj * 128); r1 = *(const f32x4*)(rp + bj * 128 + 4); }
                    const f32x4 a = acc[ai][bj][m][0] + r0, b = acc[ai][bj][m][1] + r1;
                    if (xo) { float* op = xo + (size_t)row * DM + col0 + bj * 128; *(f32x4*)op = a; *(f32x4*)(op + 4) = b; }
                    if (xb) { u32x4 w; w.x = pk2(a[0], a[1]); w.y = pk2(a[2], a[3]); w.z = pk2(b[0], b[1]); w.w = pk2(b[2], b[3]); *(u32x4*)(xb + (size_t)row * DM + col0 + bj * 128) = w; }
                    s += (a[0] * a[0] + a[1] * a[1]) + (a[2] * a[2] + a[3] * a[3]) + (b[0] * b[0] + b[1] * b[1]) + (b[2] * b[2] + b[3] * b[3]);
                }
                s += __shfl_xor(s, 16); s += __shfl_xor(s, 32);
                if (fq == 0) atomicAdd(ss + row, s);
            }
    }
};
struct EpiGU2 {
    static constexpr bool PERM = true, AFTER_DRAIN = false;
    bf16_t* act; const float* ss; const float* cw; const float* cb; float* halo; LAS float* xch;
    DI void operator()(const f32x4 (&acc)[2][2][4][2], const pg8::Unit& u, int wr, int wc, int fr, int fq) const {
        const int lane = fr + 16 * fq;
        int cl_ = wc * 32 + 8 * fq; asm volatile("" : "+v"(cl_)); const int cl = cl_, ch0 = u.pn * 128 + cl;
        LAS float* wtab = xch + 1024;
        LAS float* rstab = xch + 1536;
        { const int tid_ = (wr * 4 + wc) * 64 + lane;
          if (tid_ >= 256) rstab[tid_ - 256] = rsqrtf(ss[u.pm * 256 + tid_ - 256] * (1.f / DM) + EPS);
          if (tid_ < 128) { const int ch = u.pn * 128 + tid_; wtab[tid_] = cw[ch]; wtab[128 + tid_] = cw[DFF + ch]; wtab[256 + tid_] = cw[2 * DFF + ch]; wtab[384 + tid_] = cb[ch]; } }
#pragma unroll
        for (int ai = 0; ai < 2; ++ai) {
            LAS float* xs = xch + (ai * 2 + wr) * 256 + cl;
            if (fr == 0) { const float r0 = rsqrtf(ss[u.pm * 256 + ai * 128 + wr * 64] * (1.f / DM) + EPS); *(LAS f32x4*)xs = acc[ai][0][0][0] * r0; *(LAS f32x4*)(xs + 4) = acc[ai][0][0][1] * r0; }
            if (fr == 15) { const float r3 = rsqrtf(ss[u.pm * 256 + ai * 128 + wr * 64 + 63] * (1.f / DM) + EPS); *(LAS f32x4*)(xs + 128) = acc[ai][0][3][0] * r3; *(LAS f32x4*)(xs + 132) = acc[ai][0][3][1] * r3; }
        }
        asm volatile("s_waitcnt lgkmcnt(0)" ::: "memory"); __builtin_amdgcn_s_barrier(); asm volatile("" ::: "memory");
        const f32x4 zero4 = {0.f, 0.f, 0.f, 0.f};
        float rs[2][4];
#pragma unroll
        for (int ai = 0; ai < 2; ++ai)
#pragma unroll
            for (int m = 0; m < 4; ++m) rs[ai][m] = rstab[ai * 128 + wr * 64 + m * 16 + fr];
#pragma unroll
        for (int ai = 0; ai < 2; ++ai) {
            const int strip = ai * 2 + wr;
            f32x4 gc[2], dnp[2], upc[2];
#pragma unroll
            for (int jh = 0; jh < 2; ++jh) {
                gc[jh] = acc[ai][0][0][jh] * rs[ai][0];
                dnp[jh] = strip > 0 ? *(const LAS f32x4*)(xch + (strip - 1) * 256 + 128 + cl + 4 * jh) : zero4;
#pragma unroll
                for (int k = 0; k < 4; ++k) upc[jh][k] = dpp_ror15(gc[jh][k]);
            }
#pragma unroll
            for (int m = 0; m < 4; ++m) {
                const int row = u.pm * 256 + ai * 128 + wr * 64 + m * 16 + fr;
                const bool first = (strip == 0 && m == 0 && fr == 0), last = (strip == 3 && m == 3 && fr == 15);
                u32x2 ob[2];
#pragma unroll
                for (int jh = 0; jh < 2; ++jh) {
                    const LAS float* wp = wtab + cl + 4 * jh;
                    const f32x4 w0 = *(const LAS f32x4*)wp, w1 = *(const LAS f32x4*)(wp + 128), w2 = *(const LAS f32x4*)(wp + 256), bb = *(const LAS f32x4*)(wp + 384);
                    f32x4 dnc, upn, gn = gc[jh];
                    if (m < 3) gn = acc[ai][0][m < 3 ? m + 1 : 3][jh] * rs[ai][m < 3 ? m + 1 : 3];
                    const f32x4 en = (m == 3 && strip < 3) ? *(const LAS f32x4*)(xch + (strip + 1) * 256 + cl + 4 * jh) : zero4;
#pragma unroll
                    for (int k = 0; k < 4; ++k) { dnc[k] = dpp_ror1(gc[jh][k]); upn[k] = m < 3 ? dpp_ror15(gn[k]) : en[k]; }
                    const f32x4 prev = fr == 0 ? dnp[jh] : dnc;
                    const f32x4 next = fr == 15 ? upn : upc[jh];
                    const f32x4 part = w0 * prev + w1 * gc[jh] + w2 * next + bb;
                    const f32x4 uq = acc[ai][1][m][jh] * rs[ai][m];
                    ob[jh].x = pk2(silu(part[0]) * uq[0], silu(part[1]) * uq[1]); ob[jh].y = pk2(silu(part[2]) * uq[2], silu(part[3]) * uq[3]);
                    if (first || last) {
                        const size_t ho = ((size_t)u.pm * 2 + (last ? 1 : 0)) * DFF + ch0 + 4 * jh; const size_t hs = (size_t)320 * 2 * DFF;
                        *(f32x4*)(halo + ho) = part; *(f32x4*)(halo + hs + ho) = uq; *(f32x4*)(halo + 2 * hs + ho) = gc[jh];
                    }
                    dnp[jh] = dnc; upc[jh] = upn; gc[jh] = gn;
                }
                *(u32x4*)(act + (size_t)row * DFF + ch0) = (u32x4){ob[0].x, ob[0].y, ob[1].x, ob[1].y};
            }
        }
        asm volatile("s_waitcnt lgkmcnt(0)" ::: "memory"); __builtin_amdgcn_s_barrier(); asm volatile("" ::: "memory");
    }
};
struct EpiGU {
    static constexpr bool PERM = true, AFTER_DRAIN = false;
    bf16_t *g, *uo; const float* ss; int row_off;
    DI void operator()(const f32x4 (&acc)[2][2][4][2], const pg8::Unit& u, int wr, int wc, int fr, int fq) const {
        const int col0 = u.pn * 128 + wc * 32 + 8 * fq;
#pragma unroll
        for (int ai = 0; ai < 2; ++ai)
#pragma unroll
            for (int m = 0; m < 4; ++m) {
                const int lrow = u.pm * 256 + ai * 128 + wr * 64 + m * 16 + fr;
                const float rs = rsqrtf(ss[row_off + lrow] * (1.f / DM) + EPS);
#pragma unroll
                for (int bj = 0; bj < 2; ++bj) {
                    const f32x4 a = acc[ai][bj][m][0] * rs, b = acc[ai][bj][m][1] * rs;
                    u32x4 w; w.x = pk2(a[0], a[1]); w.y = pk2(a[2], a[3]); w.z = pk2(b[0], b[1]); w.w = pk2(b[2], b[3]);
                    *(u32x4*)((bj == 0 ? g : uo) + (size_t)lrow * DFF + col0) = w;
                }
            }
    }
};

template <class F> DI void transpose_item(const float* W, int K, int N, bf16_t* WT, LAS float* scr, int item, int lane, F destrow, const float* kscale) {
    const int nblk = N / 32, kb = item / nblk, nb = item % nblk, k0 = 64 * kb, n0 = 32 * nb;
    { f32x4 wv[8];
#pragma unroll
      for (int i = 0; i < 8; ++i) { const int kk = 8 * i + (lane >> 3); wv[i] = *(const f32x4*)(W + (size_t)(k0 + kk) * N + n0 + (lane & 7) * 4); }
#pragma unroll
      for (int i = 0; i < 8; ++i) { const int kk = 8 * i + (lane >> 3); const float ks = kscale ? kscale[k0 + kk] : 1.f; LAS float* d = scr + kk * 33 + (lane & 7) * 4; d[0] = wv[i][0] * ks; d[1] = wv[i][1] * ks; d[2] = wv[i][2] * ks; d[3] = wv[i][3] * ks; } }
    asm volatile("s_waitcnt lgkmcnt(0)" ::: "memory");
    const int c = lane & 7;
#pragma unroll
    for (int j = 0; j < 4; ++j) { const int n = (lane >> 3) + 8 * j; const LAS float* s = scr + (8 * c) * 33 + n;
        u32x4 o; o.x = pk2(s[0 * 33], s[1 * 33]); o.y = pk2(s[2 * 33], s[3 * 33]); o.z = pk2(s[4 * 33], s[5 * 33]); o.w = pk2(s[6 * 33], s[7 * 33]);
        *(u32x4*)(WT + (size_t)destrow(n0 + n) * K + k0 + 8 * c) = o; }
    asm volatile("s_waitcnt lgkmcnt(0)" ::: "memory");
}
struct DestIn { DI int operator()(int c) const { if (c >= 640 && c < 672) { const int i = c - 640; return 2304 + 640 + (i < 16 ? 2 * i : 2 * (i - 16) + 1); } return c < 672 ? 2304 + c : (c < 1696 ? c - 672 : (c < 2976 ? 1024 + (c - 1696) : 2304 + 672 + (c - 2976))); } };
struct DestQb { DI int operator()(int c) const { const int h = c / 96, j = c % 96; if (j < 64) return h * 64 + j; const int i = j - 64; return 1024 + h * 32 + (i < 16 ? 2 * i : 2 * (i - 16) + 1); } };
struct DestKvb { DI int operator()(int c) const { const int h = c >> 7, j = c & 127; return j < 64 ? h * 64 + j : 1024 + h * 64 + (j - 64); } };
struct DestId { DI int operator()(int c) const { return c; } };
struct DestGate { DI int operator()(int c) const { return 256 * (c >> 7) + (c & 127); } };
struct DestUp { DI int operator()(int c) const { return 256 * (c >> 7) + 128 + (c & 127); } };

DI void p0_prologue(const Params& P, LAS uchar* lds) {
    const int tid = otid(), lane = tid & 63, wave = tid >> 6, G = gridDim.x;
    const int gw = blockIdx.x * 8 + wave, NGW = G * 8;
    const int gt = blockIdx.x * 512 + tid, NGT = G * 512;
    LAS float* scr = (LAS float*)(lds + wave * 16384);
    bf16_t* Win = (bf16_t*)(P.ws + WS_WIN); bf16_t* Wqb = (bf16_t*)(P.ws + WS_WQB); bf16_t* Wkvb = (bf16_t*)(P.ws + WS_WKVB);
    bf16_t* Wout = (bf16_t*)(P.ws + WS_WOUT); bf16_t* Wgu = (bf16_t*)(P.ws + WS_WGU); bf16_t* Wdn = (bf16_t*)(P.ws + WS_WDN);
    constexpr int I_IN = 16 * 94, I_QB = 6 * 48, I_KVB = 4 * 64, I_OUT = 32 * 32, I_G = 16 * 88, I_DN = 44 * 32;
    constexpr int NITEMS = I_IN + I_QB + I_KVB + I_OUT + 2 * I_G + I_DN;
    for (int it = gw; it < NITEMS; it += NGW) {
        int r = it;
        if (r < I_IN) { transpose_item(P.w_in, 1024, DIN, Win, scr, r, lane, DestIn(), nullptr); continue; } r -= I_IN;
        if (r < I_QB) { transpose_item(P.w_q_b, 384, NQ, Wqb, scr, r, lane, DestQb(), P.q_a_norm); continue; } r -= I_QB;
        if (r < I_KVB) { transpose_item(P.w_kv_b, 256, NKV, Wkvb, scr, r, lane, DestKvb(), P.kv_a_norm); continue; } r -= I_KVB;
        if (r < I_OUT) { transpose_item(P.w_out, 2048, DM, Wout, scr, r, lane, DestId(), nullptr); continue; } r -= I_OUT;
        if (r < I_G) { transpose_item(P.w_gate, 1024, DFF, Wgu, scr, r, lane, DestGate(), P.norm2); continue; } r -= I_G;
        if (r < I_G) { transpose_item(P.w_up, 1024, DFF, Wgu, scr, r, lane, DestUp(), P.norm2); continue; } r -= I_G;
        transpose_item(P.w_down, DFF, DM, Wdn, scr, r, lane, DestId(), nullptr);
    }
    for (int i = gt; i < 64 * 1024 / 8; i += NGT) *(u32x4*)(Win + (size_t)3008 * 1024 + (size_t)i * 8) = (u32x4){0u, 0u, 0u, 0u};
    float* tab = (float*)(P.ws + WS_TAB);
    for (int i = gt; i < LS * 16; i += NGT) { const int pos = i >> 4, k = i & 15; const float inv = powf(10000.0f, -(float)(2 * k) / 32.0f); const float ang = (float)pos * inv; float s, c; sincosf(ang, &s, &c); tab[2 * i] = c; tab[2 * i + 1] = s; }
    float* ss = (float*)(P.ws + WS_SS);
    for (int i = gt; i < 4 * T; i += NGT) ss[i] = 0.f;
    bf16_t* hb = (bf16_t*)(P.ws + WS_H);
    for (int row = gw; row < T; row += NGW) {
        const f32x4* xr = (const f32x4*)xrow(P, row) + lane;
        f32x4 v[4]; float s = 0.f;
#pragma unroll
        for (int j = 0; j < 4; ++j) { v[j] = __builtin_nontemporal_load(xr + 64 * j); s += (v[j][0] * v[j][0] + v[j][1] * v[j][1]) + (v[j][2] * v[j][2] + v[j][3] * v[j][3]); }
        const float rs = rsqrtf(wave_sum(s) * (1.f / DM) + EPS);
        u32x2* o = (u32x2*)(hb + (size_t)row * DM) + lane;
#pragma unroll
        for (int j = 0; j < 4; ++j) { const f32x4 w = ((const f32x4*)P.norm1)[lane + 64 * j]; u32x2 pk; pk.x = pk2(v[j][0] * rs * w[0], v[j][1] * rs * w[1]); pk.y = pk2(v[j][2] * rs * w[2], v[j][3] * rs * w[3]); o[64 * j] = pk; }
    }
}

DI float gsum16(float v) { v += __shfl_xor(v, 1); v += __shfl_xor(v, 2); v += __shfl_xor(v, 4); v += __shfl_xor(v, 8); return v; }
template <bool ACT> DI void conv8_item(const bf16_t* src, bf16_t* dst, int ld, int lrow0, int grow0, int c0, const float* cw, const float* cb) {
    float w0[8], w1[8], w2[8], bb[8];
    { const f32x4 a0 = *(const f32x4*)(cw + c0), a1 = *(const f32x4*)(cw + c0 + 4), b0 = *(const f32x4*)(cw + ld + c0), b1 = *(const f32x4*)(cw + ld + c0 + 4);
      const f32x4 c0v = *(const f32x4*)(cw + 2 * ld + c0), c1v = *(const f32x4*)(cw + 2 * ld + c0 + 4), d0 = *(const f32x4*)(cb + c0), d1 = *(const f32x4*)(cb + c0 + 4);
#pragma unroll
      for (int j = 0; j < 4; ++j) { w0[j] = a0[j]; w0[4 + j] = a1[j]; w1[j] = b0[j]; w1[4 + j] = b1[j]; w2[j] = c0v[j]; w2[4 + j] = c1v[j]; bb[j] = d0[j]; bb[4 + j] = d1[j]; } }
    const int pos0 = posof(grow0), L = lenof(grow0);
    u32x4 raw[10], ur[8];
    const u32x4 zero4 = {0u, 0u, 0u, 0u};
    raw[0] = pos0 > 0 ? *(const u32x4*)(src + (size_t)(lrow0 - 1) * ld + c0) : zero4;
#pragma unroll
    for (int i = 0; i < 8; ++i) raw[1 + i] = *(const u32x4*)(src + (size_t)(lrow0 + i) * ld + c0);
    raw[9] = pos0 + 8 < L ? *(const u32x4*)(src + (size_t)(lrow0 + 8) * ld + c0) : zero4;
    if (ACT) {
#pragma unroll
        for (int i = 0; i < 8; ++i) ur[i] = *(const u32x4*)(dst + (size_t)(lrow0 + i) * ld + c0);
    }
    float prv[8], cur[8], nxt[8];
    unpack8(raw[0], prv); unpack8(raw[1], cur);
#pragma unroll
    for (int i = 0; i < 8; ++i) {
        unpack8(raw[2 + i], nxt);
        float o[8];
#pragma unroll
        for (int j = 0; j < 8; ++j) o[j] = silu(w0[j] * prv[j] + w1[j] * cur[j] + w2[j] * nxt[j] + bb[j]);
        if (ACT) { float uu[8]; unpack8(ur[i], uu);
#pragma unroll
            for (int j = 0; j < 8; ++j) o[j] *= uu[j]; }
        *(u32x4*)(dst + (size_t)(lrow0 + i) * ld + c0) = pack8(o);
#pragma unroll
        for (int j = 0; j < 8; ++j) { prv[j] = cur[j]; cur[j] = nxt[j]; }
    }
}
DI void p2_prep(const Params& P) {
    const int tid = otid(), lane = tid & 63, wave = tid >> 6, G = gridDim.x;
    const int gw = blockIdx.x * 8 + wave, NGW = G * 8;
    const int gt = blockIdx.x * 512 + tid, NGT = G * 512;
    bf16_t* lat = (bf16_t*)(P.ws + WS_LAT); float* dt = (float*)(P.ws + WS_DT); const float* tab = (const float*)(P.ws + WS_TAB);
    const int gl = lane >> 4, li = lane & 15;
    for (int row = gw * 4 + gl; row < T; row += NGW * 4) {
        bf16_t* lr = lat + (size_t)row * NLAT;
        u32x4 qr[3], kr[2];
#pragma unroll
        for (int j = 0; j < 3; ++j) qr[j] = *(const u32x4*)(lr + (li + 16 * j) * 8);
#pragma unroll
        for (int j = 0; j < 2; ++j) kr[j] = *(const u32x4*)(lr + 384 + (li + 16 * j) * 8);
        const float x1 = bf2f(lr[640 + li]), x2 = bf2f(lr[656 + li]);
        const float dv0 = dt[(size_t)row * 32 + li], dv1 = dt[(size_t)row * 32 + 16 + li];
        float qv[3][8], kv[2][8]; float sq = 0.f, sk = 0.f;
#pragma unroll
        for (int j = 0; j < 3; ++j) { unpack8(qr[j], qv[j]);
#pragma unroll
            for (int e = 0; e < 8; ++e) sq += qv[j][e] * qv[j][e]; }
#pragma unroll
        for (int j = 0; j < 2; ++j) { unpack8(kr[j], kv[j]);
#pragma unroll
            for (int e = 0; e < 8; ++e) sk += kv[j][e] * kv[j][e]; }
        sq = gsum16(sq); sk = gsum16(sk);
        const float rq = rsqrtf(sq * (1.f / 384.f) + EPS), rk = rsqrtf(sk * (1.f / 256.f) + EPS);
#pragma unroll
        for (int j = 0; j < 3; ++j) { float o[8]; const int c = (li + 16 * j) * 8;
#pragma unroll
            for (int e = 0; e < 8; ++e) o[e] = qv[j][e] * rq * P.q_a_norm[c + e];
            *(u32x4*)(lr + c) = pack8(o); }
#pragma unroll
        for (int j = 0; j < 2; ++j) { float o[8]; const int c = (li + 16 * j) * 8;
#pragma unroll
            for (int e = 0; e < 8; ++e) o[e] = kv[j][e] * rk * P.kv_a_norm[c + e];
            *(u32x4*)(lr + 384 + c) = pack8(o); }
        { const float c = tab[((size_t)posof(row) * 16 + li) * 2], s = tab[((size_t)posof(row) * 16 + li) * 2 + 1];
          *(unsigned*)(lr + 640 + 2 * li) = pk2(x1 * c - x2 * s, x2 * c + x1 * s); }
        { const float v0 = dv0 + P.dt_bias_f[li], v1 = dv1 + P.dt_bias_b[li];
          dt[(size_t)row * 32 + li] = fmaxf(v0, 0.f) + log1pf(__expf(-fabsf(v0)));
          dt[(size_t)row * 32 + 16 + li] = fmaxf(v1, 0.f) + log1pf(__expf(-fabsf(v1))); }
    }
    const bf16_t* xbc = (const bf16_t*)(P.ws + WS_XBC); bf16_t* xbc2 = (bf16_t*)(P.ws + WS_XBC2);
    for (int idx = gt; idx < (T / 8) * 160; idx += NGT) { const int rb = idx / 160, c0 = (idx - rb * 160) * 8; conv8_item<false>(xbc, xbc2, NXBC, rb * 8, rb * 8, c0, P.conv_w, P.conv_b); }
}

constexpr int BCROW = 144, SSD_BT = 0, SSD_CT = 128 * BCROW, SSD_WAVE = 2 * 128 * BCROW, SSD_WSZ = 8192 + 2048, SSD_RED = SSD_WAVE + 8 * SSD_WSZ;
constexpr size_t WS_DEC = 352 * MiB;
DI float wave_incl_scan(float v, int lane) {
#pragma unroll
    for (int o = 1; o < 64; o <<= 1) { const float n = __shfl_up(v, o); if (lane >= o) v += n; }
    return v;
}
DI bf16x8 tr_frag(const LAS uchar* p, int rowstride) {
    const s16x4 lo = __builtin_bit_cast(s16x4, __builtin_amdgcn_ds_read_tr16_b64_v4i16((LAS s16x4*)p));
    const s16x4 hh = __builtin_bit_cast(s16x4, __builtin_amdgcn_ds_read_tr16_b64_v4i16((LAS s16x4*)(p + 8 * rowstride)));
    return __builtin_shufflevector(lo, hh, 0, 1, 2, 3, 4, 5, 6, 7);
}
DI void ssd_chunk_prologue(const Params& P, LAS uchar* lds, int cg, int g) {
    const int tid = otid(), lane = tid & 63, wave = tid >> 6;
    const bf16_t* xbc2 = (const bf16_t*)(P.ws + WS_XBC2); const float* dtg = (const float*)(P.ws + WS_DT);
    const int row0 = cg * 128, head = g * 8 + wave;
    __syncthreads();
#pragma unroll
    for (int k = 0; k < 2; ++k) { const int c = tid + 512 * k, row = c >> 3, c16 = c & 7;
        const bf16_t* src = xbc2 + (size_t)(row0 + row) * NXBC + 1024 + g * 64 + c16 * 8;
        *(LAS u32x4*)(lds + SSD_BT + row * BCROW + c16 * 16) = *(const u32x4*)src;
        *(LAS u32x4*)(lds + SSD_CT + row * BCROW + c16 * 16) = *(const u32x4*)(src + 128); }
    LAS float* arr = (LAS float*)(lds + SSD_WAVE + wave * SSD_WSZ + 8192);
    const float Af = -__expf(P.a_log_f[head]), Ab = -__expf(P.a_log_b[head]);
    const float df0 = dtg[(size_t)(row0 + lane) * 32 + head], df1 = dtg[(size_t)(row0 + 64 + lane) * 32 + head];
    const float db0 = dtg[(size_t)(row0 + lane) * 32 + 16 + head], db1 = dtg[(size_t)(row0 + 64 + lane) * 32 + 16 + head];
    float p0 = wave_incl_scan(Af * df0, lane); const float tot0 = __shfl(p0, 63); float p1 = wave_incl_scan(Af * df1, lane) + tot0;
    float q0 = wave_incl_scan(Ab * db0, lane); const float qt0 = __shfl(q0, 63); float q1 = wave_incl_scan(Ab * db1, lane) + qt0; const float qtot = __shfl(q1, 63);
    arr[lane] = df0; arr[64 + lane] = df1; arr[128 + lane] = db0; arr[192 + lane] = db1;
    arr[256 + lane] = p0; arr[320 + lane] = p1;
    arr[384 + lane] = qtot - q0 + Ab * db0; arr[448 + lane] = qtot - q1 + Ab * db1;
    __syncthreads();
}
DI void ssd_xload(const Params& P, u32x4 (&v)[4], int row0, int sb, int head, int lane) {
    const bf16_t* xbc2 = (const bf16_t*)(P.ws + WS_XBC2);
#pragma unroll
    for (int i = 0; i < 4; ++i) { const int c = lane + 64 * i, row = c >> 3, c16 = c & 7; v[i] = *(const u32x4*)(xbc2 + (size_t)(row0 + 32 * sb + row) * NXBC + head * 64 + c16 * 8); }
}
DI void ssd_xstore(LAS uchar* xb, const u32x4 (&v)[4], int lane) {
#pragma unroll
    for (int i = 0; i < 4; ++i) { const int c = lane + 64 * i, row = c >> 3, c16 = c & 7; *(LAS u32x4*)(xb + row * 128 + c16 * 16) = v[i]; }
}
DI void p3_s1_states(const Params& P, LAS uchar* lds) {
    const int tid = otid(), lane = tid & 63, wave = tid >> 6, r32 = lane & 31, hi = lane >> 5;
    const int i16 = lane & 15, qq = i16 >> 2, pp = i16 & 3, blk = (lane >> 4) & 1;
    bf16_t* st = (bf16_t*)P.out; float* dec = (float*)(P.ws + WS_DEC);
    LAS uchar* xbuf = lds + SSD_WAVE + wave * SSD_WSZ; const LAS float* arr = (const LAS float*)(xbuf + 8192);
    for (int item = blockIdx.x; item < 1280; item += gridDim.x) {
        const int cg = item >> 1, g = item & 1, row0 = cg * 128, head = g * 8 + wave;
        u32x4 xr[4]; ssd_xload(P, xr, row0, 0, head, lane);
        ssd_chunk_prologue(P, lds, cg, g);
        f32x16 acc[2][2][2];
#pragma unroll
        for (int d = 0; d < 2; ++d)
#pragma unroll
            for (int a = 0; a < 2; ++a)
#pragma unroll
                for (int b = 0; b < 2; ++b)
#pragma unroll
                    for (int r = 0; r < 16; ++r) acc[d][a][b][r] = 0.f;
        const float wlf = arr[256 + 127], wlb = arr[384];
#pragma unroll 1
        for (int sb = 0; sb < 4; ++sb) {
            LAS uchar* xb = xbuf + (sb & 1) * 4096;
            ssd_xstore(xb, xr, lane);
            if (sb < 3) ssd_xload(P, xr, row0, sb + 1, head, lane);
#pragma unroll
            for (int k2 = 0; k2 < 2; ++k2) {
                const int sbase = 32 * sb + 16 * k2 + 4 * hi;
                float wf[8], wb[8];
                { const f32x4 a0 = *(const LAS f32x4*)(arr + 256 + sbase), a1 = *(const LAS f32x4*)(arr + 256 + sbase + 8), d0 = *(const LAS f32x4*)(arr + sbase), d1 = *(const LAS f32x4*)(arr + sbase + 8);
#pragma unroll
                  for (int j = 0; j < 4; ++j) { wf[j] = __expf(wlf - a0[j]) * d0[j]; wf[4 + j] = __expf(wlf - a1[j]) * d1[j]; } }
                { const f32x4 a0 = *(const LAS f32x4*)(arr + 384 + sbase), a1 = *(const LAS f32x4*)(arr + 384 + sbase + 8), d0 = *(const LAS f32x4*)(arr + 128 + sbase), d1 = *(const LAS f32x4*)(arr + 128 + sbase + 8);
#pragma unroll
                  for (int j = 0; j < 4; ++j) { wb[j] = __expf(wlb - a0[j]) * d0[j]; wb[4 + j] = __expf(wlb - a1[j]) * d1[j]; } }
                bf16x8 xsf[2], xsb[2];
#pragma unroll
                for (int pb = 0; pb < 2; ++pb) {
                    const bf16x8 xf = tr_frag(xb + (16 * k2 + 4 * hi + qq) * 128 + (32 * pb + 16 * blk + 4 * pp) * 2, 128);
                    float f[8], f2[8]; unpack8(__builtin_bit_cast(u32x4, xf), f);
#pragma unroll
                    for (int j = 0; j < 8; ++j) { f2[j] = f[j] * wb[j]; f[j] *= wf[j]; }
                    xsf[pb] = __builtin_bit_cast(bf16x8, pack8(f)); xsb[pb] = __builtin_bit_cast(bf16x8, pack8(f2));
                }
#pragma unroll
                for (int nb = 0; nb < 2; ++nb) {
                    const bf16x8 bf = tr_frag(lds + SSD_BT + (32 * sb + 16 * k2 + 4 * hi + qq) * BCROW + (32 * nb + 16 * blk + 4 * pp) * 2, BCROW);
#pragma unroll
                    for (int pb = 0; pb < 2; ++pb) {
                        acc[0][nb][pb] = __builtin_amdgcn_mfma_f32_32x32x16_bf16(bf, xsf[pb], acc[0][nb][pb], 0, 0, 0);
                        acc[1][nb][pb] = __builtin_amdgcn_mfma_f32_32x32x16_bf16(bf, xsb[pb], acc[1][nb][pb], 0, 0, 0);
                    }
                }
            }
        }
#pragma unroll
        for (int d = 0; d < 2; ++d) {
            bf16_t* so = st + ((size_t)(cg * 2 + d) * 16 + head) * 4096;
#pragma unroll
            for (int nb = 0; nb < 2; ++nb)
#pragma unroll
                for (int pb = 0; pb < 2; ++pb)
#pragma unroll
                    for (int gq = 0; gq < 4; ++gq) { u32x2 o; o.x = pk2(acc[d][nb][pb][4 * gq], acc[d][nb][pb][4 * gq + 1]); o.y = pk2(acc[d][nb][pb][4 * gq + 2], acc[d][nb][pb][4 * gq + 3]);
                        *(u32x2*)(so + (32 * pb + r32) * 64 + 32 * nb + 8 * gq + 4 * hi) = o; }
        }
        if (lane == 0) { dec[(cg * 2 + 0) * 16 + head] = __expf(wlf); dec[(cg * 2 + 1) * 16 + head] = __expf(wlb); }
    }
}
DI void p3_s2_scan(const Params& P) {
    unsigned* st = (unsigned*)P.out; const float* dec = (const float*)(P.ws + WS_DEC);
    for (int e = blockIdx.x * 512 + otid(); e < 65536; e += gridDim.x * 512) {
        const int dir = e >> 15, dh = e >> 11;
        for (int seq = 0; seq < 33; ++seq) {
            const int c0 = seq * 16, nc = seq < 32 ? 16 : 128;
            float h0 = 0.f, h1 = 0.f;
            for (int b = 0; b < nc; b += 16) {
                unsigned s[16]; float d[16];
#pragma unroll
                for (int i = 0; i < 16; ++i) { const int c = dir == 0 ? c0 + b + i : c0 + nc - 1 - b - i; s[i] = st[(size_t)c * 65536 + e]; d[i] = dec[c * 32 + dh]; }
#pragma unroll
                for (int i = 0; i < 16; ++i) { const float t0 = __uint_as_float(s[i] << 16), t1 = __uint_as_float(s[i] & 0xffff0000u); s[i] = pk2(h0, h1); h0 = h0 * d[i] + t0; h1 = h1 * d[i] + t1; }
#pragma unroll
                for (int i = 0; i < 16; ++i) { const int c = dir == 0 ? c0 + b + i : c0 + nc - 1 - b - i; st[(size_t)c * 65536 + e] = s[i]; }
            }
        }
    }
}
DI void p3_s3_output(const Params& P, LAS uchar* lds, unsigned long long& tacc_) {
    unsigned long long tA_ = 0;
    const int tid = otid(), lane = tid & 63, wave = tid >> 6, r32 = lane & 31, hi = lane >> 5;
    const int i16 = lane & 15, qq = i16 >> 2, pp = i16 & 3, blk = (lane >> 4) & 1;
    const bf16_t* st = (const bf16_t*)P.out; const bf16_t* zb = (const bf16_t*)(P.ws + WS_Z); bf16_t* mix = (bf16_t*)(P.ws + WS_MIX);
    LAS uchar* xbuf = lds + SSD_WAVE + wave * SSD_WSZ; const LAS float* arr = (const LAS float*)(xbuf + 8192);
    LAS float* red = (LAS float*)(lds + SSD_RED);
    for (int item = blockIdx.x; item < 1280; item += gridDim.x) {
        const int cg = item >> 1, g = item & 1, row0 = cg * 128, head = g * 8 + wave;
        PB(13);
        bf16x8 hfr[2][4][2];
#pragma unroll
        for (int d = 0; d < 2; ++d) { const bf16_t* H = st + ((size_t)(cg * 2 + d) * 16 + head) * 4096;
#pragma unroll
            for (int ks = 0; ks < 4; ++ks)
#pragma unroll
                for (int pb = 0; pb < 2; ++pb) hfr[d][ks][pb] = *(const bf16x8*)(H + (32 * pb + r32) * 64 + 16 * ks + 8 * hi); }
        u32x4 xr[4]; ssd_xload(P, xr, row0, 0, head, lane);
        ssd_chunk_prologue(P, lds, cg, g);
        const float Dk = P.d_skip[head];
        PE(13);
#pragma unroll 1
        for (int tb = 0; tb < 4; ++tb) {
            PB(14);
            const int t = 32 * tb + r32;
            const float af_t = arr[256 + t], rb_t = arr[384 + t];
            const float ef = __expf(af_t), eb = __expf(rb_t);
            bf16x8 cfr[4];
#pragma unroll
            for (int ks = 0; ks < 4; ++ks) cfr[ks] = *(const LAS bf16x8*)(lds + SSD_CT + t * BCROW + ks * 32 + hi * 16);
            const int row = row0 + t; const int cbase = g * 512 + wave * 64;
            f32x16 acc[2];
#pragma unroll
            for (int dir = 0; dir < 2; ++dir) {
                f32x16 tmp[2];
#pragma unroll
                for (int pb = 0; pb < 2; ++pb)
#pragma unroll
                    for (int r = 0; r < 16; ++r) tmp[pb][r] = 0.f;
#pragma unroll
                for (int ks = 0; ks < 4; ++ks)
#pragma unroll
                    for (int pb = 0; pb < 2; ++pb) tmp[pb] = __builtin_amdgcn_mfma_f32_32x32x16_bf16(hfr[dir][ks][pb], cfr[ks], tmp[pb], 0, 0, 0);
                const float e = dir == 0 ? ef : eb;
#pragma unroll
                for (int pb = 0; pb < 2; ++pb)
#pragma unroll
                    for (int r = 0; r < 16; ++r) acc[pb][r] = dir == 0 ? e * tmp[pb][r] : acc[pb][r] + e * tmp[pb][r];
            }
            PE(14); PB(15);
            u32x2 zw[2][4];
#pragma unroll
            for (int pb = 0; pb < 2; ++pb)
#pragma unroll
                for (int gq = 0; gq < 4; ++gq) zw[pb][gq] = *(const u32x2*)(zb + (size_t)row * DM + cbase + 32 * pb + 8 * gq + 4 * hi);
#pragma unroll 1
            for (int sb = 0; sb < 4; ++sb) {
                LAS uchar* xb = xbuf + (sb & 1) * 4096;
                ssd_xstore(xb, xr, lane);
                if (sb < 3 || tb < 3) ssd_xload(P, xr, row0, (sb + 1) & 3, head, lane);
                f32x16 X;
#pragma unroll
                for (int r = 0; r < 16; ++r) X[r] = 0.f;
#pragma unroll
                for (int ks = 0; ks < 4; ++ks) {
                    const bf16x8 bfa = *(const LAS bf16x8*)(lds + SSD_BT + (32 * sb + r32) * BCROW + ks * 32 + hi * 16);
                    const bf16x8 cfk = *(const LAS bf16x8*)(lds + SSD_CT + t * BCROW + ks * 32 + hi * 16);
                    X = __builtin_amdgcn_mfma_f32_32x32x16_bf16(bfa, cfk, X, 0, 0, 0);
                }
                constexpr float L2E = 1.4426950408889634f;
                if (sb < tb) {
                    const float a2 = af_t * L2E;
#pragma unroll
                    for (int gq = 0; gq < 4; ++gq) { const int s0 = 32 * sb + 8 * gq + 4 * hi;
                        const f32x4 dfv = *(const LAS f32x4*)(arr + s0), afv = *(const LAS f32x4*)(arr + 256 + s0);
#pragma unroll
                        for (int j = 0; j < 4; ++j) X[4 * gq + j] *= __builtin_amdgcn_exp2f(a2 - afv[j] * L2E) * dfv[j]; }
                } else if (sb > tb) {
                    const float b2 = rb_t * L2E;
#pragma unroll
                    for (int gq = 0; gq < 4; ++gq) { const int s0 = 32 * sb + 8 * gq + 4 * hi;
                        const f32x4 dbv = *(const LAS f32x4*)(arr + 128 + s0), rbv = *(const LAS f32x4*)(arr + 384 + s0);
#pragma unroll
                        for (int j = 0; j < 4; ++j) X[4 * gq + j] *= __builtin_amdgcn_exp2f(b2 - rbv[j] * L2E) * dbv[j]; }
                } else {
#pragma unroll
                    for (int gq = 0; gq < 4; ++gq) {
                        const int s0 = 32 * sb + 8 * gq + 4 * hi;
                        const f32x4 dfv = *(const LAS f32x4*)(arr + s0), dbv = *(const LAS f32x4*)(arr + 128 + s0);
                        const f32x4 afv = *(const LAS f32x4*)(arr + 256 + s0), rbv = *(const LAS f32x4*)(arr + 384 + s0);
#pragma unroll
                        for (int j = 0; j < 4; ++j) {
                            const int s = s0 + j;
                            float coef = 0.f;
                            if (s <= t) coef = __expf(af_t - afv[j]) * dfv[j];
                            if (s >= t) coef += __expf(rb_t - rbv[j]) * dbv[j];
                            float v = X[4 * gq + j] * coef;
                            if (s == t) v += Dk;
                            X[4 * gq + j] = v;
                        }
                    }
                }
#pragma unroll
                for (int s2 = 0; s2 < 2; ++s2) {
                    u32x4 pw;
                    if (s2 == 0) { pw.x = pk2(X[0], X[1]); pw.y = pk2(X[2], X[3]); pw.z = pk2(X[4], X[5]); pw.w = pk2(X[6], X[7]); }
                    else { pw.x = pk2(X[8], X[9]); pw.y = pk2(X[10], X[11]); pw.z = pk2(X[12], X[13]); pw.w = pk2(X[14], X[15]); }
                    const bf16x8 pbk = __builtin_bit_cast(bf16x8, pw);
#pragma unroll
                    for (int pb = 0; pb < 2; ++pb) {
                        const bf16x8 xf = tr_frag(xb + (16 * s2 + 4 * hi + qq) * 128 + (32 * pb + 16 * blk + 4 * pp) * 2, 128);
                        acc[pb] = __builtin_amdgcn_mfma_f32_32x32x16_bf16(xf, pbk, acc[pb], 0, 0, 0);
                    }
                }
            }
            PE(15); PB(16);
            float ssum = 0.f;
#pragma unroll
            for (int pb = 0; pb < 2; ++pb)
#pragma unroll
                for (int gq = 0; gq < 4; ++gq) {
                    const u32x2 zz = zw[pb][gq];
                    const float z0 = __uint_as_float(zz.x << 16), z1 = __uint_as_float(zz.x & 0xffff0000u), z2 = __uint_as_float(zz.y << 16), z3 = __uint_as_float(zz.y & 0xffff0000u);
                    float v0 = acc[pb][4 * gq] * silu(z0), v1 = acc[pb][4 * gq + 1] * silu(z1), v2 = acc[pb][4 * gq + 2] * silu(z2), v3 = acc[pb][4 * gq + 3] * silu(z3);
                    acc[pb][4 * gq] = v0; acc[pb][4 * gq + 1] = v1; acc[pb][4 * gq + 2] = v2; acc[pb][4 * gq + 3] = v3;
                    ssum += (v0 * v0 + v1 * v1) + (v2 * v2 + v3 * v3);
                }
            ssum += __shfl_xor(ssum, 32);
            LAS float* rd = red + (tb & 1) * 256;
            if (hi == 0) rd[wave * 32 + r32] = ssum;
            __syncthreads();
            float tot = 0.f;
#pragma unroll
            for (int w = 0; w < 8; ++w) tot += rd[w * 32 + r32];
            const float rs = rsqrtf(tot * (1.f / 512.f) + EPS);
#pragma unroll
            for (int pb = 0; pb < 2; ++pb)
#pragma unroll
                for (int gq = 0; gq < 4; ++gq) {
                    const int p0 = 32 * pb + 8 * gq + 4 * hi;
                    const f32x4 nw = *(const f32x4*)(P.ssm_norm + cbase + p0);
                    u32x2 o; o.x = pk2(acc[pb][4 * gq] * rs * nw[0], acc[pb][4 * gq + 1] * rs * nw[1]); o.y = pk2(acc[pb][4 * gq + 2] * rs * nw[2], acc[pb][4 * gq + 3] * rs * nw[3]);
                    *(u32x2*)(mix + (size_t)row * 2048 + 1024 + cbase + p0) = o;
                }
            PE(16);
        }
    }
}

DI float max3f(float a, float b, float c) { float r; asm("v_max3_f32 %0, %1, %2, %3" : "=v"(r) : "v"(a), "v"(b), "v"(c)); return r; }
DI float fadd_s(float a, float b) { float r; asm("v_add_f32_e32 %0, %1, %2" : "=v"(r) : "v"(a), "v"(b)); return r; }
constexpr int KROW = 208, VROW = 192, KTILE = 64 * KROW, VTILE = 64 * VROW;
DI void attn_unit(const Params& P, LAS uchar* lds, int rowbase, int L, int h, int qb) {
    const int tid = otid(), lane = tid & 63, wid = __builtin_amdgcn_readfirstlane(tid >> 6), r32 = lane & 31, hi = lane >> 5;
    const bf16_t* qbuf = (const bf16_t*)P.out; const bf16_t* kvb = (const bf16_t*)(P.ws + WS_KV); const bf16_t* lat = (const bf16_t*)(P.ws + WS_LAT);
    bf16_t* mix = (bf16_t*)(P.ws + WS_MIX);
    const int qrow0 = rowbase + qb * 512 + wid * 64 + r32;
    bf16x8 qf[2][6];
#pragma unroll
    for (int j = 0; j < 2; ++j) { const bf16_t* Qg = qbuf + (size_t)(qrow0 + 32 * j) * NQ;
#pragma unroll
      for (int ks = 0; ks < 4; ++ks) qf[j][ks] = *(const bf16x8*)(Qg + h * 64 + ks * 16 + hi * 8);
#pragma unroll
      for (int ks = 0; ks < 2; ++ks) { float f[8], o[8]; unpack8(*(const u32x4*)(Qg + 1024 + h * 32 + ks * 16 + hi * 8), f);
          const float* tp = (const float*)(P.ws + WS_TAB) + ((size_t)(qrow0 + 32 * j - rowbase) * 16 + 8 * ks + 4 * hi) * 2;
          const f32x4 c0 = *(const f32x4*)tp, c1 = *(const f32x4*)(tp + 4);
          o[0] = f[0] * c0[0] - f[1] * c0[1]; o[1] = f[1] * c0[0] + f[0] * c0[1]; o[2] = f[2] * c0[2] - f[3] * c0[3]; o[3] = f[3] * c0[2] + f[2] * c0[3];
          o[4] = f[4] * c1[0] - f[5] * c1[1]; o[5] = f[5] * c1[0] + f[4] * c1[1]; o[6] = f[6] * c1[2] - f[7] * c1[3]; o[7] = f[7] * c1[2] + f[6] * c1[3];
          qf[j][4 + ks] = __builtin_bit_cast(bf16x8, pack8(o)); } }
    LAS uchar* Kb0 = lds; LAS uchar* Vb0 = lds + 2 * KTILE;
    const int skey = tid >> 3, sch = tid & 7, rkey = (tid >> 2) & 63, rch = tid & 3;
    const bf16_t* kn_src = kvb + (size_t)(rowbase + skey) * NKV + h * 64 + sch * 8;
    const bf16_t* v_src = kn_src + 1024;
    const bf16_t* kr_src = lat + (size_t)(rowbase + rkey) * NLAT + 640 + rch * 8;
    u32x4 rkn, rv, rkr = {0u, 0u, 0u, 0u};
    rkn = *(const u32x4*)kn_src; rv = *(const u32x4*)v_src; if (tid < 256) rkr = *(const u32x4*)kr_src;
    *(LAS u32x4*)(Kb0 + skey * KROW + sch * 16) = rkn; *(LAS u32x4*)(Vb0 + skey * VROW + sch * 16) = rv; if (tid < 256) *(LAS u32x4*)(Kb0 + rkey * KROW + 128 + rch * 16) = rkr;
    { const size_t adv = 64; rkn = *(const u32x4*)(kn_src + adv * NKV); rv = *(const u32x4*)(v_src + adv * NKV); if (tid < 256) rkr = *(const u32x4*)(kr_src + adv * NLAT); }
    __syncthreads();
    if (wid >= 4) __builtin_amdgcn_s_barrier();
    bf16x8 kaug, qaug[2];
    { const short one = hi == 0 ? (short)0x3F80 : (short)0; kaug = (bf16x8){one, 0, 0, 0, 0, 0, 0, 0}; }
    {
        f32x16 p[2][2];
#pragma unroll
        for (int j = 0; j < 2; ++j)
#pragma unroll
            for (int hh = 0; hh < 2; ++hh)
#pragma unroll
                for (int r = 0; r < 16; ++r) p[j][hh][r] = 0.f;
#pragma unroll
        for (int ks = 0; ks < 6; ++ks) {
            const bf16x8 k0 = *(const LAS bf16x8*)(Kb0 + r32 * KROW + ks * 32 + hi * 16);
            const bf16x8 k1 = *(const LAS bf16x8*)(Kb0 + (32 + r32) * KROW + ks * 32 + hi * 16);
#pragma unroll
            for (int j = 0; j < 2; ++j) {
                p[j][0] = __builtin_amdgcn_mfma_f32_32x32x16_bf16(k0, qf[j][ks], p[j][0], 0, 0, 0);
                p[j][1] = __builtin_amdgcn_mfma_f32_32x32x16_bf16(k1, qf[j][ks], p[j][1], 0, 0, 0);
            }
        }
        asm volatile("s_nop 15\n\ts_nop 7" : "+v"(p[0][0]), "+v"(p[0][1]), "+v"(p[1][0]), "+v"(p[1][1]));
#pragma unroll
        for (int j = 0; j < 2; ++j) {
            float mxa = max3f(p[j][0][0], p[j][0][1], p[j][1][0]), mxb = max3f(p[j][0][2], p[j][0][3], p[j][1][1]);
            mxa = max3f(mxa, p[j][1][2], p[j][1][3]);
#pragma unroll
            for (int r = 4; r < 16; r += 4) { mxa = max3f(mxa, p[j][0][r], p[j][0][r + 1]); mxb = max3f(mxb, p[j][0][r + 2], p[j][0][r + 3]); mxa = max3f(mxa, p[j][1][r], p[j][1][r + 1]); mxb = max3f(mxb, p[j][1][r + 2], p[j][1][r + 3]); }
            float mx = max3f(mxa, mxb, mxa); mx = fmaxf(mx, __shfl_xor(mx, 32));
            const short nb = hi == 0 ? (short)(pk2(-mx, 0.f) & 0xffffu) : (short)0;
            qaug[j] = (bf16x8){nb, 0, 0, 0, 0, 0, 0, 0};
        }
    }
    float lrun[2] = {0.f, 0.f}; f32x16 o[2][2];
#pragma unroll
    for (int j = 0; j < 2; ++j)
#pragma unroll
        for (int d = 0; d < 2; ++d)
#pragma unroll
            for (int r = 0; r < 16; ++r) o[j][d][r] = 0.f;
    const int NT = L / 64;
    const int i16 = lane & 15, qq = i16 >> 2, pp = i16 & 3, blk = (lane >> 4) & 1;
    const int vtr_off = (4 * hi + qq) * VROW + (16 * blk + 4 * pp) * 2;
    for (int kt = 0; kt < NT; ++kt) {
        const int cur = kt & 1;
        const LAS uchar* Kb = Kb0 + cur * KTILE; const LAS uchar* Vb = Vb0 + cur * VTILE;
        f32x16 p[2][2];
#pragma unroll
        for (int j = 0; j < 2; ++j)
#pragma unroll
            for (int hh = 0; hh < 2; ++hh)
#pragma unroll
                for (int r = 0; r < 16; ++r) p[j][hh][r] = 0.f;
#pragma unroll
        for (int ks = 0; ks < 6; ++ks) {
            const bf16x8 k0 = *(const LAS bf16x8*)(Kb + r32 * KROW + ks * 32 + hi * 16);
            const bf16x8 k1 = *(const LAS bf16x8*)(Kb + (32 + r32) * KROW + ks * 32 + hi * 16);
#pragma unroll
            for (int j = 0; j < 2; ++j) {
                p[j][0] = __builtin_amdgcn_mfma_f32_32x32x16_bf16(k0, qf[j][ks], p[j][0], 0, 0, 0);
                p[j][1] = __builtin_amdgcn_mfma_f32_32x32x16_bf16(k1, qf[j][ks], p[j][1], 0, 0, 0);
            }
        }
#pragma unroll
        for (int j = 0; j < 2; ++j) { p[j][0] = __builtin_amdgcn_mfma_f32_32x32x16_bf16(kaug, qaug[j], p[j][0], 0, 0, 0); p[j][1] = __builtin_amdgcn_mfma_f32_32x32x16_bf16(kaug, qaug[j], p[j][1], 0, 0, 0); }
        if (kt + 1 < NT) { LAS uchar* Kn = Kb0 + (cur ^ 1) * KTILE;
            *(LAS u32x4*)(Kn + skey * KROW + sch * 16) = rkn; if (tid < 256) *(LAS u32x4*)(Kn + rkey * KROW + 128 + rch * 16) = rkr; }
        __builtin_amdgcn_sched_barrier(0);
        asm volatile("s_waitcnt lgkmcnt(0)" ::: "memory"); __builtin_amdgcn_s_barrier(); asm volatile("" ::: "memory");
        __builtin_amdgcn_sched_barrier(0);
        __builtin_amdgcn_s_setprio(1);
#pragma unroll
        for (int s = 0; s < 4; ++s) {
            bf16x8 va[2];
#pragma unroll
            for (int db = 0; db < 2; ++db) {
                const LAS uchar* vp = Vb + vtr_off + s * 16 * VROW + db * 64;
                const s16x4 lo = __builtin_bit_cast(s16x4, __builtin_amdgcn_ds_read_tr16_b64_v4i16((LAS s16x4*)vp));
                const s16x4 hh = __builtin_bit_cast(s16x4, __builtin_amdgcn_ds_read_tr16_b64_v4i16((LAS s16x4*)(vp + 8 * VROW)));
                va[db] = __builtin_shufflevector(lo, hh, 0, 1, 2, 3, 4, 5, 6, 7);
            }
#pragma unroll
            for (int j = 0; j < 2; ++j) {
                const f32x16& pp_ = p[j][s >> 1]; const int b = 8 * (s & 1);
                float e[8];
#pragma unroll
                for (int i = 0; i < 8; ++i) e[i] = __builtin_amdgcn_exp2f(pp_[b + i]);
                lrun[j] = fadd_s(lrun[j], fadd_s(fadd_s(fadd_s(e[0], e[1]), fadd_s(e[2], e[3])), fadd_s(fadd_s(e[4], e[5]), fadd_s(e[6], e[7]))));
                u32x4 pw; pw.x = pk2(e[0], e[1]); pw.y = pk2(e[2], e[3]); pw.z = pk2(e[4], e[5]); pw.w = pk2(e[6], e[7]);
                const bf16x8 pbj = __builtin_bit_cast(bf16x8, pw);
                o[j][0] = __builtin_amdgcn_mfma_f32_32x32x16_bf16(va[0], pbj, o[j][0], 0, 0, 0);
                o[j][1] = __builtin_amdgcn_mfma_f32_32x32x16_bf16(va[1], pbj, o[j][1], 0, 0, 0);
                __builtin_amdgcn_sched_barrier(0);
            }
        }
        __builtin_amdgcn_s_setprio(0);
        if (kt + 1 < NT) { LAS uchar* Vn = Vb0 + (cur ^ 1) * VTILE; *(LAS u32x4*)(Vn + skey * VROW + sch * 16) = rv; }
        if (kt + 2 < NT) { const size_t adv = (size_t)(kt + 2) * 64; rkn = *(const u32x4*)(kn_src + adv * NKV); rv = *(const u32x4*)(v_src + adv * NKV); if (tid < 256) rkr = *(const u32x4*)(kr_src + adv * NLAT); }
        asm volatile("s_waitcnt lgkmcnt(0)" ::: "memory"); __builtin_amdgcn_s_barrier(); asm volatile("" ::: "memory");
    }
    if (wid < 4) __builtin_amdgcn_s_barrier();
#pragma unroll
    for (int j = 0; j < 2; ++j) {
        const float ltot = lrun[j] + __shfl_xor(lrun[j], 32); const float inv = 1.f / ltot;
        bf16_t* op = mix + (size_t)(qrow0 + 32 * j) * 2048 + h * 64 + 4 * hi;
#pragma unroll
        for (int g = 0; g < 4; ++g) {
            u32x2 w0, w1;
            w0.x = pk2(o[j][0][4 * g] * inv, o[j][0][4 * g + 1] * inv); w0.y = pk2(o[j][0][4 * g + 2] * inv, o[j][0][4 * g + 3] * inv);
            w1.x = pk2(o[j][1][4 * g] * inv, o[j][1][4 * g + 1] * inv); w1.y = pk2(o[j][1][4 * g + 2] * inv, o[j][1][4 * g + 3] * inv);
            *(u32x2*)(op + 8 * g) = w0; *(u32x2*)(op + 32 + 8 * g) = w1;
        }
    }
}
DI void p5_attention(const Params& P, LAS uchar* lds) {
    const int G = gridDim.x, bx = blockIdx.x; const int vcu = (G % 8 == 0) ? (bx % 8) * (G / 8) + bx / 8 : bx;
    const int perS = (512 + G - 1) / G, perP = (2048 + G - 1) / G;
    for (int i = 0; i < perS; ++i) { const int s = vcu * perS + i; if (s < 512) attn_unit(P, lds, TP, LS, s >> 5, s & 31); }
    for (int i = 0; i < perP; ++i) { const int s = vcu * perP + i; if (s < 2048) { const int b = s >> 6, rem = s & 63; attn_unit(P, lds, b * LP, LP, rem >> 2, rem & 3); } }
}

DI void p8_act(const Params& P, int rows, int row_off) {
    const int gt = blockIdx.x * 512 + otid(), NGT = gridDim.x * 512;
    const bf16_t* g = (const bf16_t*)(P.ws + WS_G); bf16_t* uo = (bf16_t*)(P.ws + WS_U);
    for (int idx = gt; idx < (rows / 8) * 352; idx += NGT) { const int rb = idx / 352, c0 = (idx - rb * 352) * 8; conv8_item<true>(g, uo, DFF, rb * 8, row_off + rb * 8, c0, P.ffn_conv_w, P.ffn_conv_b); }
}
DI void p2_fixup(const Params& P) {
    const int gt = blockIdx.x * 512 + otid(), NGT = gridDim.x * 512;
    const float* halo = (const float*)(P.ws + WS_HALO2); bf16_t* xbc2 = (bf16_t*)(P.ws + WS_XBC2); const size_t hs = (size_t)320 * 2 * NXBC;
    for (int idx = gt; idx < 320 * 2 * NXBC; idx += NGT) {
        const int ch = idx % NXBC, r2 = idx / NXBC, pm = r2 >> 1, lastrow = r2 & 1;
        const int row = pm * 256 + (lastrow ? 255 : 0); const int pos = posof(row), L = lenof(row);
        const float part = halo[(size_t)r2 * NXBC + ch];
        float gn = 0.f, w;
        if (!lastrow) { w = P.conv_w[ch]; if (pos > 0) gn = halo[hs + ((size_t)(pm - 1) * 2 + 1) * NXBC + ch]; }
        else { w = P.conv_w[2 * NXBC + ch]; if (pos < L - 1) gn = halo[hs + ((size_t)(pm + 1) * 2 + 0) * NXBC + ch]; }
        xbc2[(size_t)row * NXBC + ch] = (unsigned short)(pk2(silu(part + w * gn), 0.f) & 0xffffu);
    }
}
DI void p_fixup(const Params& P) {
    const int gt = blockIdx.x * 512 + otid(), NGT = gridDim.x * 512;
    const float* halo = (const float*)(P.ws + WS_HALO); bf16_t* act = (bf16_t*)(P.ws + WS_ACT);
    for (int idx = gt; idx < 320 * 2 * DFF; idx += NGT) {
        const int ch = idx % DFF, r2 = idx / DFF, pm = r2 >> 1, lastrow = r2 & 1;
        const int row = pm * 256 + (lastrow ? 255 : 0); const int pos = posof(row), L = lenof(row);
        const float part = halo[((size_t)(0 * 320 + pm) * 2 + lastrow) * DFF + ch], uv = halo[((size_t)(1 * 320 + pm) * 2 + lastrow) * DFF + ch];
        float gn = 0.f, w;
        if (!lastrow) { w = P.ffn_conv_w[ch]; if (pos > 0) gn = halo[((size_t)(2 * 320 + pm - 1) * 2 + 1) * DFF + ch]; }
        else { w = P.ffn_conv_w[2 * DFF + ch]; if (pos < L - 1) gn = halo[((size_t)(2 * 320 + pm + 1) * 2 + 0) * DFF + ch]; }
        const float v = part + w * gn;
        const unsigned short ob = (unsigned short)(pk2(silu(v) * uv, 0.f) & 0xffffu);
        act[(size_t)row * DFF + ch] = ob;
    }
}
DI void p_final(const Params& P) {
    const int gt = blockIdx.x * 512 + otid(), NGT = gridDim.x * 512;
    const float* ss2 = (const float*)(P.ws + WS_SS) + T;
    for (int idx = gt; idx < T * 256; idx += 4 * NGT) {
        f32x4 v[4]; float rs[4];
#pragma unroll
        for (int k = 0; k < 4; ++k) { const int i = idx + k * NGT; if (i < T * 256) { v[k] = ((const f32x4*)P.out)[i]; rs[k] = ss2[i >> 8]; } }
#pragma unroll
        for (int k = 0; k < 4; ++k) { const int i = idx + k * NGT; if (i < T * 256) { const f32x4 w = ((const f32x4*)P.final_norm)[i & 255]; __builtin_nontemporal_store(v[k] * rsqrtf(rs[k] * (1.f / DM) + EPS) * w, (f32x4*)P.out + i); } }
    }
}

#define XB_TMO      128
#define XB_XCNT(j)  (256  + 64 * (j))
#define XB_XSUB(j)  (1280 + 64 * (j))
#define XB_XGEN(j)  (2304 + 64 * (j))
#define XB_TOP      3328
#define XB_TOPGEN   3392
#define XCD_BAR_WORDS 3456
#define XB_SPIN_CAP (1u << 18)

__device__ __forceinline__ unsigned xb_ld(unsigned* p)              { return __hip_atomic_load(p, __ATOMIC_RELAXED, __HIP_MEMORY_SCOPE_AGENT); }
__device__ __forceinline__ unsigned xb_add(unsigned* p, unsigned v) { return __hip_atomic_fetch_add(p, v, __ATOMIC_RELAXED, __HIP_MEMORY_SCOPE_AGENT); }
__device__ __forceinline__ unsigned xb_xcc_id() { return (unsigned)__builtin_amdgcn_s_getreg((3 << 11) | 20) & 0xFu; }
#define XB_SPIN(cond, bar) do { unsigned _sp = 0; while (cond) { __builtin_amdgcn_s_sleep(1); \
    if ((++_sp & 255u) == 0u) { if (xb_ld(&(bar)[XB_TMO])) break; if (_sp > XB_SPIN_CAP) { atomicAdd(&(bar)[XB_TMO], 1u); break; } } } } while (0)

struct XcdBarrier {
    unsigned* bar; unsigned x;
    volatile LAS unsigned* st;
};

__device__ __forceinline__ XcdBarrier xcd_barrier_post(unsigned* bar, volatile LAS unsigned* st) {
    XcdBarrier b; b.bar = bar; b.x = xb_xcc_id(); b.st = st;
    if (threadIdx.x == 0) (void)xb_add(&bar[XB_XCNT(b.x)], 1u);
    return b;
}
__device__ __forceinline__ void xcd_barrier_complete(unsigned* bar, unsigned x, unsigned& nloc, unsigned& nx) {
    const unsigned G = gridDim.x * gridDim.y * gridDim.z;
    unsigned sum, cnt, mine, sp = 0u;
    for (;;) {
        sum = 0u; cnt = 0u; mine = 0u;
#pragma unroll
        for (unsigned j = 0; j < 16; ++j) { const unsigned c = xb_ld(&bar[XB_XCNT(j)]); sum += c; cnt += (c > 0u) ? 1u : 0u; mine = (j == x) ? c : mine; }
        if (sum == G) break;
        __builtin_amdgcn_s_sleep(1);
        if ((++sp & 255u) == 0u) { if (xb_ld(&bar[XB_TMO])) break; if (sp > XB_SPIN_CAP) { atomicAdd(&bar[XB_TMO], 1u); break; } }
    }
    nloc = mine > 0u ? mine : 1u; nx = cnt > 0u ? cnt : 1u;
}

__device__ __forceinline__ void xcd_barrier(const XcdBarrier& b) {
    asm volatile("s_waitcnt vmcnt(0)" ::: "memory");
    __syncthreads();
    if (threadIdx.x == 0) {
        unsigned* bar = b.bar; const unsigned bx_ = xb_xcc_id();
        __builtin_amdgcn_s_waitcnt(0);
        unsigned nloc = b.st[0], nx = b.st[1];
        if (nloc == 0u) { xcd_barrier_complete(bar, bx_, nloc, nx); b.st[0] = nloc; b.st[1] = nx; }
        const unsigned old = xb_add(&bar[XB_XSUB(bx_)], 1u);
        const unsigned gen = old / nloc;
        if (old + 1u == (gen + 1u) * nloc) {
            __builtin_amdgcn_fence(__ATOMIC_RELEASE, "agent");
            asm volatile("s_waitcnt vmcnt(0)" ::: "memory");
            const unsigned og = xb_add(&bar[XB_TOP], 1u);
            const unsigned tg = og / nx;
            if (og + 1u == (tg + 1u) * nx) xb_add(&bar[XB_TOPGEN], 1u);
            else XB_SPIN(xb_ld(&bar[XB_TOPGEN]) == tg, bar);
            __builtin_amdgcn_fence(__ATOMIC_ACQUIRE, "agent");
            xb_add(&bar[XB_XGEN(bx_)], 1u);
            asm volatile("s_waitcnt vmcnt(0)" ::: "memory");
        } else {
            XB_SPIN(xb_ld(&bar[XB_XGEN(bx_)]) == gen, bar);
            __builtin_amdgcn_fence(__ATOMIC_ACQUIRE, "agent");
            asm volatile("s_waitcnt vmcnt(0)" ::: "memory");
        }
    }
    __syncthreads();
}

constexpr int LDS_BYTES = 147456;
template <class Epi> DI void run_gemm(LAS uchar* lds, const bf16_t* A, int lda, const bf16_t* Bt, int M, int N, int K, const Epi& E) {
    pg8::Gemm g{A, Bt, M, N, K, lda}; pg8::StaticOrder S; S.init(M, N, (int)gridDim.x, (int)blockIdx.x);
    pg8::gemm_phase<Epi, pg8::StaticOrder, true, true>(lds, g, S, E);
}
__global__ void __launch_bounds__(512, 2) mega(Params P) {
    extern __shared__ __attribute__((aligned(16))) uchar lds_[];
    LAS uchar* lds = (LAS uchar*)lds_;
    cg::grid_group grid = cg::this_grid();
    uchar* ws = P.ws;
    volatile LAS unsigned* bst = (volatile LAS unsigned*)(lds + LDS_BYTES - 16);
    if (threadIdx.x < 4) bst[threadIdx.x] = 0u;
    __syncthreads();
    const XcdBarrier bar = xcd_barrier_post((unsigned*)(ws + WS_BAR), bst);
    bf16_t* lat = (bf16_t*)(ws + WS_LAT); float* ss = (float*)(ws + WS_SS);
    unsigned long long tA_ = 0, tacc_ = 0;
    PB(0); p0_prologue(P, lds);
    if (P.ws == nullptr) grid.sync();
    xcd_barrier(bar); PE(0);
    PB(1);
    { EpiIn2 E{(bf16_t*)(ws + WS_Z), (bf16_t*)(ws + WS_XBC2), lat, (float*)(ws + WS_DT), ss + 2 * T, ss + 3 * T, (const float*)(ws + WS_TAB), P.conv_w, P.conv_b, (float*)(ws + WS_HALO2), (LAS float*)(lds + XCH_OFF), P.dt_bias_f, P.dt_bias_b};
      run_gemm(lds, (const bf16_t*)(ws + WS_H), DM, (const bf16_t*)(ws + WS_WIN), T, DINP, DM, E); }
    xcd_barrier(bar); PE(1);
    PB(2); p2_fixup(P);
    xcd_barrier(bar); PE(2);
    PB(3); p3_s1_states(P, lds);
    xcd_barrier(bar); PE(3);
    PB(4); p3_s2_scan(P);
    xcd_barrier(bar); PE(4);
    PB(5); p3_s3_output(P, lds, tacc_);
    xcd_barrier(bar); PE(5);
    PB(6);
    { EpiPlain E{(bf16_t*)P.out, NQ, QSCALE, ss + 2 * T, 1.f / 384.f};
      run_gemm(lds, lat, NLAT, (const bf16_t*)(ws + WS_WQB), T, NQ, 384, E); }
    __syncthreads();
    { EpiPlain E{(bf16_t*)(ws + WS_KV), NKV, 1.0f, ss + 3 * T, 1.f / 256.f};
      run_gemm(lds, lat + 384, NLAT, (const bf16_t*)(ws + WS_WKVB), T, NKV, 256, E); }
    xcd_barrier(bar); PE(6);
    PB(7); p5_attention(P, lds);
    xcd_barrier(bar); PE(7);
    PB(8);
    { EpiRes E{P.xp, P.xs, nullptr, (bf16_t*)(ws + WS_X1B), ss, 0, nullptr};
      run_gemm(lds, (const bf16_t*)(ws + WS_MIX), 2048, (const bf16_t*)(ws + WS_WOUT), T, DM, 2048, E); }
    xcd_barrier(bar); PE(8);
    PB(9);
    { EpiGU2 E{(bf16_t*)(ws + WS_ACT), ss, P.ffn_conv_w, P.ffn_conv_b, (float*)(ws + WS_HALO), (LAS float*)(lds + XCH_OFF)};
      run_gemm(lds, (const bf16_t*)(ws + WS_X1B), DM, (const bf16_t*)(ws + WS_WGU), T, NGU, DM, E); }
    xcd_barrier(bar); PE(9);
    PB(10); p_fixup(P);
    xcd_barrier(bar); PE(10);
    PB(11);
    { EpiRes E{nullptr, nullptr, P.out, nullptr, ss + T, 0, (const bf16_t*)(ws + WS_X1B)};
      run_gemm(lds, (const bf16_t*)(ws + WS_ACT), DFF, (const bf16_t*)(ws + WS_WDN), T, DM, DFF, E); }
    xcd_barrier(bar); PE(11);
    PB(12); p_final(P); PE(12);
    if (PROBE_MASK && blockIdx.x == 0) { const unsigned long long t0_ = __builtin_amdgcn_s_memrealtime(); while (__builtin_amdgcn_s_memrealtime() - t0_ < (unsigned long long)PROBE_K * tacc_) __builtin_amdgcn_s_sleep(8); }
}

extern "C" void kernel_launch(void* const* d_in, const int* in_sizes, int n_in, void* d_out, int out_size, void* d_ws, size_t ws_size, hipStream_t stream) {
    static int grid = 0;
    if (grid == 0) {
        int dev = 0, cus = 0, per_cu = 0;
        hipGetDevice(&dev); hipDeviceGetAttribute(&cus, hipDeviceAttributeMultiprocessorCount, dev);
        hipFuncSetAttribute((const void*)mega, hipFuncAttributeMaxDynamicSharedMemorySize, LDS_BYTES);
        if (hipOccupancyMaxActiveBlocksPerMultiprocessor(&per_cu, (const void*)mega, 512, LDS_BYTES) != hipSuccess || per_cu < 1) per_cu = 1;
        (void)hipGetLastError();
        grid = cus * per_cu;
        if (ws_size < 1020 * MiB) fprintf(stderr, "kernel_launch: workspace too small: %zu\n", ws_size);
    }
    (void)hipMemsetAsync((char*)d_ws + WS_BAR, 0, 16384, stream);
    Params p{};
    const float** pf = (const float**)&p;
    for (int i = 0; i < 24; ++i) pf[i] = (const float*)d_in[i];
    p.out = (float*)d_out; p.ws = (uchar*)d_ws;
    void* args[] = {&p};
    hipError_t e = hipLaunchCooperativeKernel((const void*)mega, dim3(grid), dim3(512), args, LDS_BYTES, stream);
    if (e != hipSuccess) fprintf(stderr, "cooperative launch failed: %s (grid %d)\n", hipGetErrorString(e), grid);
}
```

```cpp
#include <hip/hip_runtime.h>
#include <hip/hip_cooperative_groups.h>
#include <cstdio>
#include <cstdint>
namespace cg = cooperative_groups;
namespace pg8 {
#define PG8_LAS __attribute__((address_space(3)))
typedef unsigned short bf16_t;
typedef short bf16x8 __attribute__((ext_vector_type(8)));
typedef float f32x4 __attribute__((ext_vector_type(4)));
typedef unsigned u32x4 __attribute__((ext_vector_type(4)));
constexpr int BM = 256, BK = 64, HALF = 128, HTB = HALF * BK * 2  , STAGE_BYTES = 8 * HTB, NXCD = 8, WGM = 8;
__host__ __device__ __forceinline__ int lds_byte(int r, int c) { const int st = (r >> 4) * 2 + (c >> 5), rr = r & 15, cc = c & 31, ob = rr * 64 + cc * 2; return st * 1024 + (ob ^ (((ob >> 9) & 1) << 5)); }
__host__ __device__ __forceinline__ void stage_rc(int b, int& R, int& C) { const int st = b / 1024, sb = b % 1024, swz = sb ^ (((sb >> 9) & 1) << 5); R = (st >> 1) * 16 + swz / 64; C = (st & 1) * 32 + (swz % 64) / 2; }
__host__ __device__ __forceinline__ int perm32(int rho) { const int n = rho >> 4, i = rho & 15; return 8 * (i >> 2) + 4 * n + (i & 3); }
struct Unit { int pm, pn; };
struct Gemm { const bf16_t* A; const bf16_t* Bt; int M, N, K, lda; };
struct StaticOrder {
    int nM, nN, nwg, G, c;
    __host__ __device__ void init(int M, int N, int G_, int c_) { nM = M / BM; nN = N / BM; nwg = nM * nN; G = G_; c = c_; }
    __host__ __device__ bool next(int i, Unit& u) const {
        const long L = (long)i * G + c; if (L >= nwg) return false;
        int wgid = (int)L; { const int q = nwg / NXCD, r = nwg % NXCD, xcd = wgid % NXCD, off = wgid / NXCD; wgid = (xcd < r ? xcd * (q + 1) : r * (q + 1) + (xcd - r) * q) + off; }
        const int nig = WGM * nN, gid = wgid / nig, fm = gid * WGM, gsz = (nM - fm) < WGM ? (nM - fm) : WGM;
        u.pm = fm + ((wgid % nig) % gsz); u.pn = (wgid % nig) / gsz; return true;
    }
    __device__ __forceinline__ void a_ready(const Unit&) const {}
    __device__ __forceinline__ void done(const Unit&) const {}
};
template <class Epi, class Sched, bool ALIGN_EPI = false, bool SP2 = false>
__device__ __forceinline__ void gemm_phase(PG8_LAS unsigned char* lds, const Gemm g, const Sched& S, const Epi& E) {
    int tid_ = threadIdx.x; asm volatile("" : "+v"(tid_)); const int tid = tid_, wid = __builtin_amdgcn_readfirstlane(tid >> 6), lane = tid & 63, wr = wid >> 2, wc = wid & 3, fr = lane & 15, fq = lane >> 4;
    const int K = g.K, nt = K / BK;
    unsigned voffA[2], voffB[2];
#pragma unroll
    for (int i = 0; i < 2; ++i) { int R, C; stage_rc(tid * 16 + i * 8192, R, C); const int Rb = Epi::PERM ? ((R & ~31) + perm32(R & 31)) : R;
        voffA[i] = (unsigned)(R * g.lda + C) * 2u; voffB[i] = (unsigned)(Rb * K + C) * 2u; }
    const size_t kstep = (size_t)(BK * 2);
    const size_t hstepB = (size_t)HALF * K * 2, hstepA = (size_t)HALF * g.lda * 2;
    const size_t tstepA = 2 * hstepA, tstepB = 2 * hstepB;
    const unsigned ldsw = (unsigned)wid * 1024u;
    const int aoff = lds_byte(wr * 64 + fr, fq * 8), boff = lds_byte(wc * 32 + fr, fq * 8);
#define PG8_SA(b, h) (((b) * 2 + (h)) * HTB)
#define PG8_SB(b, h) ((4 + (b) * 2 + (h)) * HTB)
#define PG8_STAGE(bufoff, gbase, voff) do { _Pragma("unroll") for (int _i = 0; _i < 2; ++_i) \
        __builtin_amdgcn_global_load_lds((const unsigned*)((const char*)(gbase) + (voff)[_i]), (PG8_LAS unsigned*)(lds + (bufoff) + ldsw + _i * 8192), 16, 0, 0); } while (0)
#define PG8_LDA(dst, b, h) do { _Pragma("unroll") for (int m = 0; m < 4; ++m) _Pragma("unroll") for (int k = 0; k < 2; ++k) dst[m][k] = *(const PG8_LAS bf16x8*)(lds + PG8_SA(b, h) + aoff + m * 2048 + k * 1024); } while (0)
#define PG8_LDB(dst, b, h) do { _Pragma("unroll") for (int n = 0; n < 2; ++n) _Pragma("unroll") for (int k = 0; k < 2; ++k) dst[n][k] = *(const PG8_LAS bf16x8*)(lds + PG8_SB(b, h) + boff + n * 2048 + k * 1024); } while (0)
#define PG8_MMA(ai, bj, At, Bt) do { __builtin_amdgcn_s_setprio(1); _Pragma("unroll") for (int m = 0; m < 4; ++m) _Pragma("unroll") for (int n = 0; n < 2; ++n) _Pragma("unroll") for (int k = 0; k < 2; ++k) \
        acc[ai][bj][m][n] = __builtin_amdgcn_mfma_f32_16x16x32_bf16(Bt[n][k], At[m][k], acc[ai][bj][m][n], 0, 0, 0); __builtin_amdgcn_s_setprio(0); } while (0)
#define PG8_WAIT_V(n) asm volatile("s_waitcnt vmcnt(" #n ")" ::: "memory")
#define PG8_WAIT_L(n) asm volatile("s_waitcnt lgkmcnt(" #n ")" ::: "memory")
#define PG8_BAR __builtin_amdgcn_s_barrier()
#define PG8_SCHED __builtin_amdgcn_sched_barrier(0)
    Unit cur, nxt; int ui = 0;
    if (!S.next(0, cur)) return;
    f32x4 acc[2][2][4][2];
#pragma unroll
    for (int a = 0; a < 2; ++a)
#pragma unroll
        for (int b = 0; b < 2; ++b)
#pragma unroll
            for (int m = 0; m < 4; ++m)
#pragma unroll
                for (int n = 0; n < 2; ++n) acc[a][b][m][n] = (f32x4){0.f, 0.f, 0.f, 0.f};
    bf16x8 At[4][2], B0[2][2], B1[2][2];
    const char* cA = (const char*)g.A + (size_t)cur.pm * tstepA; const char* cB = (const char*)g.Bt + (size_t)cur.pn * tstepB;
    S.a_ready(cur);
    if constexpr (SP2) {
        PG8_STAGE(PG8_SB(0, 0), cB, voffB); PG8_STAGE(PG8_SB(0, 1), cB + hstepB, voffB); PG8_STAGE(PG8_SA(0, 0), cA, voffA); PG8_STAGE(PG8_SA(0, 1), cA + hstepA, voffA);
        if (wr == 1) PG8_BAR;
        PG8_WAIT_V(2); PG8_BAR;
        PG8_STAGE(PG8_SB(1, 0), cB + kstep, voffB); PG8_STAGE(PG8_SA(1, 0), cA + kstep, voffA); PG8_STAGE(PG8_SB(1, 1), cB + hstepB + kstep, voffB);
        PG8_WAIT_V(6); PG8_BAR;
    } else {
        PG8_STAGE(PG8_SB(0, 0), cB, voffB); PG8_STAGE(PG8_SA(0, 0), cA, voffA); PG8_STAGE(PG8_SB(0, 1), cB + hstepB, voffB); PG8_STAGE(PG8_SA(0, 1), cA + hstepA, voffA);
        if (wr == 1) PG8_BAR;
        PG8_WAIT_V(4); PG8_BAR;
        PG8_STAGE(PG8_SB(1, 0), cB + kstep, voffB); PG8_STAGE(PG8_SA(1, 0), cA + kstep, voffA); PG8_STAGE(PG8_SB(1, 1), cB + hstepB + kstep, voffB);
        PG8_WAIT_V(6); PG8_BAR;
    }
    for (;;) {
        const bool has_next = S.next(ui + 1, nxt);
        const char* nA = has_next ? (const char*)g.A + (size_t)nxt.pm * tstepA : cA; const char* nB = has_next ? (const char*)g.Bt + (size_t)nxt.pn * tstepB : cB;
        for (int t = 0; t < nt; t += 2) {
            const bool last = (t == nt - 2);
            const char* a1 = cA + (size_t)(t + 1) * kstep;
            const char* a2 = last ? nA : cA + (size_t)(t + 2) * kstep; const char* b2 = last ? nB : cB + (size_t)(t + 2) * kstep;
            const char* a3 = a2 + kstep; const char* b3 = b2 + kstep;
            if (last && has_next) S.a_ready(nxt);
            if constexpr (SP2) {
            PG8_LDB(B0, 0, 0); PG8_LDB(B1, 0, 1); PG8_SCHED; PG8_LDA(At, 0, 0); PG8_STAGE(PG8_SA(1, 1), a1 + hstepA, voffA);
            PG8_WAIT_V(8); PG8_WAIT_L(0); PG8_BAR; PG8_MMA(0, 0, At, B0); PG8_MMA(0, 1, At, B1); PG8_BAR; PG8_SCHED;
            PG8_LDA(At, 0, 1); PG8_STAGE(PG8_SB(0, 0), b2, voffB); PG8_STAGE(PG8_SB(0, 1), b2 + hstepB, voffB); PG8_STAGE(PG8_SA(0, 0), a2, voffA);
            PG8_WAIT_V(8); PG8_WAIT_L(0); PG8_BAR; PG8_MMA(1, 0, At, B0); PG8_MMA(1, 1, At, B1); PG8_BAR; PG8_SCHED;
            PG8_LDB(B0, 1, 0); PG8_LDB(B1, 1, 1); PG8_SCHED; PG8_LDA(At, 1, 0); PG8_STAGE(PG8_SA(0, 1), a2 + hstepA, voffA);
            PG8_WAIT_V(8); PG8_WAIT_L(0); PG8_BAR; PG8_MMA(0, 0, At, B0); PG8_MMA(0, 1, At, B1); PG8_BAR; PG8_SCHED;
            PG8_LDA(At, 1, 1); PG8_STAGE(PG8_SB(1, 0), b3, voffB); PG8_STAGE(PG8_SB(1, 1), b3 + hstepB, voffB); PG8_STAGE(PG8_SA(1, 0), a3, voffA);
            PG8_WAIT_V(8); PG8_WAIT_L(0); PG8_BAR; PG8_MMA(1, 0, At, B0); PG8_MMA(1, 1, At, B1); PG8_BAR; PG8_SCHED;
            } else {
            PG8_LDB(B0, 0, 0); PG8_SCHED; PG8_LDA(At, 0, 0); PG8_STAGE(PG8_SA(1, 1), a1 + hstepA, voffA);
            PG8_WAIT_L(8); PG8_BAR; PG8_WAIT_L(0); PG8_MMA(0, 0, At, B0); PG8_BAR; PG8_SCHED;
            PG8_LDB(B1, 0, 1); PG8_STAGE(PG8_SB(0, 0), b2, voffB);
            PG8_BAR; PG8_WAIT_L(0); PG8_MMA(0, 1, At, B1); PG8_BAR;
            PG8_LDA(At, 0, 1); PG8_STAGE(PG8_SA(0, 0), a2, voffA);
            PG8_BAR; PG8_WAIT_L(0); PG8_MMA(1, 0, At, B0); PG8_BAR; PG8_SCHED;
            PG8_STAGE(PG8_SB(0, 1), b2 + hstepB, voffB);
            PG8_WAIT_V(6); PG8_BAR; PG8_MMA(1, 1, At, B1); PG8_BAR;
            PG8_LDB(B0, 1, 0); PG8_SCHED; PG8_LDA(At, 1, 0); PG8_STAGE(PG8_SA(0, 1), a2 + hstepA, voffA);
            PG8_WAIT_L(8); PG8_BAR; PG8_WAIT_L(0); PG8_MMA(0, 0, At, B0); PG8_BAR; PG8_SCHED;
            PG8_LDB(B1, 1, 1); PG8_STAGE(PG8_SB(1, 0), b3, voffB);
            PG8_BAR; PG8_WAIT_L(0); PG8_MMA(0, 1, At, B1); PG8_BAR;
            PG8_LDA(At, 1, 1); PG8_STAGE(PG8_SA(1, 0), a3, voffA);
            PG8_BAR; PG8_WAIT_L(0); PG8_MMA(1, 0, At, B0); PG8_BAR; PG8_SCHED;
            PG8_STAGE(PG8_SB(1, 1), b3 + hstepB, voffB);
            PG8_WAIT_V(6); PG8_BAR; PG8_MMA(1, 1, At, B1); PG8_BAR;
            }
        }
        if constexpr (ALIGN_EPI) { if (wr == 0) PG8_BAR; }
        if constexpr (!Epi::AFTER_DRAIN) { E(acc, cur, wr, wc, fr, fq); S.done(cur); }
        if (!has_next) break;
#pragma unroll
        for (int a = 0; a < 2; ++a)
#pragma unroll
            for (int b = 0; b < 2; ++b)
#pragma unroll
                for (int m = 0; m < 4; ++m)
#pragma unroll
                    for (int n = 0; n < 2; ++n) acc[a][b][m][n] = (f32x4){0.f, 0.f, 0.f, 0.f};
        cur = nxt; cA = nA; cB = nB; ++ui;
        if constexpr (ALIGN_EPI) { if (wr == 1) PG8_BAR; }
    }
    PG8_WAIT_V(0);
    if constexpr (!ALIGN_EPI) { if (wr == 0) PG8_BAR; }
    PG8_BAR;
    if constexpr (Epi::AFTER_DRAIN) { E.fused(acc, cur, wr, wc, fr, fq, lds, wid, lane); S.done(cur); }
#undef PG8_SA
#undef PG8_SB
#undef PG8_STAGE
#undef PG8_LDA
#undef PG8_LDB
#undef PG8_MMA
#undef PG8_WAIT_V
#undef PG8_WAIT_L
#undef PG8_BAR
#undef PG8_SCHED
}
}

#define DI __device__ __forceinline__
#define LAS __attribute__((address_space(3)))
typedef unsigned short bf16_t;
typedef unsigned char uchar;
typedef short bf16x8 __attribute__((ext_vector_type(8)));
typedef short s16x4 __attribute__((ext_vector_type(4)));
typedef float f32x4 __attribute__((ext_vector_type(4)));
typedef float f32x16 __attribute__((ext_vector_type(16)));
typedef unsigned u32x4 __attribute__((ext_vector_type(4)));
typedef unsigned u32x2 __attribute__((ext_vector_type(2)));
typedef float f32x2_t __attribute__((ext_vector_type(2)));
typedef __bf16 bf16x2_t __attribute__((ext_vector_type(2)));

constexpr int T = 81920, TP = 65536, DM = 1024;
constexpr int LP = 2048, LS = 16384;
constexpr int DIN = 3008, DINP = 3072;
constexpr int NQ = 1536, NKV = 2048, NLAT = 768, NXBC = 1280;
constexpr int DFF = 2816, NGU = 5632;
constexpr float EPS = 1e-6f;
constexpr float QSCALE = 0.10206207261596575f * 1.4426950408889634f;
constexpr int CH0_ROWS = 49152, CH1_ROWS = 32768;

constexpr size_t MiB = 1u << 20;
constexpr size_t WS_WIN = 0, WS_WQB = 6 * MiB, WS_WKVB = 8 * MiB, WS_WOUT = 9 * MiB, WS_WGU = 13 * MiB, WS_WDN = 24 * MiB;
constexpr size_t WS_TAB = 30 * MiB;
constexpr size_t WS_H = 32 * MiB;
constexpr size_t WS_XBC = 192 * MiB;
constexpr size_t WS_MIX = 32 * MiB;
constexpr size_t WS_Z = 392 * MiB;
constexpr size_t WS_LAT = 552 * MiB;
constexpr size_t WS_DT = 672 * MiB;
constexpr size_t WS_XBC2 = 682 * MiB;
constexpr size_t WS_KV = 682 * MiB;
constexpr size_t WS_X1B = 352 * MiB;
constexpr size_t WS_SS = 1004 * MiB;
constexpr size_t WS_BAR = 1006 * MiB;
constexpr size_t WS_G = 32 * MiB;
constexpr size_t WS_U = 512 * MiB;
constexpr size_t WS_ACT = 512 * MiB;
constexpr size_t WS_HALO = 32 * MiB;
constexpr size_t WS_HALO2 = 890 * MiB;
constexpr int XCH_OFF = 131072;
static_assert(WS_XBC2 + (size_t)T * NXBC * 2 <= WS_SS && WS_KV + (size_t)T * NKV * 2 <= WS_SS, "ws map");
static_assert(WS_G + (size_t)CH0_ROWS * DFF * 2 <= WS_X1B && WS_X1B + (size_t)T * DM * 2 <= WS_U && WS_U + (size_t)CH0_ROWS * DFF * 2 <= WS_SS, "ws map 2");
static_assert(WS_MIX + (size_t)T * 2048 * 2 <= WS_X1B, "ws map 3");
static_assert(WS_ACT + (size_t)T * DFF * 2 <= WS_SS && WS_HALO + (size_t)3 * 320 * 2 * DFF * 4 <= WS_X1B, "ws map 4");

struct Params {
    const float *xp, *xs, *norm1, *w_in, *q_a_norm, *kv_a_norm, *w_q_b, *w_kv_b, *conv_w, *conv_b, *dt_bias_f, *dt_bias_b, *a_log_f, *a_log_b,
        *d_skip, *ssm_norm, *w_out, *norm2, *w_gate, *w_up, *ffn_conv_w, *ffn_conv_b, *w_down, *final_norm;
    float* out; uchar* ws;
};

DI int otid() { int t = threadIdx.x; asm volatile("" : "+v"(t)); return t; }
#ifndef PROBE_MASK
#define PROBE_MASK 0u
#endif
#define PROBE_K 1
#define PB(id) do { if (PROBE_MASK && blockIdx.x == 0 && ((PROBE_MASK >> (id)) & 1u)) tA_ = __builtin_amdgcn_s_memrealtime(); } while (0)
#define PE(id) do { if (PROBE_MASK && blockIdx.x == 0 && ((PROBE_MASK >> (id)) & 1u)) tacc_ += __builtin_amdgcn_s_memrealtime() - tA_; } while (0)
DI float bf2f(bf16_t v) { return __uint_as_float((unsigned)v << 16); }
DI unsigned pk2(float lo, float hi) { f32x2_t v = {lo, hi}; bf16x2_t b = __builtin_convertvector(v, bf16x2_t); return __builtin_bit_cast(unsigned, b); }
DI void unpack8(const u32x4 w, float (&f)[8]) {
#pragma unroll
    for (int i = 0; i < 4; ++i) { f[2 * i] = __uint_as_float(w[i] << 16); f[2 * i + 1] = __uint_as_float(w[i] & 0xffff0000u); }
}
DI u32x4 pack8(const float (&f)[8]) { u32x4 w; w.x = pk2(f[0], f[1]); w.y = pk2(f[2], f[3]); w.z = pk2(f[4], f[5]); w.w = pk2(f[6], f[7]); return w; }
DI float wave_sum(float v) {
#pragma unroll
    for (int o = 1; o < 64; o <<= 1) v += __shfl_xor(v, o);
    return v;
}
DI const float* xrow(const Params& P, int row) { return row < TP ? P.xp + (size_t)row * DM : P.xs + (size_t)(row - TP) * DM; }
DI int posof(int row) { return row < TP ? (row & (LP - 1)) : row - TP; }
DI int lenof(int row) { return row < TP ? LP : LS; }
DI float silu(float v) { return v * __builtin_amdgcn_rcpf(1.f + __builtin_amdgcn_exp2f(v * -1.4426950408889634f)); }

#define EPI_LOOP_BEGIN \
    _Pragma("unroll") for (int ai = 0; ai < 2; ++ai) _Pragma("unroll") for (int m = 0; m < 4; ++m) { const int row = u.pm * 256 + ai * 128 + wr * 64 + m * 16 + fr; \
    _Pragma("unroll") for (int bj = 0; bj < 2; ++bj) { const f32x4 v0 = acc[ai][bj][m][0], v1 = acc[ai][bj][m][1];
#define EPI_LOOP_END } }

DI float dpp_ror1(float v) { return __builtin_bit_cast(float, __builtin_amdgcn_update_dpp(0, __builtin_bit_cast(int, v), 0x121, 0xf, 0xf, false)); }
DI float dpp_ror15(float v) { return __builtin_bit_cast(float, __builtin_amdgcn_update_dpp(0, __builtin_bit_cast(int, v), 0x12F, 0xf, 0xf, false)); }
struct EpiIn2 {
    static constexpr bool PERM = true, AFTER_DRAIN = false;
    bf16_t *z, *xbc2, *lat; float* dt; float *ssq, *ssk; const float* tab; const float* cw; const float* cb; float* halo; LAS float* xch; const float *dtbf, *dtbb;
    DI void operator()(const f32x4 (&acc)[2][2][4][2], const pg8::Unit& u, int wr, int wc, int fr, int fq) const {
        const int lane = fr + 16 * fq;
        if (u.pn < 4) {
            const int col0 = u.pn * 256 + wc * 32 + 8 * fq;
            EPI_LOOP_BEGIN
                u32x4 w; w.x = pk2(v0[0], v0[1]); w.y = pk2(v0[2], v0[3]); w.z = pk2(v1[0], v1[1]); w.w = pk2(v1[2], v1[3]);
                *(u32x4*)(z + (size_t)row * DM + col0 + bj * 128) = w;
            EPI_LOOP_END
        } else if (u.pn < 9) {
            int cl_ = wc * 32 + 8 * fq; asm volatile("" : "+v"(cl_)); const int cl = cl_;
#pragma unroll
            for (int ai = 0; ai < 2; ++ai)
#pragma unroll
                for (int bj = 0; bj < 2; ++bj) {
                    LAS float* xs = xch + (ai * 2 + wr) * 512 + bj * 128 + cl;
                    if (fr == 0) { *(LAS f32x4*)xs = acc[ai][bj][0][0]; *(LAS f32x4*)(xs + 4) = acc[ai][bj][0][1]; }
                    if (fr == 15) { *(LAS f32x4*)(xs + 256) = acc[ai][bj][3][0]; *(LAS f32x4*)(xs + 260) = acc[ai][bj][3][1]; }
                }
            asm volatile("s_waitcnt lgkmcnt(0)" ::: "memory"); __builtin_amdgcn_s_barrier(); asm volatile("" ::: "memory");
            const int ldn = (lane & 48) | ((fr + 15) & 15), lup = (lane & 48) | ((fr + 1) & 15);
            const f32x4 zero4 = {0.f, 0.f, 0.f, 0.f};
#pragma unroll
            for (int bj = 0; bj < 2; ++bj)
#pragma unroll
                for (int jh = 0; jh < 2; ++jh) {
                    const int tl = bj * 128 + cl + 4 * jh, chj = (u.pn - 4) * 256 + tl;
                    const f32x4 w0 = *(const f32x4*)(cw + chj), w1 = *(const f32x4*)(cw + NXBC + chj), w2 = *(const f32x4*)(cw + 2 * NXBC + chj), bb = *(const f32x4*)(cb + chj);
#pragma unroll
                    for (int ai = 0; ai < 2; ++ai) {
                        const int strip = ai * 2 + wr;
                        const f32x4 ep = strip > 0 ? *(const LAS f32x4*)(xch + (strip - 1) * 512 + 256 + tl) : zero4;
                        const f32x4 en = strip < 3 ? *(const LAS f32x4*)(xch + (strip + 1) * 512 + tl) : zero4;
                        f32x4 dnp = ep, upc, upn;
#pragma unroll
                        for (int k = 0; k < 4; ++k) upc[k] = dpp_ror15(acc[ai][bj][0][jh][k]);
#pragma unroll
                        for (int m = 0; m < 4; ++m) {
                            const int row = u.pm * 256 + ai * 128 + wr * 64 + m * 16 + fr;
                            f32x4 dnc;
#pragma unroll
                            for (int k = 0; k < 4; ++k) { dnc[k] = dpp_ror1(acc[ai][bj][m][jh][k]); upn[k] = m < 3 ? dpp_ror15(acc[ai][bj][m < 3 ? m + 1 : 3][jh][k]) : en[k]; }
                            const f32x4 prev = fr == 0 ? dnp : dnc;
                            const f32x4 next = fr == 15 ? upn : upc;
                            dnp = dnc;
                            const f32x4 part = w0 * prev + w1 * acc[ai][bj][m][jh] + w2 * next + bb;
                            u32x2 o; o.x = pk2(silu(part[0]), silu(part[1])); o.y = pk2(silu(part[2]), silu(part[3]));
                            *(u32x2*)(xbc2 + (size_t)row * NXBC + chj) = o;
                            const bool first = (strip == 0 && m == 0 && fr == 0), last = (strip == 3 && m == 3 && fr == 15);
                            if (first || last) { const size_t ho = ((size_t)u.pm * 2 + (last ? 1 : 0)) * NXBC + chj; *(f32x4*)(halo + ho) = part; *(f32x4*)(halo + (size_t)320 * 2 * NXBC + ho) = acc[ai][bj][m][jh]; }
                            upc = upn;
                        }
                    }
                }
            asm volatile("s_waitcnt lgkmcnt(0)" ::: "memory"); __builtin_amdgcn_s_barrier(); asm volatile("" ::: "memory");
        } else {
            const int colt = (u.pn - 9) * 256, col0 = colt + wc * 32 + 8 * fq;
#pragma unroll
            for (int ai = 0; ai < 2; ++ai)
#pragma unroll
                for (int m = 0; m < 4; ++m) {
                    const int row = u.pm * 256 + ai * 128 + wr * 64 + m * 16 + fr;
#pragma unroll
                    for (int bj = 0; bj < 2; ++bj) {
                        const f32x4 v0 = acc[ai][bj][m][0], v1 = acc[ai][bj][m][1];
                        const int c = col0 + bj * 128;
                        if (c < 640) {
                            u32x4 w; w.x = pk2(v0[0], v0[1]); w.y = pk2(v0[2], v0[3]); w.z = pk2(v1[0], v1[1]); w.w = pk2(v1[2], v1[3]);
                            *(u32x4*)(lat + (size_t)row * NLAT + c) = w;
                            float sq = (v0[0] * v0[0] + v0[1] * v0[1]) + (v0[2] * v0[2] + v0[3] * v0[3]) + (v1[0] * v1[0] + v1[1] * v1[1]) + (v1[2] * v1[2] + v1[3] * v1[3]);
                            sq += __shfl_xor(sq, 16); sq += __shfl_xor(sq, 32);
                            if (fq == 0) atomicAdd((c < 384 ? ssq : ssk) + row, sq);
                        } else if (c < 672) {
                            const float* tp = tab + ((size_t)posof(row) * 16 + 4 * fq) * 2;
                            const f32x4 c0 = *(const f32x4*)tp, c1 = *(const f32x4*)(tp + 4);
                            u32x4 w;
                            w.x = pk2(v0[0] * c0[0] - v0[1] * c0[1], v0[1] * c0[0] + v0[0] * c0[1]); w.y = pk2(v0[2] * c0[2] - v0[3] * c0[3], v0[3] * c0[2] + v0[2] * c0[3]);
                            w.z = pk2(v1[0] * c1[0] - v1[1] * c1[1], v1[1] * c1[0] + v1[0] * c1[1]); w.w = pk2(v1[2] * c1[2] - v1[3] * c1[3], v1[3] * c1[2] + v1[2] * c1[3]);
                            *(u32x4*)(lat + (size_t)row * NLAT + c) = w;
                        } else if (c < 704) {
                            const float* bp = (fq < 2 ? dtbf + 8 * fq : dtbb + 8 * (fq - 2));
                            const f32x4 b0 = *(const f32x4*)bp, b1 = *(const f32x4*)(bp + 4);
                            f32x4 o0, o1;
#pragma unroll
                            for (int k = 0; k < 4; ++k) { const float a = v0[k] + b0[k], b = v1[k] + b1[k]; o0[k] = fmaxf(a, 0.f) + __logf(1.f + __expf(-fabsf(a))); o1[k] = fmaxf(b, 0.f) + __logf(1.f + __expf(-fabsf(b))); }
                            float* d = dt + (size_t)row * 32 + 8 * fq; *(f32x4*)d = o0; *(f32x4*)(d + 4) = o1;
                        }
                    }
                }
        }
    }
};
struct EpiIn {
    static constexpr bool PERM = true, AFTER_DRAIN = false;
    bf16_t *z, *xbc, *lat; float* dt;
    DI void operator()(const f32x4 (&acc)[2][2][4][2], const pg8::Unit& u, int wr, int wc, int fr, int fq) const {
        bf16_t* base; int ld, colt;
        if (u.pn < 4) { base = z; ld = DM; colt = u.pn * 256; } else if (u.pn < 9) { base = xbc; ld = NXBC; colt = (u.pn - 4) * 256; } else { base = lat; ld = NLAT; colt = (u.pn - 9) * 256; }
        const int col0 = colt + wc * 32 + 8 * fq;
        EPI_LOOP_BEGIN
            u32x4 w; w.x = pk2(v0[0], v0[1]); w.y = pk2(v0[2], v0[3]); w.z = pk2(v1[0], v1[1]); w.w = pk2(v1[2], v1[3]);
            *(u32x4*)(base + (size_t)row * ld + col0 + bj * 128) = w;
            if (u.pn == 11 && bj == 1 && wc == 1) { float* d = dt + (size_t)row * 32 + 8 * fq; *(f32x4*)d = v0; *(f32x4*)(d + 4) = v1; }
        EPI_LOOP_END
    }
};
struct EpiPlain {
    static constexpr bool PERM = true, AFTER_DRAIN = false;
    bf16_t* o; int ld; float sc0; const float* ssr; float invn;
    DI void operator()(const f32x4 (&acc)[2][2][4][2], const pg8::Unit& u, int wr, int wc, int fr, int fq) const {
        const int col0 = u.pn * 256 + wc * 32 + 8 * fq;
        EPI_LOOP_BEGIN
            const float sc = sc0 * rsqrtf(ssr[row] * invn + EPS);
            u32x4 w; w.x = pk2(v0[0] * sc, v0[1] * sc); w.y = pk2(v0[2] * sc, v0[3] * sc); w.z = pk2(v1[0] * sc, v1[1] * sc); w.w = pk2(v1[2] * sc, v1[3] * sc);
            *(u32x4*)(o + (size_t)row * ld + col0 + bj * 128) = w;
        EPI_LOOP_END
    }
};
struct EpiRes {
    static constexpr bool PERM = true, AFTER_DRAIN = false;
    const float* resp; const float* ress; float* xo; bf16_t* xb; float* ss; int row_off; const bf16_t* resb;
    DI void operator()(const f32x4 (&acc)[2][2][4][2], const pg8::Unit& u, int wr, int wc, int fr, int fq) const {
        const int col0 = u.pn * 256 + wc * 32 + 8 * fq;
#pragma unroll
        for (int ai = 0; ai < 2; ++ai)
#pragma unroll
            for (int m = 0; m < 4; ++m) {
                const int row = row_off + u.pm * 256 + ai * 128 + wr * 64 + m * 16 + fr;
                const float* rp = (row < TP ? resp + (size_t)row * DM : ress + (size_t)(row - TP) * DM) + col0;
                float s = 0.f;
#pragma unroll
                for (int bj = 0; bj < 2; ++bj) {
                    f32x4 r0, r1;
                    if (resb) { float rf[8]; unpack8(*(const u32x4*)(resb + (size_t)row * DM + col0 + bj * 128), rf); r0 = (f32x4){rf[0], rf[1], rf[2], rf[3]}; r1 = (f32x4){rf[4], rf[5], rf[6], rf[7]}; }
                    else { r0 = *(const f32x4*)(rp + bj * 128); r1 = *(const f32x4*)(rp + bj * 128 + 4); }
                    const f32x4 a = acc[ai][bj][m][0] + r0, b = acc[ai][bj][m][1] + r1;
                    if (xo) { float* op = xo + (size_t)row * DM + col0 + bj * 128; *(f32x4*)op = a; *(f32x4*)(op + 4) = b; }
                    if (xb) { u32x4 w; w.x = pk2(a[0], a[1]); w.y = pk2(a[2], a[3]); w.z = pk2(b[0], b[1]); w.w = pk2(b[2], b[3]); *(u32x4*)(xb + (size_t)row * DM + col0 + bj * 128) = w; }
                    s += (a[0] * a[0] + a[1] * a[1]) + (a[2] * a[2] + a[3] * a[3]) + (b[0] * b[0] + b[1] * b[1]) + (b[2] * b[2] + b[3] * b[3]);
                }
                s += __shfl_xor(s, 16); s += __shfl_xor(s, 32);
                if (fq == 0) atomicAdd(ss + row, s);
            }
    }
};
struct EpiGU2 {
    static constexpr bool PERM = true, AFTER_DRAIN = false;
    bf16_t* act; const float* ss; const float* cw; const float* cb; float* halo; LAS float* xch0; mutable int par;
    DI void operator()(const f32x4 (&acc)[2][2][4][2], const pg8::Unit& u, int wr, int wc, int fr, int fq) const {
        const int lane = fr + 16 * fq;
        LAS float* xch = xch0 + par * 1536; par ^= 1;
        int cl_ = wc * 32 + 8 * fq; asm volatile("" : "+v"(cl_)); const int cl = cl_, ch0 = u.pn * 128 + cl;
        float rs[2][4];
#pragma unroll
        for (int ai = 0; ai < 2; ++ai)
#pragma unroll
            for (int m = 0; m < 4; ++m) rs[ai][m] = rsqrtf(ss[u.pm * 256 + ai * 128 + wr * 64 + m * 16 + fr] * (1.f / DM) + EPS);
        LAS float* wtab = xch + 1024;
        { const int tid_ = (wr * 4 + wc) * 64 + lane;
          if (tid_ < 128) { const int ch = u.pn * 128 + tid_; wtab[tid_] = cw[ch]; wtab[128 + tid_] = cw[DFF + ch]; wtab[256 + tid_] = cw[2 * DFF + ch]; wtab[384 + tid_] = cb[ch]; } }
#pragma unroll
        for (int ai = 0; ai < 2; ++ai) {
            LAS float* xs = xch + (ai * 2 + wr) * 256 + cl;
            if (fr == 0) { *(LAS f32x4*)xs = acc[ai][0][0][0] * rs[ai][0]; *(LAS f32x4*)(xs + 4) = acc[ai][0][0][1] * rs[ai][0]; }
            if (fr == 15) { *(LAS f32x4*)(xs + 128) = acc[ai][0][3][0] * rs[ai][3]; *(LAS f32x4*)(xs + 132) = acc[ai][0][3][1] * rs[ai][3]; }
        }
        asm volatile("s_waitcnt lgkmcnt(0)" ::: "memory"); __builtin_amdgcn_s_barrier(); asm volatile("" ::: "memory");
        const f32x4 zero4 = {0.f, 0.f, 0.f, 0.f};
#pragma unroll
        for (int ai = 0; ai < 2; ++ai) {
            const int strip = ai * 2 + wr;
            f32x4 gc[2], dnp[2], upc[2];
#pragma unroll
            for (int jh = 0; jh < 2; ++jh) {
                gc[jh] = acc[ai][0][0][jh] * rs[ai][0];
                dnp[jh] = strip > 0 ? *(const LAS f32x4*)(xch + (strip - 1) * 256 + 128 + cl + 4 * jh) : zero4;
#pragma unroll
                for (int k = 0; k < 4; ++k) upc[jh][k] = dpp_ror15(gc[jh][k]);
            }
#pragma unroll
            for (int m = 0; m < 4; ++m) {
                const int row = u.pm * 256 + ai * 128 + wr * 64 + m * 16 + fr;
                const bool first = (strip == 0 && m == 0 && fr == 0), last = (strip == 3 && m == 3 && fr == 15);
                u32x2 ob[2];
#pragma unroll
                for (int jh = 0; jh < 2; ++jh) {
                    const LAS float* wp = wtab + cl + 4 * jh;
                    const f32x4 w0 = *(const LAS f32x4*)wp, w1 = *(const LAS f32x4*)(wp + 128), w2 = *(const LAS f32x4*)(wp + 256), bb = *(const LAS f32x4*)(wp + 384);
                    f32x4 dnc, upn, gn = gc[jh];
                    if (m < 3) gn = acc[ai][0][m < 3 ? m + 1 : 3][jh] * rs[ai][m < 3 ? m + 1 : 3];
                    const f32x4 en = (m == 3 && strip < 3) ? *(const LAS f32x4*)(xch + (strip + 1) * 256 + cl + 4 * jh) : zero4;
#pragma unroll
                    for (int k = 0; k < 4; ++k) { dnc[k] = dpp_ror1(gc[jh][k]); upn[k] = m < 3 ? dpp_ror15(gn[k]) : en[k]; }
                    const f32x4 prev = fr == 0 ? dnp[jh] : dnc;
                    const f32x4 next = fr == 15 ? upn : upc[jh];
                    const f32x4 part = w0 * prev + w1 * gc[jh] + w2 * next + bb;
                    const f32x4 uq = acc[ai][1][m][jh] * rs[ai][m];
                    ob[jh].x = pk2(silu(part[0]) * uq[0], silu(part[1]) * uq[1]); ob[jh].y = pk2(silu(part[2]) * uq[2], silu(part[3]) * uq[3]);
                    if (first || last) {
                        const size_t ho = ((size_t)u.pm * 2 + (last ? 1 : 0)) * DFF + ch0 + 4 * jh; const size_t hs = (size_t)320 * 2 * DFF;
                        *(f32x4*)(halo + ho) = part; *(f32x4*)(halo + hs + ho) = uq; *(f32x4*)(halo + 2 * hs + ho) = gc[jh];
                    }
                    dnp[jh] = dnc; upc[jh] = upn; gc[jh] = gn;
                }
                *(u32x4*)(act + (size_t)row * DFF + ch0) = (u32x4){ob[0].x, ob[0].y, ob[1].x, ob[1].y};
            }
        }
    }
};
struct EpiGU {
    static constexpr bool PERM = true, AFTER_DRAIN = false;
    bf16_t *g, *uo; const float* ss; int row_off;
    DI void operator()(const f32x4 (&acc)[2][2][4][2], const pg8::Unit& u, int wr, int wc, int fr, int fq) const {
        const int col0 = u.pn * 128 + wc * 32 + 8 * fq;
#pragma unroll
        for (int ai = 0; ai < 2; ++ai)
#pragma unroll
            for (int m = 0; m < 4; ++m) {
                const int lrow = u.pm * 256 + ai * 128 + wr * 64 + m * 16 + fr;
                const float rs = rsqrtf(ss[row_off + lrow] * (1.f / DM) + EPS);
#pragma unroll
                for (int bj = 0; bj < 2; ++bj) {
                    const f32x4 a = acc[ai][bj][m][0] * rs, b = acc[ai][bj][m][1] * rs;
                    u32x4 w; w.x = pk2(a[0], a[1]); w.y = pk2(a[2], a[3]); w.z = pk2(b[0], b[1]); w.w = pk2(b[2], b[3]);
                    *(u32x4*)((bj == 0 ? g : uo) + (size_t)lrow * DFF + col0) = w;
                }
            }
    }
};

template <class F> DI void transpose_item(const float* W, int K, int N, bf16_t* WT, LAS float* scr, int item, int lane, F destrow, const float* kscale) {
    const int nblk = N / 32, kb = item / nblk, nb = item % nblk, k0 = 64 * kb, n0 = 32 * nb;
    { f32x4 wv[8];
#pragma unroll
      for (int i = 0; i < 8; ++i) { const int kk = 8 * i + (lane >> 3); wv[i] = *(const f32x4*)(W + (size_t)(k0 + kk) * N + n0 + (lane & 7) * 4); }
#pragma unroll
      for (int i = 0; i < 8; ++i) { const int kk = 8 * i + (lane >> 3); const float ks = kscale ? kscale[k0 + kk] : 1.f; LAS float* d = scr + kk * 33 + (lane & 7) * 4; d[0] = wv[i][0] * ks; d[1] = wv[i][1] * ks; d[2] = wv[i][2] * ks; d[3] = wv[i][3] * ks; } }
    asm volatile("s_waitcnt lgkmcnt(0)" ::: "memory");
    const int c = lane & 7;
#pragma unroll
    for (int j = 0; j < 4; ++j) { const int n = (lane >> 3) + 8 * j; const LAS float* s = scr + (8 * c) * 33 + n;
        u32x4 o; o.x = pk2(s[0 * 33], s[1 * 33]); o.y = pk2(s[2 * 33], s[3 * 33]); o.z = pk2(s[4 * 33], s[5 * 33]); o.w = pk2(s[6 * 33], s[7 * 33]);
        *(u32x4*)(WT + (size_t)destrow(n0 + n) * K + k0 + 8 * c) = o; }
    asm volatile("s_waitcnt lgkmcnt(0)" ::: "memory");
}
struct DestIn { DI int operator()(int c) const { if (c >= 640 && c < 672) { const int i = c - 640; return 2304 + 640 + (i < 16 ? 2 * i : 2 * (i - 16) + 1); } return c < 672 ? 2304 + c : (c < 1696 ? c - 672 : (c < 2976 ? 1024 + (c - 1696) : 2304 + 672 + (c - 2976))); } };
struct DestQb { DI int operator()(int c) const { const int h = c / 96, j = c % 96; if (j < 64) return h * 64 + j; const int i = j - 64; return 1024 + h * 32 + (i < 16 ? 2 * i : 2 * (i - 16) + 1); } };
struct DestKvb { DI int operator()(int c) const { const int h = c >> 7, j = c & 127; return j < 64 ? h * 64 + j : 1024 + h * 64 + (j - 64); } };
struct DestId { DI int operator()(int c) const { return c; } };
struct DestGate { DI int operator()(int c) const { return 256 * (c >> 7) + (c & 127); } };
struct DestUp { DI int operator()(int c) const { return 256 * (c >> 7) + 128 + (c & 127); } };

DI void p0_prologue(const Params& P, LAS uchar* lds) {
    const int tid = otid(), lane = tid & 63, wave = tid >> 6, G = gridDim.x;
    const int gw = blockIdx.x * 8 + wave, NGW = G * 8;
    const int gt = blockIdx.x * 512 + tid, NGT = G * 512;
    LAS float* scr = (LAS float*)(lds + wave * 16384);
    bf16_t* Win = (bf16_t*)(P.ws + WS_WIN); bf16_t* Wqb = (bf16_t*)(P.ws + WS_WQB); bf16_t* Wkvb = (bf16_t*)(P.ws + WS_WKVB);
    bf16_t* Wout = (bf16_t*)(P.ws + WS_WOUT); bf16_t* Wgu = (bf16_t*)(P.ws + WS_WGU); bf16_t* Wdn = (bf16_t*)(P.ws + WS_WDN);
    constexpr int I_IN = 16 * 94, I_QB = 6 * 48, I_KVB = 4 * 64, I_OUT = 32 * 32, I_G = 16 * 88, I_DN = 44 * 32;
    constexpr int NITEMS = I_IN + I_QB + I_KVB + I_OUT + 2 * I_G + I_DN;
    for (int it = gw; it < NITEMS; it += NGW) {
        int r = it;
        if (r < I_IN) { transpose_item(P.w_in, 1024, DIN, Win, scr, r, lane, DestIn(), nullptr); continue; } r -= I_IN;
        if (r < I_QB) { transpose_item(P.w_q_b, 384, NQ, Wqb, scr, r, lane, DestQb(), P.q_a_norm); continue; } r -= I_QB;
        if (r < I_KVB) { transpose_item(P.w_kv_b, 256, NKV, Wkvb, scr, r, lane, DestKvb(), P.kv_a_norm); continue; } r -= I_KVB;
        if (r < I_OUT) { transpose_item(P.w_out, 2048, DM, Wout, scr, r, lane, DestId(), nullptr); continue; } r -= I_OUT;
        if (r < I_G) { transpose_item(P.w_gate, 1024, DFF, Wgu, scr, r, lane, DestGate(), P.norm2); continue; } r -= I_G;
        if (r < I_G) { transpose_item(P.w_up, 1024, DFF, Wgu, scr, r, lane, DestUp(), P.norm2); continue; } r -= I_G;
        transpose_item(P.w_down, DFF, DM, Wdn, scr, r, lane, DestId(), nullptr);
    }
    for (int i = gt; i < 64 * 1024 / 8; i += NGT) *(u32x4*)(Win + (size_t)3008 * 1024 + (size_t)i * 8) = (u32x4){0u, 0u, 0u, 0u};
    float* tab = (float*)(P.ws + WS_TAB);
    for (int i = gt; i < LS * 16; i += NGT) { const int pos = i >> 4, k = i & 15; const float inv = powf(10000.0f, -(float)(2 * k) / 32.0f); const float ang = (float)pos * inv; float s, c; sincosf(ang, &s, &c); tab[2 * i] = c; tab[2 * i + 1] = s; }
    float* ss = (float*)(P.ws + WS_SS);
    for (int i = gt; i < 4 * T; i += NGT) ss[i] = 0.f;
    bf16_t* hb = (bf16_t*)(P.ws + WS_H);
    for (int row = gw; row < T; row += NGW) {
        const f32x4* xr = (const f32x4*)xrow(P, row) + lane;
        f32x4 v[4]; float s = 0.f;
#pragma unroll
        for (int j = 0; j < 4; ++j) { v[j] = __builtin_nontemporal_load(xr + 64 * j); s += (v[j][0] * v[j][0] + v[j][1] * v[j][1]) + (v[j][2] * v[j][2] + v[j][3] * v[j][3]); }
        const float rs = rsqrtf(wave_sum(s) * (1.f / DM) + EPS);
        u32x2* o = (u32x2*)(hb + (size_t)row * DM) + lane;
#pragma unroll
        for (int j = 0; j < 4; ++j) { const f32x4 w = ((const f32x4*)P.norm1)[lane + 64 * j]; u32x2 pk; pk.x = pk2(v[j][0] * rs * w[0], v[j][1] * rs * w[1]); pk.y = pk2(v[j][2] * rs * w[2], v[j][3] * rs * w[3]); o[64 * j] = pk; }
    }
}

DI float gsum16(float v) { v += __shfl_xor(v, 1); v += __shfl_xor(v, 2); v += __shfl_xor(v, 4); v += __shfl_xor(v, 8); return v; }
template <bool ACT> DI void conv8_item(const bf16_t* src, bf16_t* dst, int ld, int lrow0, int grow0, int c0, const float* cw, const float* cb) {
    float w0[8], w1[8], w2[8], bb[8];
    { const f32x4 a0 = *(const f32x4*)(cw + c0), a1 = *(const f32x4*)(cw + c0 + 4), b0 = *(const f32x4*)(cw + ld + c0), b1 = *(const f32x4*)(cw + ld + c0 + 4);
      const f32x4 c0v = *(const f32x4*)(cw + 2 * ld + c0), c1v = *(const f32x4*)(cw + 2 * ld + c0 + 4), d0 = *(const f32x4*)(cb + c0), d1 = *(const f32x4*)(cb + c0 + 4);
#pragma unroll
      for (int j = 0; j < 4; ++j) { w0[j] = a0[j]; w0[4 + j] = a1[j]; w1[j] = b0[j]; w1[4 + j] = b1[j]; w2[j] = c0v[j]; w2[4 + j] = c1v[j]; bb[j] = d0[j]; bb[4 + j] = d1[j]; } }
    const int pos0 = posof(grow0), L = lenof(grow0);
    u32x4 raw[10], ur[8];
    const u32x4 zero4 = {0u, 0u, 0u, 0u};
    raw[0] = pos0 > 0 ? *(const u32x4*)(src + (size_t)(lrow0 - 1) * ld + c0) : zero4;
#pragma unroll
    for (int i = 0; i < 8; ++i) raw[1 + i] = *(const u32x4*)(src + (size_t)(lrow0 + i) * ld + c0);
    raw[9] = pos0 + 8 < L ? *(const u32x4*)(src + (size_t)(lrow0 + 8) * ld + c0) : zero4;
    if (ACT) {
#pragma unroll
        for (int i = 0; i < 8; ++i) ur[i] = *(const u32x4*)(dst + (size_t)(lrow0 + i) * ld + c0);
    }
    float prv[8], cur[8], nxt[8];
    unpack8(raw[0], prv); unpack8(raw[1], cur);
#pragma unroll
    for (int i = 0; i < 8; ++i) {
        unpack8(raw[2 + i], nxt);
        float o[8];
#pragma unroll
        for (int j = 0; j < 8; ++j) o[j] = silu(w0[j] * prv[j] + w1[j] * cur[j] + w2[j] * nxt[j] + bb[j]);
        if (ACT) { float uu[8]; unpack8(ur[i], uu);
#pragma unroll
            for (int j = 0; j < 8; ++j) o[j] *= uu[j]; }
        *(u32x4*)(dst + (size_t)(lrow0 + i) * ld + c0) = pack8(o);
#pragma unroll
        for (int j = 0; j < 8; ++j) { prv[j] = cur[j]; cur[j] = nxt[j]; }
    }
}
DI void p2_prep(const Params& P) {
    const int tid = otid(), lane = tid & 63, wave = tid >> 6, G = gridDim.x;
    const int gw = blockIdx.x * 8 + wave, NGW = G * 8;
    const int gt = blockIdx.x * 512 + tid, NGT = G * 512;
    bf16_t* lat = (bf16_t*)(P.ws + WS_LAT); float* dt = (float*)(P.ws + WS_DT); const float* tab = (const float*)(P.ws + WS_TAB);
    const int gl = lane >> 4, li = lane & 15;
    for (int row = gw * 4 + gl; row < T; row += NGW * 4) {
        bf16_t* lr = lat + (size_t)row * NLAT;
        u32x4 qr[3], kr[2];
#pragma unroll
        for (int j = 0; j < 3; ++j) qr[j] = *(const u32x4*)(lr + (li + 16 * j) * 8);
#pragma unroll
        for (int j = 0; j < 2; ++j) kr[j] = *(const u32x4*)(lr + 384 + (li + 16 * j) * 8);
        const float x1 = bf2f(lr[640 + li]), x2 = bf2f(lr[656 + li]);
        const float dv0 = dt[(size_t)row * 32 + li], dv1 = dt[(size_t)row * 32 + 16 + li];
        float qv[3][8], kv[2][8]; float sq = 0.f, sk = 0.f;
#pragma unroll
        for (int j = 0; j < 3; ++j) { unpack8(qr[j], qv[j]);
#pragma unroll
            for (int e = 0; e < 8; ++e) sq += qv[j][e] * qv[j][e]; }
#pragma unroll
        for (int j = 0; j < 2; ++j) { unpack8(kr[j], kv[j]);
#pragma unroll
            for (int e = 0; e < 8; ++e) sk += kv[j][e] * kv[j][e]; }
        sq = gsum16(sq); sk = gsum16(sk);
        const float rq = rsqrtf(sq * (1.f / 384.f) + EPS), rk = rsqrtf(sk * (1.f / 256.f) + EPS);
#pragma unroll
        for (int j = 0; j < 3; ++j) { float o[8]; const int c = (li + 16 * j) * 8;
#pragma unroll
            for (int e = 0; e < 8; ++e) o[e] = qv[j][e] * rq * P.q_a_norm[c + e];
            *(u32x4*)(lr + c) = pack8(o); }
#pragma unroll
        for (int j = 0; j < 2; ++j) { float o[8]; const int c = (li + 16 * j) * 8;
#pragma unroll
            for (int e = 0; e < 8; ++e) o[e] = kv[j][e] * rk * P.kv_a_norm[c + e];
            *(u32x4*)(lr + 384 + c) = pack8(o); }
        { const float c = tab[((size_t)posof(row) * 16 + li) * 2], s = tab[((size_t)posof(row) * 16 + li) * 2 + 1];
          *(unsigned*)(lr + 640 + 2 * li) = pk2(x1 * c - x2 * s, x2 * c + x1 * s); }
        { const float v0 = dv0 + P.dt_bias_f[li], v1 = dv1 + P.dt_bias_b[li];
          dt[(size_t)row * 32 + li] = fmaxf(v0, 0.f) + log1pf(__expf(-fabsf(v0)));
          dt[(size_t)row * 32 + 16 + li] = fmaxf(v1, 0.f) + log1pf(__expf(-fabsf(v1))); }
    }
    const bf16_t* xbc = (const bf16_t*)(P.ws + WS_XBC); bf16_t* xbc2 = (bf16_t*)(P.ws + WS_XBC2);
    for (int idx = gt; idx < (T / 8) * 160; idx += NGT) { const int rb = idx / 160, c0 = (idx - rb * 160) * 8; conv8_item<false>(xbc, xbc2, NXBC, rb * 8, rb * 8, c0, P.conv_w, P.conv_b); }
}

constexpr int BCROW = 144, SSD_BT = 0, SSD_CT = 128 * BCROW, SSD_WAVE = 2 * 128 * BCROW, SSD_WSZ = 8192 + 2048, SSD_RED = SSD_WAVE + 8 * SSD_WSZ;
constexpr size_t WS_DEC = 352 * MiB;
DI float wave_incl_scan(float v, int lane) {
#pragma unroll
    for (int o = 1; o < 64; o <<= 1) { const float n = __shfl_up(v, o); if (lane >= o) v += n; }
    return v;
}
DI bf16x8 tr_frag(const LAS uchar* p, int rowstride) {
    const s16x4 lo = __builtin_bit_cast(s16x4, __builtin_amdgcn_ds_read_tr16_b64_v4i16((LAS s16x4*)p));
    const s16x4 hh = __builtin_bit_cast(s16x4, __builtin_amdgcn_ds_read_tr16_b64_v4i16((LAS s16x4*)(p + 8 * rowstride)));
    return __builtin_shufflevector(lo, hh, 0, 1, 2, 3, 4, 5, 6, 7);
}
DI void ssd_chunk_prologue(const Params& P, LAS uchar* lds, int cg, int g) {
    const int tid = otid(), lane = tid & 63, wave = tid >> 6;
    const bf16_t* xbc2 = (const bf16_t*)(P.ws + WS_XBC2); const float* dtg = (const float*)(P.ws + WS_DT);
    const int row0 = cg * 128, head = g * 8 + wave;
    __syncthreads();
#pragma unroll
    for (int k = 0; k < 2; ++k) { const int c = tid + 512 * k, row = c >> 3, c16 = c & 7;
        const bf16_t* src = xbc2 + (size_t)(row0 + row) * NXBC + 1024 + g * 64 + c16 * 8;
        *(LAS u32x4*)(lds + SSD_BT + row * BCROW + c16 * 16) = *(const u32x4*)src;
        *(LAS u32x4*)(lds + SSD_CT + row * BCROW + c16 * 16) = *(const u32x4*)(src + 128); }
    LAS float* arr = (LAS float*)(lds + SSD_WAVE + wave * SSD_WSZ + 8192);
    const float Af = -__expf(P.a_log_f[head]), Ab = -__expf(P.a_log_b[head]);
    const float df0 = dtg[(size_t)(row0 + lane) * 32 + head], df1 = dtg[(size_t)(row0 + 64 + lane) * 32 + head];
    const float db0 = dtg[(size_t)(row0 + lane) * 32 + 16 + head], db1 = dtg[(size_t)(row0 + 64 + lane) * 32 + 16 + head];
    float p0 = wave_incl_scan(Af * df0, lane); const float tot0 = __shfl(p0, 63); float p1 = wave_incl_scan(Af * df1, lane) + tot0;
    float q0 = wave_incl_scan(Ab * db0, lane); const float qt0 = __shfl(q0, 63); float q1 = wave_incl_scan(Ab * db1, lane) + qt0; const float qtot = __shfl(q1, 63);
    arr[lane] = df0; arr[64 + lane] = df1; arr[128 + lane] = db0; arr[192 + lane] = db1;
    arr[256 + lane] = p0; arr[320 + lane] = p1;
    arr[384 + lane] = qtot - q0 + Ab * db0; arr[448 + lane] = qtot - q1 + Ab * db1;
    __syncthreads();
}
DI void ssd_xload(const Params& P, u32x4 (&v)[4], int row0, int sb, int head, int lane) {
    const bf16_t* xbc2 = (const bf16_t*)(P.ws + WS_XBC2);
#pragma unroll
    for (int i = 0; i < 4; ++i) { const int c = lane + 64 * i, row = c >> 3, c16 = c & 7; v[i] = *(const u32x4*)(xbc2 + (size_t)(row0 + 32 * sb + row) * NXBC + head * 64 + c16 * 8); }
}
DI void ssd_xstore(LAS uchar* xb, const u32x4 (&v)[4], int lane) {
#pragma unroll
    for (int i = 0; i < 4; ++i) { const int c = lane + 64 * i, row = c >> 3, c16 = c & 7; *(LAS u32x4*)(xb + row * 128 + c16 * 16) = v[i]; }
}
DI void p3_s1_states(const Params& P, LAS uchar* lds) {
    const int tid = otid(), lane = tid & 63, wave = tid >> 6, r32 = lane & 31, hi = lane >> 5;
    const int i16 = lane & 15, qq = i16 >> 2, pp = i16 & 3, blk = (lane >> 4) & 1;
    bf16_t* st = (bf16_t*)P.out; float* dec = (float*)(P.ws + WS_DEC);
    LAS uchar* xbuf = lds + SSD_WAVE + wave * SSD_WSZ; const LAS float* arr = (const LAS float*)(xbuf + 8192);
    for (int item = blockIdx.x; item < 1280; item += gridDim.x) {
        const int cg = item >> 1, g = item & 1, row0 = cg * 128, head = g * 8 + wave;
        u32x4 xr[4]; ssd_xload(P, xr, row0, 0, head, lane);
        ssd_chunk_prologue(P, lds, cg, g);
        f32x16 acc[2][2][2];
#pragma unroll
        for (int d = 0; d < 2; ++d)
#pragma unroll
            for (int a = 0; a < 2; ++a)
#pragma unroll
                for (int b = 0; b < 2; ++b)
#pragma unroll
                    for (int r = 0; r < 16; ++r) acc[d][a][b][r] = 0.f;
        const float wlf = arr[256 + 127], wlb = arr[384];
#pragma unroll 1
        for (int sb = 0; sb < 4; ++sb) {
            LAS uchar* xb = xbuf + (sb & 1) * 4096;
            ssd_xstore(xb, xr, lane);
            if (sb < 3) ssd_xload(P, xr, row0, sb + 1, head, lane);
#pragma unroll
            for (int k2 = 0; k2 < 2; ++k2) {
                const int sbase = 32 * sb + 16 * k2 + 4 * hi;
                float wf[8], wb[8];
                { const f32x4 a0 = *(const LAS f32x4*)(arr + 256 + sbase), a1 = *(const LAS f32x4*)(arr + 256 + sbase + 8), d0 = *(const LAS f32x4*)(arr + sbase), d1 = *(const LAS f32x4*)(arr + sbase + 8);
#pragma unroll
                  for (int j = 0; j < 4; ++j) { wf[j] = __expf(wlf - a0[j]) * d0[j]; wf[4 + j] = __expf(wlf - a1[j]) * d1[j]; } }
                { const f32x4 a0 = *(const LAS f32x4*)(arr + 384 + sbase), a1 = *(const LAS f32x4*)(arr + 384 + sbase + 8), d0 = *(const LAS f32x4*)(arr + 128 + sbase), d1 = *(const LAS f32x4*)(arr + 128 + sbase + 8);
#pragma unroll
                  for (int j = 0; j < 4; ++j) { wb[j] = __expf(wlb - a0[j]) * d0[j]; wb[4 + j] = __expf(wlb - a1[j]) * d1[j]; } }
                bf16x8 xsf[2], xsb[2];
#pragma unroll
                for (int pb = 0; pb < 2; ++pb) {
                    const bf16x8 xf = tr_frag(xb + (16 * k2 + 4 * hi + qq) * 128 + (32 * pb + 16 * blk + 4 * pp) * 2, 128);
                    float f[8], f2[8]; unpack8(__builtin_bit_cast(u32x4, xf), f);
#pragma unroll
                    for (int j = 0; j < 8; ++j) { f2[j] = f[j] * wb[j]; f[j] *= wf[j]; }
                    xsf[pb] = __builtin_bit_cast(bf16x8, pack8(f)); xsb[pb] = __builtin_bit_cast(bf16x8, pack8(f2));
                }
#pragma unroll
                for (int nb = 0; nb < 2; ++nb) {
                    const bf16x8 bf = tr_frag(lds + SSD_BT + (32 * sb + 16 * k2 + 4 * hi + qq) * BCROW + (32 * nb + 16 * blk + 4 * pp) * 2, BCROW);
#pragma unroll
                    for (int pb = 0; pb < 2; ++pb) {
                        acc[0][nb][pb] = __builtin_amdgcn_mfma_f32_32x32x16_bf16(bf, xsf[pb], acc[0][nb][pb], 0, 0, 0);
                        acc[1][nb][pb] = __builtin_amdgcn_mfma_f32_32x32x16_bf16(bf, xsb[pb], acc[1][nb][pb], 0, 0, 0);
                    }
                }
            }
        }
#pragma unroll
        for (int d = 0; d < 2; ++d) {
            bf16_t* so = st + ((size_t)(cg * 2 + d) * 16 + head) * 4096;
#pragma unroll
            for (int nb = 0; nb < 2; ++nb)
#pragma unroll
                for (int pb = 0; pb < 2; ++pb)
#pragma unroll
                    for (int gq = 0; gq < 4; ++gq) { u32x2 o; o.x = pk2(acc[d][nb][pb][4 * gq], acc[d][nb][pb][4 * gq + 1]); o.y = pk2(acc[d][nb][pb][4 * gq + 2], acc[d][nb][pb][4 * gq + 3]);
                        *(u32x2*)(so + (32 * pb + r32) * 64 + 32 * nb + 8 * gq + 4 * hi) = o; }
        }
        if (lane == 0) { dec[(cg * 2 + 0) * 16 + head] = __expf(wlf); dec[(cg * 2 + 1) * 16 + head] = __expf(wlb); }
    }
}
DI void p3_s2_scan(const Params& P) {
    unsigned* st = (unsigned*)P.out; const float* dec = (const float*)(P.ws + WS_DEC);
    for (int e = blockIdx.x * 512 + otid(); e < 65536; e += gridDim.x * 512) {
        const int dir = e >> 15, dh = e >> 11;
        for (int seq = 0; seq < 33; ++seq) {
            const int c0 = seq * 16, nc = seq < 32 ? 16 : 128;
            float h0 = 0.f, h1 = 0.f;
            for (int b = 0; b < nc; b += 16) {
                unsigned s[16]; float d[16];
#pragma unroll
                for (int i = 0; i < 16; ++i) { const int c = dir == 0 ? c0 + b + i : c0 + nc - 1 - b - i; s[i] = st[(size_t)c * 65536 + e]; d[i] = dec[c * 32 + dh]; }
#pragma unroll
                for (int i = 0; i < 16; ++i) { const float t0 = __uint_as_float(s[i] << 16), t1 = __uint_as_float(s[i] & 0xffff0000u); s[i] = pk2(h0, h1); h0 = h0 * d[i] + t0; h1 = h1 * d[i] + t1; }
#pragma unroll
                for (int i = 0; i < 16; ++i) { const int c = dir == 0 ? c0 + b + i : c0 + nc - 1 - b - i; st[(size_t)c * 65536 + e] = s[i]; }
            }
        }
    }
}
DI void p3_s3_output(const Params& P, LAS uchar* lds, unsigned long long& tacc_) {
    unsigned long long tA_ = 0;
    const int tid = otid(), lane = tid & 63, wave = tid >> 6, r32 = lane & 31, hi = lane >> 5;
    const int i16 = lane & 15, qq = i16 >> 2, pp = i16 & 3, blk = (lane >> 4) & 1;
    const bf16_t* st = (const bf16_t*)P.out; const bf16_t* zb = (const bf16_t*)(P.ws + WS_Z); bf16_t* mix = (bf16_t*)(P.ws + WS_MIX);
    LAS uchar* xbuf = lds + SSD_WAVE + wave * SSD_WSZ; const LAS float* arr = (const LAS float*)(xbuf + 8192);
    LAS float* red = (LAS float*)(lds + SSD_RED);
    for (int item = blockIdx.x; item < 1280; item += gridDim.x) {
        const int cg = item >> 1, g = item & 1, row0 = cg * 128, head = g * 8 + wave;
        PB(13);
        bf16x8 hfr[2][4][2];
#pragma unroll
        for (int d = 0; d < 2; ++d) { const bf16_t* H = st + ((size_t)(cg * 2 + d) * 16 + head) * 4096;
#pragma unroll
            for (int ks = 0; ks < 4; ++ks)
#pragma unroll
                for (int pb = 0; pb < 2; ++pb) hfr[d][ks][pb] = *(const bf16x8*)(H + (32 * pb + r32) * 64 + 16 * ks + 8 * hi); }
        u32x4 xr[4]; ssd_xload(P, xr, row0, 0, head, lane);
        ssd_chunk_prologue(P, lds, cg, g);
        const float Dk = P.d_skip[head];
        PE(13);
#pragma unroll 1
        for (int tb = 0; tb < 4; ++tb) {
            PB(14);
            const int t = 32 * tb + r32;
            const float af_t = arr[256 + t], rb_t = arr[384 + t];
            const float ef = __expf(af_t), eb = __expf(rb_t);
            bf16x8 cfr[4];
#pragma unroll
            for (int ks = 0; ks < 4; ++ks) cfr[ks] = *(const LAS bf16x8*)(lds + SSD_CT + t * BCROW + ks * 32 + hi * 16);
            const int row = row0 + t; const int cbase = g * 512 + wave * 64;
            f32x16 acc[2];
#pragma unroll
            for (int dir = 0; dir < 2; ++dir) {
                f32x16 tmp[2];
#pragma unroll
                for (int pb = 0; pb < 2; ++pb)
#pragma unroll
                    for (int r = 0; r < 16; ++r) tmp[pb][r] = 0.f;
#pragma unroll
                for (int ks = 0; ks < 4; ++ks)
#pragma unroll
                    for (int pb = 0; pb < 2; ++pb) tmp[pb] = __builtin_amdgcn_mfma_f32_32x32x16_bf16(hfr[dir][ks][pb], cfr[ks], tmp[pb], 0, 0, 0);
                const float e = dir == 0 ? ef : eb;
#pragma unroll
                for (int pb = 0; pb < 2; ++pb)
#pragma unroll
                    for (int r = 0; r < 16; ++r) acc[pb][r] = dir == 0 ? e * tmp[pb][r] : acc[pb][r] + e * tmp[pb][r];
            }
            PE(14); PB(15);
            u32x2 zw[2][4];
#pragma unroll
            for (int pb = 0; pb < 2; ++pb)
#pragma unroll
                for (int gq = 0; gq < 4; ++gq) zw[pb][gq] = *(const u32x2*)(zb + (size_t)row * DM + cbase + 32 * pb + 8 * gq + 4 * hi);
#pragma unroll 1
            for (int sb = 0; sb < 4; ++sb) {
                LAS uchar* xb = xbuf + (sb & 1) * 4096;
                ssd_xstore(xb, xr, lane);
                if (sb < 3 || tb < 3) ssd_xload(P, xr, row0, (sb + 1) & 3, head, lane);
                f32x16 X;
#pragma unroll
                for (int r = 0; r < 16; ++r) X[r] = 0.f;
#pragma unroll
                for (int ks = 0; ks < 4; ++ks) {
                    const bf16x8 bfa = *(const LAS bf16x8*)(lds + SSD_BT + (32 * sb + r32) * BCROW + ks * 32 + hi * 16);
                    const bf16x8 cfk = *(const LAS bf16x8*)(lds + SSD_CT + t * BCROW + ks * 32 + hi * 16);
                    X = __builtin_amdgcn_mfma_f32_32x32x16_bf16(bfa, cfk, X, 0, 0, 0);
                }
                constexpr float L2E = 1.4426950408889634f;
                if (sb < tb) {
                    const float a2 = af_t * L2E;
#pragma unroll
                    for (int gq = 0; gq < 4; ++gq) { const int s0 = 32 * sb + 8 * gq + 4 * hi;
                        const f32x4 dfv = *(const LAS f32x4*)(arr + s0), afv = *(const LAS f32x4*)(arr + 256 + s0);
#pragma unroll
                        for (int j = 0; j < 4; ++j) X[4 * gq + j] *= __builtin_amdgcn_exp2f(a2 - afv[j] * L2E) * dfv[j]; }
                } else if (sb > tb) {
                    const float b2 = rb_t * L2E;
#pragma unroll
                    for (int gq = 0; gq < 4; ++gq) { const int s0 = 32 * sb + 8 * gq + 4 * hi;
                        const f32x4 dbv = *(const LAS f32x4*)(arr + 128 + s0), rbv = *(const LAS f32x4*)(arr + 384 + s0);
#pragma unroll
                        for (int j = 0; j < 4; ++j) X[4 * gq + j] *= __builtin_amdgcn_exp2f(b2 - rbv[j] * L2E) * dbv[j]; }
                } else {
#pragma unroll
                    for (int gq = 0; gq < 4; ++gq) {
                        const int s0 = 32 * sb + 8 * gq + 4 * hi;
                        const f32x4 dfv = *(const LAS f32x4*)(arr + s0), dbv = *(const LAS f32x4*)(arr + 128 + s0);
                        const f32x4 afv = *(const LAS f32x4*)(arr + 256 + s0), rbv = *(const LAS f32x4*)(arr + 384 + s0);
#pragma unroll
                        for (int j = 0; j < 4; ++j) {
                            const int s = s0 + j;
                            float coef = 0.f;
                            if (s <= t) coef = __expf(af_t - afv[j]) * dfv[j];
                            if (s >= t) coef += __expf(rb_t - rbv[j]) * dbv[j];
                            float v = X[4 * gq + j] * coef;
                            if (s == t) v += Dk;
                            X[4 * gq + j] = v;
                        }
                    }
                }
#pragma unroll
                for (int s2 = 0; s2 < 2; ++s2) {
                    u32x4 pw;
                    if (s2 == 0) { pw.x = pk2(X[0], X[1]); pw.y = pk2(X[2], X[3]); pw.z = pk2(X[4], X[5]); pw.w = pk2(X[6], X[7]); }
                    else { pw.x = pk2(X[8], X[9]); pw.y = pk2(X[10], X[11]); pw.z = pk2(X[12], X[13]); pw.w = pk2(X[14], X[15]); }
                    const bf16x8 pbk = __builtin_bit_cast(bf16x8, pw);
#pragma unroll
                    for (int pb = 0; pb < 2; ++pb) {
                        const bf16x8 xf = tr_frag(xb + (16 * s2 + 4 * hi + qq) * 128 + (32 * pb + 16 * blk + 4 * pp) * 2, 128);
                        acc[pb] = __builtin_amdgcn_mfma_f32_32x32x16_bf16(xf, pbk, acc[pb], 0, 0, 0);
                    }
                }
            }
            PE(15); PB(16);
            float ssum = 0.f;
#pragma unroll
            for (int pb = 0; pb < 2; ++pb)
#pragma unroll
                for (int gq = 0; gq < 4; ++gq) {
                    const u32x2 zz = zw[pb][gq];
                    const float z0 = __uint_as_float(zz.x << 16), z1 = __uint_as_float(zz.x & 0xffff0000u), z2 = __uint_as_float(zz.y << 16), z3 = __uint_as_float(zz.y & 0xffff0000u);
                    float v0 = acc[pb][4 * gq] * silu(z0), v1 = acc[pb][4 * gq + 1] * silu(z1), v2 = acc[pb][4 * gq + 2] * silu(z2), v3 = acc[pb][4 * gq + 3] * silu(z3);
                    acc[pb][4 * gq] = v0; acc[pb][4 * gq + 1] = v1; acc[pb][4 * gq + 2] = v2; acc[pb][4 * gq + 3] = v3;
                    ssum += (v0 * v0 + v1 * v1) + (v2 * v2 + v3 * v3);
                }
            ssum += __shfl_xor(ssum, 32);
            LAS float* rd = red + (tb & 1) * 256;
            if (hi == 0) rd[wave * 32 + r32] = ssum;
            __syncthreads();
            float tot = 0.f;
#pragma unroll
            for (int w = 0; w < 8; ++w) tot += rd[w * 32 + r32];
            const float rs = rsqrtf(tot * (1.f / 512.f) + EPS);
#pragma unroll
            for (int pb = 0; pb < 2; ++pb)
#pragma unroll
                for (int gq = 0; gq < 4; ++gq) {
                    const int p0 = 32 * pb + 8 * gq + 4 * hi;
                    const f32x4 nw = *(const f32x4*)(P.ssm_norm + cbase + p0);
                    u32x2 o; o.x = pk2(acc[pb][4 * gq] * rs * nw[0], acc[pb][4 * gq + 1] * rs * nw[1]); o.y = pk2(acc[pb][4 * gq + 2] * rs * nw[2], acc[pb][4 * gq + 3] * rs * nw[3]);
                    *(u32x2*)(mix + (size_t)row * 2048 + 1024 + cbase + p0) = o;
                }
            PE(16);
        }
    }
}

DI float max3f(float a, float b, float c) { float r; asm("v_max3_f32 %0, %1, %2, %3" : "=v"(r) : "v"(a), "v"(b), "v"(c)); return r; }
DI float fadd_s(float a, float b) { float r; asm("v_add_f32_e32 %0, %1, %2" : "=v"(r) : "v"(a), "v"(b)); return r; }
constexpr int KROW = 208, VROW = 192, KTILE = 64 * KROW, VTILE = 64 * VROW;
DI void attn_unit(const Params& P, LAS uchar* lds, int rowbase, int L, int h, int qb) {
    const int tid = otid(), lane = tid & 63, wid = __builtin_amdgcn_readfirstlane(tid >> 6), r32 = lane & 31, hi = lane >> 5;
    const bf16_t* qbuf = (const bf16_t*)P.out; const bf16_t* kvb = (const bf16_t*)(P.ws + WS_KV); const bf16_t* lat = (const bf16_t*)(P.ws + WS_LAT);
    bf16_t* mix = (bf16_t*)(P.ws + WS_MIX);
    const int qrow0 = rowbase + qb * 512 + wid * 64 + r32;
    bf16x8 qf[2][6];
#pragma unroll
    for (int j = 0; j < 2; ++j) { const bf16_t* Qg = qbuf + (size_t)(qrow0 + 32 * j) * NQ;
#pragma unroll
      for (int ks = 0; ks < 4; ++ks) qf[j][ks] = *(const bf16x8*)(Qg + h * 64 + ks * 16 + hi * 8);
#pragma unroll
      for (int ks = 0; ks < 2; ++ks) { float f[8], o[8]; unpack8(*(const u32x4*)(Qg + 1024 + h * 32 + ks * 16 + hi * 8), f);
          const float* tp = (const float*)(P.ws + WS_TAB) + ((size_t)(qrow0 + 32 * j - rowbase) * 16 + 8 * ks + 4 * hi) * 2;
          const f32x4 c0 = *(const f32x4*)tp, c1 = *(const f32x4*)(tp + 4);
          o[0] = f[0] * c0[0] - f[1] * c0[1]; o[1] = f[1] * c0[0] + f[0] * c0[1]; o[2] = f[2] * c0[2] - f[3] * c0[3]; o[3] = f[3] * c0[2] + f[2] * c0[3];
          o[4] = f[4] * c1[0] - f[5] * c1[1]; o[5] = f[5] * c1[0] + f[4] * c1[1]; o[6] = f[6] * c1[2] - f[7] * c1[3]; o[7] = f[7] * c1[2] + f[6] * c1[3];
          qf[j][4 + ks] = __builtin_bit_cast(bf16x8, pack8(o)); } }
    LAS uchar* Kb0 = lds; LAS uchar* Vb0 = lds + 2 * KTILE;
    const int skey = tid >> 3, sch = tid & 7, rkey = (tid >> 2) & 63, rch = tid & 3;
    const bf16_t* kn_src = kvb + (size_t)(rowbase + skey) * NKV + h * 64 + sch * 8;
    const bf16_t* v_src = kn_src + 1024;
    const bf16_t* kr_src = lat + (size_t)(rowbase + rkey) * NLAT + 640 + rch * 8;
    u32x4 rkn, rv, rkr = {0u, 0u, 0u, 0u};
    rkn = *(const u32x4*)kn_src; rv = *(const u32x4*)v_src; if (tid < 256) rkr = *(const u32x4*)kr_src;
    *(LAS u32x4*)(Kb0 + skey * KROW + sch * 16) = rkn; *(LAS u32x4*)(Vb0 + skey * VROW + sch * 16) = rv; if (tid < 256) *(LAS u32x4*)(Kb0 + rkey * KROW + 128 + rch * 16) = rkr;
    { const size_t adv = 64; rkn = *(const u32x4*)(kn_src + adv * NKV); rv = *(const u32x4*)(v_src + adv * NKV); if (tid < 256) rkr = *(const u32x4*)(kr_src + adv * NLAT); }
    __syncthreads();
    if (wid >= 4) __builtin_amdgcn_s_barrier();
    bf16x8 kaug, qaug[2];
    { const short one = hi == 0 ? (short)0x3F80 : (short)0; kaug = (bf16x8){one, 0, 0, 0, 0, 0, 0, 0}; }
    {
        f32x16 p[2][2];
#pragma unroll
        for (int j = 0; j < 2; ++j)
#pragma unroll
            for (int hh = 0; hh < 2; ++hh)
#pragma unroll
                for (int r = 0; r < 16; ++r) p[j][hh][r] = 0.f;
#pragma unroll
        for (int ks = 0; ks < 6; ++ks) {
            const bf16x8 k0 = *(const LAS bf16x8*)(Kb0 + r32 * KROW + ks * 32 + hi * 16);
            const bf16x8 k1 = *(const LAS bf16x8*)(Kb0 + (32 + r32) * KROW + ks * 32 + hi * 16);
#pragma unroll
            for (int j = 0; j < 2; ++j) {
                p[j][0] = __builtin_amdgcn_mfma_f32_32x32x16_bf16(k0, qf[j][ks], p[j][0], 0, 0, 0);
                p[j][1] = __builtin_amdgcn_mfma_f32_32x32x16_bf16(k1, qf[j][ks], p[j][1], 0, 0, 0);
            }
        }
        asm volatile("s_nop 15\n\ts_nop 7" : "+v"(p[0][0]), "+v"(p[0][1]), "+v"(p[1][0]), "+v"(p[1][1]));
#pragma unroll
        for (int j = 0; j < 2; ++j) {
            float mxa = max3f(p[j][0][0], p[j][0][1], p[j][1][0]), mxb = max3f(p[j][0][2], p[j][0][3], p[j][1][1]);
            mxa = max3f(mxa, p[j][1][2], p[j][1][3]);
#pragma unroll
            for (int r = 4; r < 16; r += 4) { mxa = max3f(mxa, p[j][0][r], p[j][0][r + 1]); mxb = max3f(mxb, p[j][0][r + 2], p[j][0][r + 3]); mxa = max3f(mxa, p[j][1][r], p[j][1][r + 1]); mxb = max3f(mxb, p[j][1][r + 2], p[j][1][r + 3]); }
            float mx = max3f(mxa, mxb, mxa); mx = fmaxf(mx, __shfl_xor(mx, 32));
            const short nb = hi == 0 ? (short)(pk2(-mx, 0.f) & 0xffffu) : (short)0;
            qaug[j] = (bf16x8){nb, 0, 0, 0, 0, 0, 0, 0};
        }
    }
    float lrun[2] = {0.f, 0.f}; f32x16 o[2][2];
#pragma unroll
    for (int j = 0; j < 2; ++j)
#pragma unroll
        for (int d = 0; d < 2; ++d)
#pragma unroll
            for (int r = 0; r < 16; ++r) o[j][d][r] = 0.f;
    const int NT = L / 64;
    const int i16 = lane & 15, qq = i16 >> 2, pp = i16 & 3, blk = (lane >> 4) & 1;
    const int vtr_off = (4 * hi + qq) * VROW + (16 * blk + 4 * pp) * 2;
    for (int kt = 0; kt < NT; ++kt) {
        const int cur = kt & 1;
        const LAS uchar* Kb = Kb0 + cur * KTILE; const LAS uchar* Vb = Vb0 + cur * VTILE;
        f32x16 p[2][2];
#pragma unroll
        for (int j = 0; j < 2; ++j)
#pragma unroll
            for (int hh = 0; hh < 2; ++hh)
#pragma unroll
                for (int r = 0; r < 16; ++r) p[j][hh][r] = 0.f;
#pragma unroll
        for (int ks = 0; ks < 6; ++ks) {
            const bf16x8 k0 = *(const LAS bf16x8*)(Kb + r32 * KROW + ks * 32 + hi * 16);
            const bf16x8 k1 = *(const LAS bf16x8*)(Kb + (32 + r32) * KROW + ks * 32 + hi * 16);
#pragma unroll
            for (int j = 0; j < 2; ++j) {
                p[j][0] = __builtin_amdgcn_mfma_f32_32x32x16_bf16(k0, qf[j][ks], p[j][0], 0, 0, 0);
                p[j][1] = __builtin_amdgcn_mfma_f32_32x32x16_bf16(k1, qf[j][ks], p[j][1], 0, 0, 0);
            }
        }
#pragma unroll
        for (int j = 0; j < 2; ++j) { p[j][0] = __builtin_amdgcn_mfma_f32_32x32x16_bf16(kaug, qaug[j], p[j][0], 0, 0, 0); p[j][1] = __builtin_amdgcn_mfma_f32_32x32x16_bf16(kaug, qaug[j], p[j][1], 0, 0, 0); }
        if (kt + 1 < NT) { LAS uchar* Kn = Kb0 + (cur ^ 1) * KTILE;
            *(LAS u32x4*)(Kn + skey * KROW + sch * 16) = rkn; if (tid < 256) *(LAS u32x4*)(Kn + rkey * KROW + 128 + rch * 16) = rkr; }
        __builtin_amdgcn_sched_barrier(0);
        asm volatile("s_waitcnt lgkmcnt(0)" ::: "memory"); __builtin_amdgcn_s_barrier(); asm volatile("" ::: "memory");
        __builtin_amdgcn_sched_barrier(0);
        __builtin_amdgcn_s_setprio(1);
#pragma unroll
        for (int s = 0; s < 4; ++s) {
            bf16x8 va[2];
#pragma unroll
            for (int db = 0; db < 2; ++db) {
                const LAS uchar* vp = Vb + vtr_off + s * 16 * VROW + db * 64;
                const s16x4 lo = __builtin_bit_cast(s16x4, __builtin_amdgcn_ds_read_tr16_b64_v4i16((LAS s16x4*)vp));
                const s16x4 hh = __builtin_bit_cast(s16x4, __builtin_amdgcn_ds_read_tr16_b64_v4i16((LAS s16x4*)(vp + 8 * VROW)));
                va[db] = __builtin_shufflevector(lo, hh, 0, 1, 2, 3, 4, 5, 6, 7);
            }
#pragma unroll
            for (int j = 0; j < 2; ++j) {
                const f32x16& pp_ = p[j][s >> 1]; const int b = 8 * (s & 1);
                float e[8];
#pragma unroll
                for (int i = 0; i < 8; ++i) e[i] = __builtin_amdgcn_exp2f(pp_[b + i]);
                lrun[j] = fadd_s(lrun[j], fadd_s(fadd_s(fadd_s(e[0], e[1]), fadd_s(e[2], e[3])), fadd_s(fadd_s(e[4], e[5]), fadd_s(e[6], e[7]))));
                u32x4 pw; pw.x = pk2(e[0], e[1]); pw.y = pk2(e[2], e[3]); pw.z = pk2(e[4], e[5]); pw.w = pk2(e[6], e[7]);
                const bf16x8 pbj = __builtin_bit_cast(bf16x8, pw);
                o[j][0] = __builtin_amdgcn_mfma_f32_32x32x16_bf16(va[0], pbj, o[j][0], 0, 0, 0);
                o[j][1] = __builtin_amdgcn_mfma_f32_32x32x16_bf16(va[1], pbj, o[j][1], 0, 0, 0);
                __builtin_amdgcn_sched_barrier(0);
            }
        }
        __builtin_amdgcn_s_setprio(0);
        if (kt + 1 < NT) { LAS uchar* Vn = Vb0 + (cur ^ 1) * VTILE; *(LAS u32x4*)(Vn + skey * VROW + sch * 16) = rv; }
        if (kt + 2 < NT) { const size_t adv = (size_t)(kt + 2) * 64; rkn = *(const u32x4*)(kn_src + adv * NKV); rv = *(const u32x4*)(v_src + adv * NKV); if (tid < 256) rkr = *(const u32x4*)(kr_src + adv * NLAT); }
        asm volatile("s_waitcnt lgkmcnt(0)" ::: "memory"); __builtin_amdgcn_s_barrier(); asm volatile("" ::: "memory");
    }
    if (wid < 4) __builtin_amdgcn_s_barrier();
#pragma unroll
    for (int j = 0; j < 2; ++j) {
        const float ltot = lrun[j] + __shfl_xor(lrun[j], 32); const float inv = 1.f / ltot;
        bf16_t* op = mix + (size_t)(qrow0 + 32 * j) * 2048 + h * 64 + 4 * hi;
#pragma unroll
        for (int g = 0; g < 4; ++g) {
            u32x2 w0, w1;
            w0.x = pk2(o[j][0][4 * g] * inv, o[j][0][4 * g + 1] * inv); w0.y = pk2(o[j][0][4 * g + 2] * inv, o[j][0][4 * g + 3] * inv);
            w1.x = pk2(o[j][1][4 * g] * inv, o[j][1][4 * g + 1] * inv); w1.y = pk2(o[j][1][4 * g + 2] * inv, o[j][1][4 * g + 3] * inv);
            *(u32x2*)(op + 8 * g) = w0; *(u32x2*)(op + 32 + 8 * g) = w1;
        }
    }
}
DI void p5_attention(const Params& P, LAS uchar* lds) {
    const int G = gridDim.x, bx = blockIdx.x; const int vcu = (G % 8 == 0) ? (bx % 8) * (G / 8) + bx / 8 : bx;
    const int perS = (512 + G - 1) / G, perP = (2048 + G - 1) / G;
    for (int i = 0; i < perS; ++i) { const int s = vcu * perS + i; if (s < 512) attn_unit(P, lds, TP, LS, s >> 5, s & 31); }
    for (int i = 0; i < perP; ++i) { const int s = vcu * perP + i; if (s < 2048) { const int b = s >> 6, rem = s & 63; attn_unit(P, lds, b * LP, LP, rem >> 2, rem & 3); } }
}

DI void p8_act(const Params& P, int rows, int row_off) {
    const int gt = blockIdx.x * 512 + otid(), NGT = gridDim.x * 512;
    const bf16_t* g = (const bf16_t*)(P.ws + WS_G); bf16_t* uo = (bf16_t*)(P.ws + WS_U);
    for (int idx = gt; idx < (rows / 8) * 352; idx += NGT) { const int rb = idx / 352, c0 = (idx - rb * 352) * 8; conv8_item<true>(g, uo, DFF, rb * 8, row_off + rb * 8, c0, P.ffn_conv_w, P.ffn_conv_b); }
}
DI void p2_fixup(const Params& P) {
    const int gt = blockIdx.x * 512 + otid(), NGT = gridDim.x * 512;
    const float* halo = (const float*)(P.ws + WS_HALO2); bf16_t* xbc2 = (bf16_t*)(P.ws + WS_XBC2); const size_t hs = (size_t)320 * 2 * NXBC;
    for (int idx = gt; idx < 320 * 2 * NXBC; idx += NGT) {
        const int ch = idx % NXBC, r2 = idx / NXBC, pm = r2 >> 1, lastrow = r2 & 1;
        const int row = pm * 256 + (lastrow ? 255 : 0); const int pos = posof(row), L = lenof(row);
        const float part = halo[(size_t)r2 * NXBC + ch];
        float gn = 0.f, w;
        if (!lastrow) { w = P.conv_w[ch]; if (pos > 0) gn = halo[hs + ((size_t)(pm - 1) * 2 + 1) * NXBC + ch]; }
        else { w = P.conv_w[2 * NXBC + ch]; if (pos < L - 1) gn = halo[hs + ((size_t)(pm + 1) * 2 + 0) * NXBC + ch]; }
        xbc2[(size_t)row * NXBC + ch] = (unsigned short)(pk2(silu(part + w * gn), 0.f) & 0xffffu);
    }
}
DI void p_fixup(const Params& P) {
    const int gt = blockIdx.x * 512 + otid(), NGT = gridDim.x * 512;
    const float* halo = (const float*)(P.ws + WS_HALO); bf16_t* act = (bf16_t*)(P.ws + WS_ACT);
    for (int idx = gt; idx < 320 * 2 * DFF; idx += NGT) {
        const int ch = idx % DFF, r2 = idx / DFF, pm = r2 >> 1, lastrow = r2 & 1;
        const int row = pm * 256 + (lastrow ? 255 : 0); const int pos = posof(row), L = lenof(row);
        const float part = halo[((size_t)(0 * 320 + pm) * 2 + lastrow) * DFF + ch], uv = halo[((size_t)(1 * 320 + pm) * 2 + lastrow) * DFF + ch];
        float gn = 0.f, w;
        if (!lastrow) { w = P.ffn_conv_w[ch]; if (pos > 0) gn = halo[((size_t)(2 * 320 + pm - 1) * 2 + 1) * DFF + ch]; }
        else { w = P.ffn_conv_w[2 * DFF + ch]; if (pos < L - 1) gn = halo[((size_t)(2 * 320 + pm + 1) * 2 + 0) * DFF + ch]; }
        const float v = part + w * gn;
        const unsigned short ob = (unsigned short)(pk2(silu(v) * uv, 0.f) & 0xffffu);
        act[(size_t)row * DFF + ch] = ob;
    }
}
DI void p_final(const Params& P) {
    const int gt = blockIdx.x * 512 + otid(), NGT = gridDim.x * 512;
    const float* ss2 = (const float*)(P.ws + WS_SS) + T;
    for (int idx = gt; idx < T * 256; idx += 4 * NGT) {
        f32x4 v[4]; float rs[4];
#pragma unroll
        for (int k = 0; k < 4; ++k) { const int i = idx + k * NGT; if (i < T * 256) { v[k] = ((const f32x4*)P.out)[i]; rs[k] = ss2[i >> 8]; } }
#pragma unroll
        for (int k = 0; k < 4; ++k) { const int i = idx + k * NGT; if (i < T * 256) { const f32x4 w = ((const f32x4*)P.final_norm)[i & 255]; __builtin_nontemporal_store(v[k] * rsqrtf(rs[k] * (1.f / DM) + EPS) * w, (f32x4*)P.out + i); } }
    }
}

#define XB_TMO      128
#define XB_XCNT(j)  (256  + 64 * (j))
#define XB_XSUB(j)  (1280 + 64 * (j))
#define XB_XGEN(j)  (2304 + 64 * (j))
#define XB_TOP      3328
#define XB_TOPGEN   3392
#define XCD_BAR_WORDS 3456
#define XB_SPIN_CAP (1u << 18)

__device__ __forceinline__ unsigned xb_ld(unsigned* p)              { return __hip_atomic_load(p, __ATOMIC_RELAXED, __HIP_MEMORY_SCOPE_AGENT); }
__device__ __forceinline__ unsigned xb_add(unsigned* p, unsigned v) { return __hip_atomic_fetch_add(p, v, __ATOMIC_RELAXED, __HIP_MEMORY_SCOPE_AGENT); }
__device__ __forceinline__ unsigned xb_xcc_id() { return (unsigned)__builtin_amdgcn_s_getreg((3 << 11) | 20) & 0xFu; }
#define XB_SPIN(cond, bar) do { unsigned _sp = 0; while (cond) { __builtin_amdgcn_s_sleep(1); \
    if ((++_sp & 255u) == 0u) { if (xb_ld(&(bar)[XB_TMO])) break; if (_sp > XB_SPIN_CAP) { atomicAdd(&(bar)[XB_TMO], 1u); break; } } } } while (0)

struct XcdBarrier {
    unsigned* bar; unsigned x;
    volatile LAS unsigned* st;
};

__device__ __forceinline__ XcdBarrier xcd_barrier_post(unsigned* bar, volatile LAS unsigned* st) {
    XcdBarrier b; b.bar = bar; b.x = xb_xcc_id(); b.st = st;
    if (threadIdx.x == 0) (void)xb_add(&bar[XB_XCNT(b.x)], 1u);
    return b;
}
__device__ __forceinline__ void xcd_barrier_complete(unsigned* bar, unsigned x, unsigned& nloc, unsigned& nx) {
    const unsigned G = gridDim.x * gridDim.y * gridDim.z;
    unsigned sum, cnt, mine, sp = 0u;
    for (;;) {
        sum = 0u; cnt = 0u; mine = 0u;
#pragma unroll
        for (unsigned j = 0; j < 16; ++j) { const unsigned c = xb_ld(&bar[XB_XCNT(j)]); sum += c; cnt += (c > 0u) ? 1u : 0u; mine = (j == x) ? c : mine; }
        if (sum == G) break;
        __builtin_amdgcn_s_sleep(1);
        if ((++sp & 255u) == 0u) { if (xb_ld(&bar[XB_TMO])) break; if (sp > XB_SPIN_CAP) { atomicAdd(&bar[XB_TMO], 1u); break; } }
    }
    nloc = mine > 0u ? mine : 1u; nx = cnt > 0u ? cnt : 1u;
}

__device__ __forceinline__ void xcd_barrier(const XcdBarrier& b) {
    asm volatile("s_waitcnt vmcnt(0)" ::: "memory");
    __syncthreads();
    if (threadIdx.x == 0) {
        unsigned* bar = b.bar; const unsigned bx_ = xb_xcc_id();
        __builtin_amdgcn_s_waitcnt(0);
        unsigned nloc = b.st[0], nx = b.st[1];
        if (nloc == 0u) { xcd_barrier_complete(bar, bx_, nloc, nx); b.st[0] = nloc; b.st[1] = nx; }
        const unsigned old = xb_add(&bar[XB_XSUB(bx_)], 1u);
        const unsigned gen = old / nloc;
        if (old + 1u == (gen + 1u) * nloc) {
            __builtin_amdgcn_fence(__ATOMIC_RELEASE, "agent");
            asm volatile("s_waitcnt vmcnt(0)" ::: "memory");
            const unsigned og = xb_add(&bar[XB_TOP], 1u);
            const unsigned tg = og / nx;
            if (og + 1u == (tg + 1u) * nx) xb_add(&bar[XB_TOPGEN], 1u);
            else XB_SPIN(xb_ld(&bar[XB_TOPGEN]) == tg, bar);
            __builtin_amdgcn_fence(__ATOMIC_ACQUIRE, "agent");
            xb_add(&bar[XB_XGEN(bx_)], 1u);
            asm volatile("s_waitcnt vmcnt(0)" ::: "memory");
        } else {
            XB_SPIN(xb_ld(&bar[XB_XGEN(bx_)]) == gen, bar);
            __builtin_amdgcn_fence(__ATOMIC_ACQUIRE, "agent");
            asm volatile("s_waitcnt vmcnt(0)" ::: "memory");
        }
    }
    __syncthreads();
}

constexpr int LDS_BYTES = 147456;
template <class Epi> DI void run_gemm(LAS uchar* lds, const bf16_t* A, int lda, const bf16_t* Bt, int M, int N, int K, const Epi& E) {
    pg8::Gemm g{A, Bt, M, N, K, lda}; pg8::StaticOrder S; S.init(M, N, (int)gridDim.x, (int)blockIdx.x);
    pg8::gemm_phase<Epi, pg8::StaticOrder, true, true>(lds, g, S, E);
}
__global__ void __launch_bounds__(512, 2) mega(Params P) {
    extern __shared__ __attribute__((aligned(16))) uchar lds_[];
    LAS uchar* lds = (LAS uchar*)lds_;
    cg::grid_group grid = cg::this_grid();
    uchar* ws = P.ws;
    volatile LAS unsigned* bst = (volatile LAS unsigned*)(lds + LDS_BYTES - 16);
    if (threadIdx.x < 4) bst[threadIdx.x] = 0u;
    __syncthreads();
    const XcdBarrier bar = xcd_barrier_post((unsigned*)(ws + WS_BAR), bst);
    bf16_t* lat = (bf16_t*)(ws + WS_LAT); float* ss = (float*)(ws + WS_SS);
    unsigned long long tA_ = 0, tacc_ = 0;
    PB(0); p0_prologue(P, lds);
    if (P.ws == nullptr) grid.sync();
    xcd_barrier(bar); PE(0);
    PB(1);
    { EpiIn2 E{(bf16_t*)(ws + WS_Z), (bf16_t*)(ws + WS_XBC2), lat, (float*)(ws + WS_DT), ss + 2 * T, ss + 3 * T, (const float*)(ws + WS_TAB), P.conv_w, P.conv_b, (float*)(ws + WS_HALO2), (LAS float*)(lds + XCH_OFF), P.dt_bias_f, P.dt_bias_b};
      run_gemm(lds, (const bf16_t*)(ws + WS_H), DM, (const bf16_t*)(ws + WS_WIN), T, DINP, DM, E); }
    xcd_barrier(bar); PE(1);
    PB(2); p2_fixup(P);
    xcd_barrier(bar); PE(2);
    PB(3); p3_s1_states(P, lds);
    xcd_barrier(bar); PE(3);
    PB(4); p3_s2_scan(P);
    xcd_barrier(bar); PE(4);
    PB(5); p3_s3_output(P, lds, tacc_);
    xcd_barrier(bar); PE(5);
    PB(6);
    { EpiPlain E{(bf16_t*)P.out, NQ, QSCALE, ss + 2 * T, 1.f / 384.f};
      run_gemm(lds, lat, NLAT, (const bf16_t*)(ws + WS_WQB), T, NQ, 384, E); }
    __syncthreads();
    { EpiPlain E{(bf16_t*)(ws + WS_KV), NKV, 1.0f, ss + 3 * T, 1.f / 256.f};
      run_gemm(lds, lat + 384, NLAT, (const bf16_t*)(ws + WS_WKVB), T, NKV, 256, E); }
    xcd_barrier(bar); PE(6);
    PB(7); p5_attention(P, lds);
    xcd_barrier(bar); PE(7);
    PB(8);
    { EpiRes E{P.xp, P.xs, nullptr, (bf16_t*)(ws + WS_X1B), ss, 0, nullptr};
      run_gemm(lds, (const bf16_t*)(ws + WS_MIX), 2048, (const bf16_t*)(ws + WS_WOUT), T, DM, 2048, E); }
    xcd_barrier(bar); PE(8);
    PB(9);
    { EpiGU2 E{(bf16_t*)(ws + WS_ACT), ss, P.ffn_conv_w, P.ffn_conv_b, (float*)(ws + WS_HALO), (LAS float*)(lds + XCH_OFF), 0};
      run_gemm(lds, (const bf16_t*)(ws + WS_X1B), DM, (const bf16_t*)(ws + WS_WGU), T, NGU, DM, E); }
    xcd_barrier(bar); PE(9);
    PB(10); p_fixup(P);
    xcd_barrier(bar); PE(10);
    PB(11);
    { EpiRes E{nullptr, nullptr, P.out, nullptr, ss + T, 0, (const bf16_t*)(ws + WS_X1B)};
      run_gemm(lds, (const bf16_t*)(ws + WS_ACT), DFF, (const bf16_t*)(ws + WS_WDN), T, DM, DFF, E); }
    xcd_barrier(bar); PE(11);
    PB(12); p_final(P); PE(12);
    if (PROBE_MASK && blockIdx.x == 0) { const unsigned long long t0_ = __builtin_amdgcn_s_memrealtime(); while (__builtin_amdgcn_s_memrealtime() - t0_ < (unsigned long long)PROBE_K * tacc_) __builtin_amdgcn_s_sleep(8); }
}

extern "C" void kernel_launch(void* const* d_in, const int* in_sizes, int n_in, void* d_out, int out_size, void* d_ws, size_t ws_size, hipStream_t stream) {
    static int grid = 0;
    if (grid == 0) {
        int dev = 0, cus = 0, per_cu = 0;
        hipGetDevice(&dev); hipDeviceGetAttribute(&cus, hipDeviceAttributeMultiprocessorCount, dev);
        hipFuncSetAttribute((const void*)mega, hipFuncAttributeMaxDynamicSharedMemorySize, LDS_BYTES);
        if (hipOccupancyMaxActiveBlocksPerMultiprocessor(&per_cu, (const void*)mega, 512, LDS_BYTES) != hipSuccess || per_cu < 1) per_cu = 1;
        (void)hipGetLastError();
        grid = cus * per_cu;
        if (ws_size < 1020 * MiB) fprintf(stderr, "kernel_launch: workspace too small: %zu\n", ws_size);
    }
    (void)hipMemsetAsync((char*)d_ws + WS_BAR, 0, 16384, stream);
    Params p{};
    const float** pf = (const float**)&p;
    for (int i = 0; i < 24; ++i) pf[i] = (const float*)d_in[i];
    p.out = (float*)d_out; p.ws = (uchar*)d_ws;
    void* args[] = {&p};
    hipError_t e = hipLaunchCooperativeKernel((const void*)mega, dim3(grid), dim3(512), args, LDS_BYTES, stream);
    if (e != hipSuccess) fprintf(stderr, "cooperative launch failed: %s (grid %d)\n", hipGetErrorString(e), grid);
}
```

```cpp
#include <hip/hip_runtime.h>
#include <hip/hip_cooperative_groups.h>
#include <cstdio>
#include <cstdint>
namespace cg = cooperative_groups;
namespace pg8 {
#define PG8_LAS __attribute__((address_space(3)))
typedef unsigned short bf16_t;
typedef short bf16x8 __attribute__((ext_vector_type(8)));
typedef float f32x4 __attribute__((ext_vector_type(4)));
typedef unsigned u32x4 __attribute__((ext_vector_type(4)));
constexpr int BM = 256, BK = 64, HALF = 128, HTB = HALF * BK * 2  , STAGE_BYTES = 8 * HTB, NXCD = 8, WGM = 8;
__host__ __device__ __forceinline__ int lds_byte(int r, int c) { const int st = (r >> 4) * 2 + (c >> 5), rr = r & 15, cc = c & 31, ob = rr * 64 + cc * 2; return st * 1024 + (ob ^ (((ob >> 9) & 1) << 5)); }
__host__ __device__ __forceinline__ void stage_rc(int b, int& R, int& C) { const int st = b / 1024, sb = b % 1024, swz = sb ^ (((sb >> 9) & 1) << 5); R = (st >> 1) * 16 + swz / 64; C = (st & 1) * 32 + (swz % 64) / 2; }
__host__ __device__ __forceinline__ int perm32(int rho) { const int n = rho >> 4, i = rho & 15; return 8 * (i >> 2) + 4 * n + (i & 3); }
struct Unit { int pm, pn; };
struct Gemm { const bf16_t* A; const bf16_t* Bt; int M, N, K, lda; };
struct StaticOrder {
    int nM, nN, nwg, G, c;
    __host__ __device__ void init(int M, int N, int G_, int c_) { nM = M / BM; nN = N / BM; nwg = nM * nN; G = G_; c = c_; }
    __host__ __device__ bool next(int i, Unit& u) const {
        const long L = (long)i * G + c; if (L >= nwg) return false;
        int wgid = (int)L; { const int q = nwg / NXCD, r = nwg % NXCD, xcd = wgid % NXCD, off = wgid / NXCD; wgid = (xcd < r ? xcd * (q + 1) : r * (q + 1) + (xcd - r) * q) + off; }
        const int nig = WGM * nN, gid = wgid / nig, fm = gid * WGM, gsz = (nM - fm) < WGM ? (nM - fm) : WGM;
        u.pm = fm + ((wgid % nig) % gsz); u.pn = (wgid % nig) / gsz; return true;
    }
    __device__ __forceinline__ void a_ready(const Unit&) const {}
    __device__ __forceinline__ void done(const Unit&) const {}
};
template <class Epi, class Sched, bool ALIGN_EPI = false, bool SP2 = false>
__device__ __forceinline__ void gemm_phase(PG8_LAS unsigned char* lds, const Gemm g, const Sched& S, const Epi& E) {
    int tid_ = threadIdx.x; asm volatile("" : "+v"(tid_)); const int tid = tid_, wid = __builtin_amdgcn_readfirstlane(tid >> 6), lane = tid & 63, wr = wid >> 2, wc = wid & 3, fr = lane & 15, fq = lane >> 4;
    const int K = g.K, nt = K / BK;
    unsigned voffA[2], voffB[2];
#pragma unroll
    for (int i = 0; i < 2; ++i) { int R, C; stage_rc(tid * 16 + i * 8192, R, C); const int Rb = Epi::PERM ? ((R & ~31) + perm32(R & 31)) : R;
        voffA[i] = (unsigned)(R * g.lda + C) * 2u; voffB[i] = (unsigned)(Rb * K + C) * 2u; }
    const size_t kstep = (size_t)(BK * 2);
    const size_t hstepB = (size_t)HALF * K * 2, hstepA = (size_t)HALF * g.lda * 2;
    const size_t tstepA = 2 * hstepA, tstepB = 2 * hstepB;
    const unsigned ldsw = (unsigned)wid * 1024u;
    const int aoff = lds_byte(wr * 64 + fr, fq * 8), boff = lds_byte(wc * 32 + fr, fq * 8);
#define PG8_SA(b, h) (((b) * 2 + (h)) * HTB)
#define PG8_SB(b, h) ((4 + (b) * 2 + (h)) * HTB)
#define PG8_STAGE(bufoff, gbase, voff) do { _Pragma("unroll") for (int _i = 0; _i < 2; ++_i) \
        __builtin_amdgcn_global_load_lds((const unsigned*)((const char*)(gbase) + (voff)[_i]), (PG8_LAS unsigned*)(lds + (bufoff) + ldsw + _i * 8192), 16, 0, 0); } while (0)
#define PG8_LDA(dst, b, h) do { _Pragma("unroll") for (int m = 0; m < 4; ++m) _Pragma("unroll") for (int k = 0; k < 2; ++k) dst[m][k] = *(const PG8_LAS bf16x8*)(lds + PG8_SA(b, h) + aoff + m * 2048 + k * 1024); } while (0)
#define PG8_LDB(dst, b, h) do { _Pragma("unroll") for (int n = 0; n < 2; ++n) _Pragma("unroll") for (int k = 0; k < 2; ++k) dst[n][k] = *(const PG8_LAS bf16x8*)(lds + PG8_SB(b, h) + boff + n * 2048 + k * 1024); } while (0)
#define PG8_MMA(ai, bj, At, Bt) do { __builtin_amdgcn_s_setprio(1); _Pragma("unroll") for (int m = 0; m < 4; ++m) _Pragma("unroll") for (int n = 0; n < 2; ++n) _Pragma("unroll") for (int k = 0; k < 2; ++k) \
        acc[ai][bj][m][n] = __builtin_amdgcn_mfma_f32_16x16x32_bf16(Bt[n][k], At[m][k], acc[ai][bj][m][n], 0, 0, 0); __builtin_amdgcn_s_setprio(0); } while (0)
#define PG8_WAIT_V(n) asm volatile("s_waitcnt vmcnt(" #n ")" ::: "memory")
#define PG8_WAIT_L(n) asm volatile("s_waitcnt lgkmcnt(" #n ")" ::: "memory")
#define PG8_BAR __builtin_amdgcn_s_barrier()
#define PG8_SCHED __builtin_amdgcn_sched_barrier(0)
    Unit cur, nxt; int ui = 0;
    if (!S.next(0, cur)) return;
    f32x4 acc[2][2][4][2];
#pragma unroll
    for (int a = 0; a < 2; ++a)
#pragma unroll
        for (int b = 0; b < 2; ++b)
#pragma unroll
            for (int m = 0; m < 4; ++m)
#pragma unroll
                for (int n = 0; n < 2; ++n) acc[a][b][m][n] = (f32x4){0.f, 0.f, 0.f, 0.f};
    bf16x8 At[4][2], B0[2][2], B1[2][2];
    const char* cA = (const char*)g.A + (size_t)cur.pm * tstepA; const char* cB = (const char*)g.Bt + (size_t)cur.pn * tstepB;
    S.a_ready(cur);
    if constexpr (SP2) {
        PG8_STAGE(PG8_SB(0, 0), cB, voffB); PG8_STAGE(PG8_SB(0, 1), cB + hstepB, voffB); PG8_STAGE(PG8_SA(0, 0), cA, voffA); PG8_STAGE(PG8_SA(0, 1), cA + hstepA, voffA);
        if (wr == 1) PG8_BAR;
        PG8_WAIT_V(2); PG8_BAR;
        PG8_STAGE(PG8_SB(1, 0), cB + kstep, voffB); PG8_STAGE(PG8_SA(1, 0), cA + kstep, voffA); PG8_STAGE(PG8_SB(1, 1), cB + hstepB + kstep, voffB);
        PG8_WAIT_V(6); PG8_BAR;
    } else {
        PG8_STAGE(PG8_SB(0, 0), cB, voffB); PG8_STAGE(PG8_SA(0, 0), cA, voffA); PG8_STAGE(PG8_SB(0, 1), cB + hstepB, voffB); PG8_STAGE(PG8_SA(0, 1), cA + hstepA, voffA);
        if (wr == 1) PG8_BAR;
        PG8_WAIT_V(4); PG8_BAR;
        PG8_STAGE(PG8_SB(1, 0), cB + kstep, voffB); PG8_STAGE(PG8_SA(1, 0), cA + kstep, voffA); PG8_STAGE(PG8_SB(1, 1), cB + hstepB + kstep, voffB);
        PG8_WAIT_V(6); PG8_BAR;
    }
    for (;;) {
        const bool has_next = S.next(ui + 1, nxt);
        const char* nA = has_next ? (const char*)g.A + (size_t)nxt.pm * tstepA : cA; const char* nB = has_next ? (const char*)g.Bt + (size_t)nxt.pn * tstepB : cB;
        for (int t = 0; t < nt; t += 2) {
            const bool last = (t == nt - 2);
            const char* a1 = cA + (size_t)(t + 1) * kstep;
            const char* a2 = last ? nA : cA + (size_t)(t + 2) * kstep; const char* b2 = last ? nB : cB + (size_t)(t + 2) * kstep;
            const char* a3 = a2 + kstep; const char* b3 = b2 + kstep;
            if (last && has_next) S.a_ready(nxt);
            if constexpr (SP2) {
            PG8_LDB(B0, 0, 0); PG8_LDB(B1, 0, 1); PG8_SCHED; PG8_LDA(At, 0, 0); PG8_STAGE(PG8_SA(1, 1), a1 + hstepA, voffA);
            PG8_WAIT_V(8); PG8_WAIT_L(0); PG8_BAR; PG8_MMA(0, 0, At, B0); PG8_MMA(0, 1, At, B1); PG8_BAR; PG8_SCHED;
            PG8_LDA(At, 0, 1); PG8_STAGE(PG8_SB(0, 0), b2, voffB); PG8_STAGE(PG8_SB(0, 1), b2 + hstepB, voffB); PG8_STAGE(PG8_SA(0, 0), a2, voffA);
            PG8_WAIT_V(8); PG8_WAIT_L(0); PG8_BAR; PG8_MMA(1, 0, At, B0); PG8_MMA(1, 1, At, B1); PG8_BAR; PG8_SCHED;
            PG8_LDB(B0, 1, 0); PG8_LDB(B1, 1, 1); PG8_SCHED; PG8_LDA(At, 1, 0); PG8_STAGE(PG8_SA(0, 1), a2 + hstepA, voffA);
            PG8_WAIT_V(8); PG8_WAIT_L(0); PG8_BAR; PG8_MMA(0, 0, At, B0); PG8_MMA(0, 1, At, B1); PG8_BAR; PG8_SCHED;
            PG8_LDA(At, 1, 1); PG8_STAGE(PG8_SB(1, 0), b3, voffB); PG8_STAGE(PG8_SB(1, 1), b3 + hstepB, voffB); PG8_STAGE(PG8_SA(1, 0), a3, voffA);
            PG8_WAIT_V(8); PG8_WAIT_L(0); PG8_BAR; PG8_MMA(1, 0, At, B0); PG8_MMA(1, 1, At, B1); PG8_BAR; PG8_SCHED;
            } else {
            PG8_LDB(B0, 0, 0); PG8_SCHED; PG8_LDA(At, 0, 0); PG8_STAGE(PG8_SA(1, 1), a1 + hstepA, voffA);
            PG8_WAIT_L(8); PG8_BAR; PG8_WAIT_L(0); PG8_MMA(0, 0, At, B0); PG8_BAR; PG8_SCHED;
            PG8_LDB(B1, 0, 1); PG8_STAGE(PG8_SB(0, 0), b2, voffB);
            PG8_BAR; PG8_WAIT_L(0); PG8_MMA(0, 1, At, B1); PG8_BAR;
            PG8_LDA(At, 0, 1); PG8_STAGE(PG8_SA(0, 0), a2, voffA);
            PG8_BAR; PG8_WAIT_L(0); PG8_MMA(1, 0, At, B0); PG8_BAR; PG8_SCHED;
            PG8_STAGE(PG8_SB(0, 1), b2 + hstepB, voffB);
            PG8_WAIT_V(6); PG8_BAR; PG8_MMA(1, 1, At, B1); PG8_BAR;
            PG8_LDB(B0, 1, 0); PG8_SCHED; PG8_LDA(At, 1, 0); PG8_STAGE(PG8_SA(0, 1), a2 + hstepA, voffA);
            PG8_WAIT_L(8); PG8_BAR; PG8_WAIT_L(0); PG8_MMA(0, 0, At, B0); PG8_BAR; PG8_SCHED;
            PG8_LDB(B1, 1, 1); PG8_STAGE(PG8_SB(1, 0), b3, voffB);
            PG8_BAR; PG8_WAIT_L(0); PG8_MMA(0, 1, At, B1); PG8_BAR;
            PG8_LDA(At, 1, 1); PG8_STAGE(PG8_SA(1, 0), a3, voffA);
            PG8_BAR; PG8_WAIT_L(0); PG8_MMA(1, 0, At, B0); PG8_BAR; PG8_SCHED;
            PG8_STAGE(PG8_SB(1, 1), b3 + hstepB, voffB);
            PG8_WAIT_V(6); PG8_BAR; PG8_MMA(1, 1, At, B1); PG8_BAR;
            }
        }
        if constexpr (ALIGN_EPI) { if (wr == 0) PG8_BAR; }
        if constexpr (!Epi::AFTER_DRAIN) { E(acc, cur, wr, wc, fr, fq); S.done(cur); }
        if (!has_next) break;
#pragma unroll
        for (int a = 0; a < 2; ++a)
#pragma unroll
            for (int b = 0; b < 2; ++b)
#pragma unroll
                for (int m = 0; m < 4; ++m)
#pragma unroll
                    for (int n = 0; n < 2; ++n) acc[a][b][m][n] = (f32x4){0.f, 0.f, 0.f, 0.f};
        cur = nxt; cA = nA; cB = nB; ++ui;
        if constexpr (ALIGN_EPI) { if (wr == 1) PG8_BAR; }
    }
    PG8_WAIT_V(0);
    if constexpr (!ALIGN_EPI) { if (wr == 0) PG8_BAR; }
    PG8_BAR;
    if constexpr (Epi::AFTER_DRAIN) { E.fused(acc, cur, wr, wc, fr, fq, lds, wid, lane); S.done(cur); }
#undef PG8_SA
#undef PG8_SB
#undef PG8_STAGE
#undef PG8_LDA
#undef PG8_LDB
#undef PG8_MMA
#undef PG8_WAIT_V
#undef PG8_WAIT_L
#undef PG8_BAR
#undef PG8_SCHED
}
}

#define DI __device__ __forceinline__
#define LAS __attribute__((address_space(3)))
typedef unsigned short bf16_t;
typedef unsigned char uchar;
typedef short bf16x8 __attribute__((ext_vector_type(8)));
typedef short s16x4 __attribute__((ext_vector_type(4)));
typedef float f32x4 __attribute__((ext_vector_type(4)));
typedef float f32x16 __attribute__((ext_vector_type(16)));
typedef unsigned u32x4 __attribute__((ext_vector_type(4)));
typedef unsigned u32x2 __attribute__((ext_vector_type(2)));
typedef float f32x2_t __attribute__((ext_vector_type(2)));
typedef __bf16 bf16x2_t __attribute__((ext_vector_type(2)));

constexpr int T = 81920, TP = 65536, DM = 1024;
constexpr int LP = 2048, LS = 16384;
constexpr int DIN = 3008, DINP = 3072;
constexpr int NQ = 1536, NKV = 2048, NLAT = 768, NXBC = 1280;
constexpr int DFF = 2816, NGU = 5632;
constexpr float EPS = 1e-6f;
constexpr float QSCALE = 0.10206207261596575f * 1.4426950408889634f;
constexpr int CH0_ROWS = 49152, CH1_ROWS = 32768;

constexpr size_t MiB = 1u << 20;
constexpr size_t WS_WIN = 0, WS_WQB = 6 * MiB, WS_WKVB = 8 * MiB, WS_WOUT = 9 * MiB, WS_WGU = 13 * MiB, WS_WDN = 24 * MiB;
constexpr size_t WS_TAB = 30 * MiB;
constexpr size_t WS_H = 32 * MiB;
constexpr size_t WS_XBC = 192 * MiB;
constexpr size_t WS_MIX = 32 * MiB;
constexpr size_t WS_Z = 392 * MiB;
constexpr size_t WS_LAT = 552 * MiB;
constexpr size_t WS_DT = 672 * MiB;
constexpr size_t WS_XBC2 = 682 * MiB;
constexpr size_t WS_KV = 682 * MiB;
constexpr size_t WS_X1B = 352 * MiB;
constexpr size_t WS_SS = 1004 * MiB;
constexpr size_t WS_BAR = 1006 * MiB;
constexpr size_t WS_G = 32 * MiB;
constexpr size_t WS_U = 512 * MiB;
constexpr size_t WS_ACT = 512 * MiB;
constexpr size_t WS_HALO = 32 * MiB;
constexpr size_t WS_HALO2 = 890 * MiB;
constexpr int XCH_OFF = 131072;
static_assert(WS_XBC2 + (size_t)T * NXBC * 2 <= WS_SS && WS_KV + (size_t)T * NKV * 2 <= WS_SS, "ws map");
static_assert(WS_G + (size_t)CH0_ROWS * DFF * 2 <= WS_X1B && WS_X1B + (size_t)T * DM * 2 <= WS_U && WS_U + (size_t)CH0_ROWS * DFF * 2 <= WS_SS, "ws map 2");
static_assert(WS_MIX + (size_t)T * 2048 * 2 <= WS_X1B, "ws map 3");
static_assert(WS_ACT + (size_t)T * DFF * 2 <= WS_SS && WS_HALO + (size_t)3 * 320 * 2 * DFF * 4 <= WS_X1B, "ws map 4");

struct Params {
    const float *xp, *xs, *norm1, *w_in, *q_a_norm, *kv_a_norm, *w_q_b, *w_kv_b, *conv_w, *conv_b, *dt_bias_f, *dt_bias_b, *a_log_f, *a_log_b,
        *d_skip, *ssm_norm, *w_out, *norm2, *w_gate, *w_up, *ffn_conv_w, *ffn_conv_b, *w_down, *final_norm;
    float* out; uchar* ws;
};

DI int otid() { int t = threadIdx.x; asm volatile("" : "+v"(t)); return t; }
#ifndef PROBE_MASK
#define PROBE_MASK 0u
#endif
#define PROBE_K 1
#define PB(id) do { if (PROBE_MASK && blockIdx.x == 0 && ((PROBE_MASK >> (id)) & 1u)) tA_ = __builtin_amdgcn_s_memrealtime(); } while (0)
#define PE(id) do { if (PROBE_MASK && blockIdx.x == 0 && ((PROBE_MASK >> (id)) & 1u)) tacc_ += __builtin_amdgcn_s_memrealtime() - tA_; } while (0)
DI float bf2f(bf16_t v) { return __uint_as_float((unsigned)v << 16); }
DI unsigned pk2(float lo, float hi) { f32x2_t v = {lo, hi}; bf16x2_t b = __builtin_convertvector(v, bf16x2_t); return __builtin_bit_cast(unsigned, b); }
DI void unpack8(const u32x4 w, float (&f)[8]) {
#pragma unroll
    for (int i = 0; i < 4; ++i) { f[2 * i] = __uint_as_float(w[i] << 16); f[2 * i + 1] = __uint_as_float(w[i] & 0xffff0000u); }
}
DI u32x4 pack8(const float (&f)[8]) { u32x4 w; w.x = pk2(f[0], f[1]); w.y = pk2(f[2], f[3]); w.z = pk2(f[4], f[5]); w.w = pk2(f[6], f[7]); return w; }
DI float wave_sum(float v) {
#pragma unroll
    for (int o = 1; o < 64; o <<= 1) v += __shfl_xor(v, o);
    return v;
}
DI const float* xrow(const Params& P, int row) { return row < TP ? P.xp + (size_t)row * DM : P.xs + (size_t)(row - TP) * DM; }
DI int posof(int row) { return row < TP ? (row & (LP - 1)) : row - TP; }
DI int lenof(int row) { return row < TP ? LP : LS; }
DI float silu(float v) { return v * __builtin_amdgcn_rcpf(1.f + __builtin_amdgcn_exp2f(v * -1.4426950408889634f)); }

#define EPI_LOOP_BEGIN \
    _Pragma("unroll") for (int ai = 0; ai < 2; ++ai) _Pragma("unroll") for (int m = 0; m < 4; ++m) { const int row = u.pm * 256 + ai * 128 + wr * 64 + m * 16 + fr; \
    _Pragma("unroll") for (int bj = 0; bj < 2; ++bj) { const f32x4 v0 = acc[ai][bj][m][0], v1 = acc[ai][bj][m][1];
#define EPI_LOOP_END } }

DI float dpp_ror1(float v) { return __builtin_bit_cast(float, __builtin_amdgcn_update_dpp(0, __builtin_bit_cast(int, v), 0x121, 0xf, 0xf, false)); }
DI float dpp_ror15(float v) { return __builtin_bit_cast(float, __builtin_amdgcn_update_dpp(0, __builtin_bit_cast(int, v), 0x12F, 0xf, 0xf, false)); }
struct EpiIn2 {
    static constexpr bool PERM = true, AFTER_DRAIN = false;
    bf16_t *z, *xbc2, *lat; float* dt; float *ssq, *ssk; const float* tab; const float* cw; const float* cb; float* halo; LAS float* xch0; const float *dtbf, *dtbb; mutable int par;
    DI void operator()(const f32x4 (&acc)[2][2][4][2], const pg8::Unit& u, int wr, int wc, int fr, int fq) const {
        const int lane = fr + 16 * fq;
        if (u.pn < 4) {
            const int col0 = u.pn * 256 + wc * 32 + 8 * fq;
            EPI_LOOP_BEGIN
                u32x4 w; w.x = pk2(v0[0], v0[1]); w.y = pk2(v0[2], v0[3]); w.z = pk2(v1[0], v1[1]); w.w = pk2(v1[2], v1[3]);
                *(u32x4*)(z + (size_t)row * DM + col0 + bj * 128) = w;
            EPI_LOOP_END
        } else if (u.pn < 9) {
            LAS float* xch = xch0 + par * 2048; par ^= 1;
            int cl_ = wc * 32 + 8 * fq; asm volatile("" : "+v"(cl_)); const int cl = cl_;
#pragma unroll
            for (int ai = 0; ai < 2; ++ai)
#pragma unroll
                for (int bj = 0; bj < 2; ++bj) {
                    LAS float* xs = xch + (ai * 2 + wr) * 512 + bj * 128 + cl;
                    if (fr == 0) { *(LAS f32x4*)xs = acc[ai][bj][0][0]; *(LAS f32x4*)(xs + 4) = acc[ai][bj][0][1]; }
                    if (fr == 15) { *(LAS f32x4*)(xs + 256) = acc[ai][bj][3][0]; *(LAS f32x4*)(xs + 260) = acc[ai][bj][3][1]; }
                }
            asm volatile("s_waitcnt lgkmcnt(0)" ::: "memory"); __builtin_amdgcn_s_barrier(); asm volatile("" ::: "memory");
            const int ldn = (lane & 48) | ((fr + 15) & 15), lup = (lane & 48) | ((fr + 1) & 15);
            const f32x4 zero4 = {0.f, 0.f, 0.f, 0.f};
#pragma unroll
            for (int bj = 0; bj < 2; ++bj)
#pragma unroll
                for (int jh = 0; jh < 2; ++jh) {
                    const int tl = bj * 128 + cl + 4 * jh, chj = (u.pn - 4) * 256 + tl;
                    const f32x4 w0 = *(const f32x4*)(cw + chj), w1 = *(const f32x4*)(cw + NXBC + chj), w2 = *(const f32x4*)(cw + 2 * NXBC + chj), bb = *(const f32x4*)(cb + chj);
#pragma unroll
                    for (int ai = 0; ai < 2; ++ai) {
                        const int strip = ai * 2 + wr;
                        const f32x4 ep = strip > 0 ? *(const LAS f32x4*)(xch + (strip - 1) * 512 + 256 + tl) : zero4;
                        const f32x4 en = strip < 3 ? *(const LAS f32x4*)(xch + (strip + 1) * 512 + tl) : zero4;
                        f32x4 dnp = ep, upc, upn;
#pragma unroll
                        for (int k = 0; k < 4; ++k) upc[k] = dpp_ror15(acc[ai][bj][0][jh][k]);
#pragma unroll
                        for (int m = 0; m < 4; ++m) {
                            const int row = u.pm * 256 + ai * 128 + wr * 64 + m * 16 + fr;
                            f32x4 dnc;
#pragma unroll
                            for (int k = 0; k < 4; ++k) { dnc[k] = dpp_ror1(acc[ai][bj][m][jh][k]); upn[k] = m < 3 ? dpp_ror15(acc[ai][bj][m < 3 ? m + 1 : 3][jh][k]) : en[k]; }
                            const f32x4 prev = fr == 0 ? dnp : dnc;
                            const f32x4 next = fr == 15 ? upn : upc;
                            dnp = dnc;
                            const f32x4 part = w0 * prev + w1 * acc[ai][bj][m][jh] + w2 * next + bb;
                            u32x2 o; o.x = pk2(silu(part[0]), silu(part[1])); o.y = pk2(silu(part[2]), silu(part[3]));
                            *(u32x2*)(xbc2 + (size_t)row * NXBC + chj) = o;
                            const bool first = (strip == 0 && m == 0 && fr == 0), last = (strip == 3 && m == 3 && fr == 15);
                            if (first || last) { const size_t ho = ((size_t)u.pm * 2 + (last ? 1 : 0)) * NXBC + chj; *(f32x4*)(halo + ho) = part; *(f32x4*)(halo + (size_t)320 * 2 * NXBC + ho) = acc[ai][bj][m][jh]; }
                            upc = upn;
                        }
                    }
                }
        } else {
            const int colt = (u.pn - 9) * 256, col0 = colt + wc * 32 + 8 * fq;
#pragma unroll
            for (int ai = 0; ai < 2; ++ai)
#pragma unroll
                for (int m = 0; m < 4; ++m) {
                    const int row = u.pm * 256 + ai * 128 + wr * 64 + m * 16 + fr;
#pragma unroll
                    for (int bj = 0; bj < 2; ++bj) {
                        const f32x4 v0 = acc[ai][bj][m][0], v1 = acc[ai][bj][m][1];
                        const int c = col0 + bj * 128;
                        if (c < 640) {
                            u32x4 w; w.x = pk2(v0[0], v0[1]); w.y = pk2(v0[2], v0[3]); w.z = pk2(v1[0], v1[1]); w.w = pk2(v1[2], v1[3]);
                            *(u32x4*)(lat + (size_t)row * NLAT + c) = w;
                            float sq = (v0[0] * v0[0] + v0[1] * v0[1]) + (v0[2] * v0[2] + v0[3] * v0[3]) + (v1[0] * v1[0] + v1[1] * v1[1]) + (v1[2] * v1[2] + v1[3] * v1[3]);
                            sq += __shfl_xor(sq, 16); sq += __shfl_xor(sq, 32);
                            if (fq == 0) atomicAdd((c < 384 ? ssq : ssk) + row, sq);
                        } else if (c < 672) {
                            const float* tp = tab + ((size_t)posof(row) * 16 + 4 * fq) * 2;
                            const f32x4 c0 = *(const f32x4*)tp, c1 = *(const f32x4*)(tp + 4);
                            u32x4 w;
                            w.x = pk2(v0[0] * c0[0] - v0[1] * c0[1], v0[1] * c0[0] + v0[0] * c0[1]); w.y = pk2(v0[2] * c0[2] - v0[3] * c0[3], v0[3] * c0[2] + v0[2] * c0[3]);
                            w.z = pk2(v1[0] * c1[0] - v1[1] * c1[1], v1[1] * c1[0] + v1[0] * c1[1]); w.w = pk2(v1[2] * c1[2] - v1[3] * c1[3], v1[3] * c1[2] + v1[2] * c1[3]);
                            *(u32x4*)(lat + (size_t)row * NLAT + c) = w;
                        } else if (c < 704) {
                            const float* bp = (fq < 2 ? dtbf + 8 * fq : dtbb + 8 * (fq - 2));
                            const f32x4 b0 = *(const f32x4*)bp, b1 = *(const f32x4*)(bp + 4);
                            f32x4 o0, o1;
#pragma unroll
                            for (int k = 0; k < 4; ++k) { const float a = v0[k] + b0[k], b = v1[k] + b1[k]; o0[k] = fmaxf(a, 0.f) + __logf(1.f + __expf(-fabsf(a))); o1[k] = fmaxf(b, 0.f) + __logf(1.f + __expf(-fabsf(b))); }
                            float* d = dt + (size_t)row * 32 + 8 * fq; *(f32x4*)d = o0; *(f32x4*)(d + 4) = o1;
                        }
                    }
                }
        }
    }
};
struct EpiIn {
    static constexpr bool PERM = true, AFTER_DRAIN = false;
    bf16_t *z, *xbc, *lat; float* dt;
    DI void operator()(const f32x4 (&acc)[2][2][4][2], const pg8::Unit& u, int wr, int wc, int fr, int fq) const {
        bf16_t* base; int ld, colt;
        if (u.pn < 4) { base = z; ld = DM; colt = u.pn * 256; } else if (u.pn < 9) { base = xbc; ld = NXBC; colt = (u.pn - 4) * 256; } else { base = lat; ld = NLAT; colt = (u.pn - 9) * 256; }
        const int col0 = colt + wc * 32 + 8 * fq;
        EPI_LOOP_BEGIN
            u32x4 w; w.x = pk2(v0[0], v0[1]); w.y = pk2(v0[2], v0[3]); w.z = pk2(v1[0], v1[1]); w.w = pk2(v1[2], v1[3]);
            *(u32x4*)(base + (size_t)row * ld + col0 + bj * 128) = w;
            if (u.pn == 11 && bj == 1 && wc == 1) { float* d = dt + (size_t)row * 32 + 8 * fq; *(f32x4*)d = v0; *(f32x4*)(d + 4) = v1; }
        EPI_LOOP_END
    }
};
struct EpiPlain {
    static constexpr bool PERM = true, AFTER_DRAIN = false;
    bf16_t* o; int ld; float sc0; const float* ssr; float invn;
    DI void operator()(const f32x4 (&acc)[2][2][4][2], const pg8::Unit& u, int wr, int wc, int fr, int fq) const {
        const int col0 = u.pn * 256 + wc * 32 + 8 * fq;
        EPI_LOOP_BEGIN
            const float sc = sc0 * rsqrtf(ssr[row] * invn + EPS);
            u32x4 w; w.x = pk2(v0[0] * sc, v0[1] * sc); w.y = pk2(v0[2] * sc, v0[3] * sc); w.z = pk2(v1[0] * sc, v1[1] * sc); w.w = pk2(v1[2] * sc, v1[3] * sc);
            *(u32x4*)(o + (size_t)row * ld + col0 + bj * 128) = w;
        EPI_LOOP_END
    }
};
struct EpiRes {
    static constexpr bool PERM = true, AFTER_DRAIN = false;
    const float* resp; const float* ress; float* xo; bf16_t* xb; float* ss; int row_off; const bf16_t* resb;
    DI void operator()(const f32x4 (&acc)[2][2][4][2], const pg8::Unit& u, int wr, int wc, int fr, int fq) const {
        const int col0 = u.pn * 256 + wc * 32 + 8 * fq;
#pragma unroll
        for (int ai = 0; ai < 2; ++ai)
#pragma unroll
            for (int m = 0; m < 4; ++m) {
                const int row = row_off + u.pm * 256 + ai * 128 + wr * 64 + m * 16 + fr;
                const float* rp = (row < TP ? resp + (size_t)row * DM : ress + (size_t)(row - TP) * DM) + col0;
                float s = 0.f;
#pragma unroll
                for (int bj = 0; bj < 2; ++bj) {
                    f32x4 r0, r1;
                    if (resb) { float rf[8]; unpack8(*(const u32x4*)(resb + (size_t)row * DM + col0 + bj * 128), rf); r0 = (f32x4){rf[0], rf[1], rf[2], rf[3]}; r1 = (f32x4){rf[4], rf[5], rf[6], rf[7]}; }
                    else { r0 = *(const f32x4*)(rp + bj * 128); r1 = *(const f32x4*)(rp + bj * 128 + 4); }
                    const f32x4 a = acc[ai][bj][m][0] + r0, b = acc[ai][bj][m][1] + r1;
                    if (xo) { float* op = xo + (size_t)row * DM + col0 + bj * 128; *(f32x4*)op = a; *(f32x4*)(op + 4) = b; }
                    if (xb) { u32x4 w; w.x = pk2(a[0], a[1]); w.y = pk2(a[2], a[3]); w.z = pk2(b[0], b[1]); w.w = pk2(b[2], b[3]); *(u32x4*)(xb + (size_t)row * DM + col0 + bj * 128) = w; }
                    s += (a[0] * a[0] + a[1] * a[1]) + (a[2] * a[2] + a[3] * a[3]) + (b[0] * b[0] + b[1] * b[1]) + (b[2] * b[2] + b[3] * b[3]);
                }
                s += __shfl_xor(s, 16); s += __shfl_xor(s, 32);
                if (fq == 0) atomicAdd(ss + row, s);
            }
    }
};
struct EpiGU2 {
    static constexpr bool PERM = true, AFTER_DRAIN = false;
    bf16_t* act; const float* ss; const float* cw; const float* cb; float* halo; LAS float* xch0; mutable int par;
    DI void operator()(const f32x4 (&acc)[2][2][4][2], const pg8::Unit& u, int wr, int wc, int fr, int fq) const {
        const int lane = fr + 16 * fq;
        LAS float* xch = xch0 + par * 1536; par ^= 1;
        int cl_ = wc * 32 + 8 * fq; asm volatile("" : "+v"(cl_)); const int cl = cl_, ch0 = u.pn * 128 + cl;
        float rs[2][4];
#pragma unroll
        for (int ai = 0; ai < 2; ++ai)
#pragma unroll
            for (int m = 0; m < 4; ++m) rs[ai][m] = rsqrtf(ss[u.pm * 256 + ai * 128 + wr * 64 + m * 16 + fr] * (1.f / DM) + EPS);
        LAS float* wtab = xch + 1024;
        { const int tid_ = (wr * 4 + wc) * 64 + lane;
          if (tid_ < 128) { const int ch = u.pn * 128 + tid_; wtab[tid_] = cw[ch]; wtab[128 + tid_] = cw[DFF + ch]; wtab[256 + tid_] = cw[2 * DFF + ch]; wtab[384 + tid_] = cb[ch]; } }
#pragma unroll
        for (int ai = 0; ai < 2; ++ai) {
            LAS float* xs = xch + (ai * 2 + wr) * 256 + cl;
            if (fr == 0) { *(LAS f32x4*)xs = acc[ai][0][0][0] * rs[ai][0]; *(LAS f32x4*)(xs + 4) = acc[ai][0][0][1] * rs[ai][0]; }
            if (fr == 15) { *(LAS f32x4*)(xs + 128) = acc[ai][0][3][0] * rs[ai][3]; *(LAS f32x4*)(xs + 132) = acc[ai][0][3][1] * rs[ai][3]; }
        }
        asm volatile("s_waitcnt lgkmcnt(0)" ::: "memory"); __builtin_amdgcn_s_barrier(); asm volatile("" ::: "memory");
        const f32x4 zero4 = {0.f, 0.f, 0.f, 0.f};
#pragma unroll
        for (int ai = 0; ai < 2; ++ai) {
            const int strip = ai * 2 + wr;
            f32x4 gc[2], dnp[2], upc[2];
#pragma unroll
            for (int jh = 0; jh < 2; ++jh) {
                gc[jh] = acc[ai][0][0][jh] * rs[ai][0];
                dnp[jh] = strip > 0 ? *(const LAS f32x4*)(xch + (strip - 1) * 256 + 128 + cl + 4 * jh) : zero4;
#pragma unroll
                for (int k = 0; k < 4; ++k) upc[jh][k] = dpp_ror15(gc[jh][k]);
            }
#pragma unroll
            for (int m = 0; m < 4; ++m) {
                const int row = u.pm * 256 + ai * 128 + wr * 64 + m * 16 + fr;
                const bool first = (strip == 0 && m == 0 && fr == 0), last = (strip == 3 && m == 3 && fr == 15);
                u32x2 ob[2];
#pragma unroll
                for (int jh = 0; jh < 2; ++jh) {
                    const LAS float* wp = wtab + cl + 4 * jh;
                    const f32x4 w0 = *(const LAS f32x4*)wp, w1 = *(const LAS f32x4*)(wp + 128), w2 = *(const LAS f32x4*)(wp + 256), bb = *(const LAS f32x4*)(wp + 384);
                    f32x4 dnc, upn, gn = gc[jh];
                    if (m < 3) gn = acc[ai][0][m < 3 ? m + 1 : 3][jh] * rs[ai][m < 3 ? m + 1 : 3];
                    const f32x4 en = (m == 3 && strip < 3) ? *(const LAS f32x4*)(xch + (strip + 1) * 256 + cl + 4 * jh) : zero4;
#pragma unroll
                    for (int k = 0; k < 4; ++k) { dnc[k] = dpp_ror1(gc[jh][k]); upn[k] = m < 3 ? dpp_ror15(gn[k]) : en[k]; }
                    const f32x4 prev = fr == 0 ? dnp[jh] : dnc;
                    const f32x4 next = fr == 15 ? upn : upc[jh];
                    const f32x4 part = w0 * prev + w1 * gc[jh] + w2 * next + bb;
                    const f32x4 uq = acc[ai][1][m][jh] * rs[ai][m];
                    ob[jh].x = pk2(silu(part[0]) * uq[0], silu(part[1]) * uq[1]); ob[jh].y = pk2(silu(part[2]) * uq[2], silu(part[3]) * uq[3]);
                    if (first || last) {
                        const size_t ho = ((size_t)u.pm * 2 + (last ? 1 : 0)) * DFF + ch0 + 4 * jh; const size_t hs = (size_t)320 * 2 * DFF;
                        *(f32x4*)(halo + ho) = part; *(f32x4*)(halo + hs + ho) = uq; *(f32x4*)(halo + 2 * hs + ho) = gc[jh];
                    }
                    dnp[jh] = dnc; upc[jh] = upn; gc[jh] = gn;
                }
                *(u32x4*)(act + (size_t)row * DFF + ch0) = (u32x4){ob[0].x, ob[0].y, ob[1].x, ob[1].y};
            }
        }
    }
};
struct EpiGU {
    static constexpr bool PERM = true, AFTER_DRAIN = false;
    bf16_t *g, *uo; const float* ss; int row_off;
    DI void operator()(const f32x4 (&acc)[2][2][4][2], const pg8::Unit& u, int wr, int wc, int fr, int fq) const {
        const int col0 = u.pn * 128 + wc * 32 + 8 * fq;
#pragma unroll
        for (int ai = 0; ai < 2; ++ai)
#pragma unroll
            for (int m = 0; m < 4; ++m) {
                const int lrow = u.pm * 256 + ai * 128 + wr * 64 + m * 16 + fr;
                const float rs = rsqrtf(ss[row_off + lrow] * (1.f / DM) + EPS);
#pragma unroll
                for (int bj = 0; bj < 2; ++bj) {
                    const f32x4 a = acc[ai][bj][m][0] * rs, b = acc[ai][bj][m][1] * rs;
                    u32x4 w; w.x = pk2(a[0], a[1]); w.y = pk2(a[2], a[3]); w.z = pk2(b[0], b[1]); w.w = pk2(b[2], b[3]);
                    *(u32x4*)((bj == 0 ? g : uo) + (size_t)lrow * DFF + col0) = w;
                }
            }
    }
};

template <class F> DI void transpose_item(const float* W, int K, int N, bf16_t* WT, LAS float* scr, int item, int lane, F destrow, const float* kscale) {
    const int nblk = N / 32, kb = item / nblk, nb = item % nblk, k0 = 64 * kb, n0 = 32 * nb;
    { f32x4 wv[8];
#pragma unroll
      for (int i = 0; i < 8; ++i) { const int kk = 8 * i + (lane >> 3); wv[i] = *(const f32x4*)(W + (size_t)(k0 + kk) * N + n0 + (lane & 7) * 4); }
#pragma unroll
      for (int i = 0; i < 8; ++i) { const int kk = 8 * i + (lane >> 3); const float ks = kscale ? kscale[k0 + kk] : 1.f; LAS float* d = scr + kk * 33 + (lane & 7) * 4; d[0] = wv[i][0] * ks; d[1] = wv[i][1] * ks; d[2] = wv[i][2] * ks; d[3] = wv[i][3] * ks; } }
    asm volatile("s_waitcnt lgkmcnt(0)" ::: "memory");
    const int c = lane & 7;
#pragma unroll
    for (int j = 0; j < 4; ++j) { const int n = (lane >> 3) + 8 * j; const LAS float* s = scr + (8 * c) * 33 + n;
        u32x4 o; o.x = pk2(s[0 * 33], s[1 * 33]); o.y = pk2(s[2 * 33], s[3 * 33]); o.z = pk2(s[4 * 33], s[5 * 33]); o.w = pk2(s[6 * 33], s[7 * 33]);
        *(u32x4*)(WT + (size_t)destrow(n0 + n) * K + k0 + 8 * c) = o; }
    asm volatile("s_waitcnt lgkmcnt(0)" ::: "memory");
}
struct DestIn { DI int operator()(int c) const { if (c >= 640 && c < 672) { const int i = c - 640; return 2304 + 640 + (i < 16 ? 2 * i : 2 * (i - 16) + 1); } return c < 672 ? 2304 + c : (c < 1696 ? c - 672 : (c < 2976 ? 1024 + (c - 1696) : 2304 + 672 + (c - 2976))); } };
struct DestQb { DI int operator()(int c) const { const int h = c / 96, j = c % 96; if (j < 64) return h * 64 + j; const int i = j - 64; return 1024 + h * 32 + (i < 16 ? 2 * i : 2 * (i - 16) + 1); } };
struct DestKvb { DI int operator()(int c) const { const int h = c >> 7, j = c & 127; return j < 64 ? h * 64 + j : 1024 + h * 64 + (j - 64); } };
struct DestId { DI int operator()(int c) const { return c; } };
struct DestGate { DI int operator()(int c) const { return 256 * (c >> 7) + (c & 127); } };
struct DestUp { DI int operator()(int c) const { return 256 * (c >> 7) + 128 + (c & 127); } };

DI void p0_prologue(const Params& P, LAS uchar* lds) {
    const int tid = otid(), lane = tid & 63, wave = tid >> 6, G = gridDim.x;
    const int gw = blockIdx.x * 8 + wave, NGW = G * 8;
    const int gt = blockIdx.x * 512 + tid, NGT = G * 512;
    LAS float* scr = (LAS float*)(lds + wave * 16384);
    bf16_t* Win = (bf16_t*)(P.ws + WS_WIN); bf16_t* Wqb = (bf16_t*)(P.ws + WS_WQB); bf16_t* Wkvb = (bf16_t*)(P.ws + WS_WKVB);
    bf16_t* Wout = (bf16_t*)(P.ws + WS_WOUT); bf16_t* Wgu = (bf16_t*)(P.ws + WS_WGU); bf16_t* Wdn = (bf16_t*)(P.ws + WS_WDN);
    constexpr int I_IN = 16 * 94, I_QB = 6 * 48, I_KVB = 4 * 64, I_OUT = 32 * 32, I_G = 16 * 88, I_DN = 44 * 32;
    constexpr int NITEMS = I_IN + I_QB + I_KVB + I_OUT + 2 * I_G + I_DN;
    for (int it = gw; it < NITEMS; it += NGW) {
        int r = it;
        if (r < I_IN) { transpose_item(P.w_in, 1024, DIN, Win, scr, r, lane, DestIn(), nullptr); continue; } r -= I_IN;
        if (r < I_QB) { transpose_item(P.w_q_b, 384, NQ, Wqb, scr, r, lane, DestQb(), P.q_a_norm); continue; } r -= I_QB;
        if (r < I_KVB) { transpose_item(P.w_kv_b, 256, NKV, Wkvb, scr, r, lane, DestKvb(), P.kv_a_norm); continue; } r -= I_KVB;
        if (r < I_OUT) { transpose_item(P.w_out, 2048, DM, Wout, scr, r, lane, DestId(), nullptr); continue; } r -= I_OUT;
        if (r < I_G) { transpose_item(P.w_gate, 1024, DFF, Wgu, scr, r, lane, DestGate(), P.norm2); continue; } r -= I_G;
        if (r < I_G) { transpose_item(P.w_up, 1024, DFF, Wgu, scr, r, lane, DestUp(), P.norm2); continue; } r -= I_G;
        transpose_item(P.w_down, DFF, DM, Wdn, scr, r, lane, DestId(), nullptr);
    }
    for (int i = gt; i < 64 * 1024 / 8; i += NGT) *(u32x4*)(Win + (size_t)3008 * 1024 + (size_t)i * 8) = (u32x4){0u, 0u, 0u, 0u};
    float* tab = (float*)(P.ws + WS_TAB);
    for (int i = gt; i < LS * 16; i += NGT) { const int pos = i >> 4, k = i & 15; const float inv = powf(10000.0f, -(float)(2 * k) / 32.0f); const float ang = (float)pos * inv; float s, c; sincosf(ang, &s, &c); tab[2 * i] = c; tab[2 * i + 1] = s; }
    float* ss = (float*)(P.ws + WS_SS);
    for (int i = gt; i < 4 * T; i += NGT) ss[i] = 0.f;
    bf16_t* hb = (bf16_t*)(P.ws + WS_H);
    for (int row = gw; row < T; row += NGW) {
        const f32x4* xr = (const f32x4*)xrow(P, row) + lane;
        f32x4 v[4]; float s = 0.f;
#pragma unroll
        for (int j = 0; j < 4; ++j) { v[j] = __builtin_nontemporal_load(xr + 64 * j); s += (v[j][0] * v[j][0] + v[j][1] * v[j][1]) + (v[j][2] * v[j][2] + v[j][3] * v[j][3]); }
        const float rs = rsqrtf(wave_sum(s) * (1.f / DM) + EPS);
        u32x2* o = (u32x2*)(hb + (size_t)row * DM) + lane;
#pragma unroll
        for (int j = 0; j < 4; ++j) { const f32x4 w = ((const f32x4*)P.norm1)[lane + 64 * j]; u32x2 pk; pk.x = pk2(v[j][0] * rs * w[0], v[j][1] * rs * w[1]); pk.y = pk2(v[j][2] * rs * w[2], v[j][3] * rs * w[3]); o[64 * j] = pk; }
    }
}

DI float gsum16(float v) { v += __shfl_xor(v, 1); v += __shfl_xor(v, 2); v += __shfl_xor(v, 4); v += __shfl_xor(v, 8); return v; }
template <bool ACT> DI void conv8_item(const bf16_t* src, bf16_t* dst, int ld, int lrow0, int grow0, int c0, const float* cw, const float* cb) {
    float w0[8], w1[8], w2[8], bb[8];
    { const f32x4 a0 = *(const f32x4*)(cw + c0), a1 = *(const f32x4*)(cw + c0 + 4), b0 = *(const f32x4*)(cw + ld + c0), b1 = *(const f32x4*)(cw + ld + c0 + 4);
      const f32x4 c0v = *(const f32x4*)(cw + 2 * ld + c0), c1v = *(const f32x4*)(cw + 2 * ld + c0 + 4), d0 = *(const f32x4*)(cb + c0), d1 = *(const f32x4*)(cb + c0 + 4);
#pragma unroll
      for (int j = 0; j < 4; ++j) { w0[j] = a0[j]; w0[4 + j] = a1[j]; w1[j] = b0[j]; w1[4 + j] = b1[j]; w2[j] = c0v[j]; w2[4 + j] = c1v[j]; bb[j] = d0[j]; bb[4 + j] = d1[j]; } }
    const int pos0 = posof(grow0), L = lenof(grow0);
    u32x4 raw[10], ur[8];
    const u32x4 zero4 = {0u, 0u, 0u, 0u};
    raw[0] = pos0 > 0 ? *(const u32x4*)(src + (size_t)(lrow0 - 1) * ld + c0) : zero4;
#pragma unroll
    for (int i = 0; i < 8; ++i) raw[1 + i] = *(const u32x4*)(src + (size_t)(lrow0 + i) * ld + c0);
    raw[9] = pos0 + 8 < L ? *(const u32x4*)(src + (size_t)(lrow0 + 8) * ld + c0) : zero4;
    if (ACT) {
#pragma unroll
        for (int i = 0; i < 8; ++i) ur[i] = *(const u32x4*)(dst + (size_t)(lrow0 + i) * ld + c0);
    }
    float prv[8], cur[8], nxt[8];
    unpack8(raw[0], prv); unpack8(raw[1], cur);
#pragma unroll
    for (int i = 0; i < 8; ++i) {
        unpack8(raw[2 + i], nxt);
        float o[8];
#pragma unroll
        for (int j = 0; j < 8; ++j) o[j] = silu(w0[j] * prv[j] + w1[j] * cur[j] + w2[j] * nxt[j] + bb[j]);
        if (ACT) { float uu[8]; unpack8(ur[i], uu);
#pragma unroll
            for (int j = 0; j < 8; ++j) o[j] *= uu[j]; }
        *(u32x4*)(dst + (size_t)(lrow0 + i) * ld + c0) = pack8(o);
#pragma unroll
        for (int j = 0; j < 8; ++j) { prv[j] = cur[j]; cur[j] = nxt[j]; }
    }
}
DI void p2_prep(const Params& P) {
    const int tid = otid(), lane = tid & 63, wave = tid >> 6, G = gridDim.x;
    const int gw = blockIdx.x * 8 + wave, NGW = G * 8;
    const int gt = blockIdx.x * 512 + tid, NGT = G * 512;
    bf16_t* lat = (bf16_t*)(P.ws + WS_LAT); float* dt = (float*)(P.ws + WS_DT); const float* tab = (const float*)(P.ws + WS_TAB);
    const int gl = lane >> 4, li = lane & 15;
    for (int row = gw * 4 + gl; row < T; row += NGW * 4) {
        bf16_t* lr = lat + (size_t)row * NLAT;
        u32x4 qr[3], kr[2];
#pragma unroll
        for (int j = 0; j < 3; ++j) qr[j] = *(const u32x4*)(lr + (li + 16 * j) * 8);
#pragma unroll
        for (int j = 0; j < 2; ++j) kr[j] = *(const u32x4*)(lr + 384 + (li + 16 * j) * 8);
        const float x1 = bf2f(lr[640 + li]), x2 = bf2f(lr[656 + li]);
        const float dv0 = dt[(size_t)row * 32 + li], dv1 = dt[(size_t)row * 32 + 16 + li];
        float qv[3][8], kv[2][8]; float sq = 0.f, sk = 0.f;
#pragma unroll
        for (int j = 0; j < 3; ++j) { unpack8(qr[j], qv[j]);
#pragma unroll
            for (int e = 0; e < 8; ++e) sq += qv[j][e] * qv[j][e]; }
#pragma unroll
        for (int j = 0; j < 2; ++j) { unpack8(kr[j], kv[j]);
#pragma unroll
            for (int e = 0; e < 8; ++e) sk += kv[j][e] * kv[j][e]; }
        sq = gsum16(sq); sk = gsum16(sk);
        const float rq = rsqrtf(sq * (1.f / 384.f) + EPS), rk = rsqrtf(sk * (1.f / 256.f) + EPS);
#pragma unroll
        for (int j = 0; j < 3; ++j) { float o[8]; const int c = (li + 16 * j) * 8;
#pragma unroll
            for (int e = 0; e < 8; ++e) o[e] = qv[j][e] * rq * P.q_a_norm[c + e];
            *(u32x4*)(lr + c) = pack8(o); }
#pragma unroll
        for (int j = 0; j < 2; ++j) { float o[8]; const int c = (li + 16 * j) * 8;
#pragma unroll
            for (int e = 0; e < 8; ++e) o[e] = kv[j][e] * rk * P.kv_a_norm[c + e];
            *(u32x4*)(lr + 384 + c) = pack8(o); }
        { const float c = tab[((size_t)posof(row) * 16 + li) * 2], s = tab[((size_t)posof(row) * 16 + li) * 2 + 1];
          *(unsigned*)(lr + 640 + 2 * li) = pk2(x1 * c - x2 * s, x2 * c + x1 * s); }
        { const float v0 = dv0 + P.dt_bias_f[li], v1 = dv1 + P.dt_bias_b[li];
          dt[(size_t)row * 32 + li] = fmaxf(v0, 0.f) + log1pf(__expf(-fabsf(v0)));
          dt[(size_t)row * 32 + 16 + li] = fmaxf(v1, 0.f) + log1pf(__expf(-fabsf(v1))); }
    }
    const bf16_t* xbc = (const bf16_t*)(P.ws + WS_XBC); bf16_t* xbc2 = (bf16_t*)(P.ws + WS_XBC2);
    for (int idx = gt; idx < (T / 8) * 160; idx += NGT) { const int rb = idx / 160, c0 = (idx - rb * 160) * 8; conv8_item<false>(xbc, xbc2, NXBC, rb * 8, rb * 8, c0, P.conv_w, P.conv_b); }
}

constexpr int BCROW = 144, SSD_BT = 0, SSD_CT = 128 * BCROW, SSD_WAVE = 2 * 128 * BCROW, SSD_WSZ = 8192 + 2048, SSD_RED = SSD_WAVE + 8 * SSD_WSZ;
constexpr size_t WS_DEC = 352 * MiB;
DI float wave_incl_scan(float v, int lane) {
#pragma unroll
    for (int o = 1; o < 64; o <<= 1) { const float n = __shfl_up(v, o); if (lane >= o) v += n; }
    return v;
}
DI bf16x8 tr_frag(const LAS uchar* p, int rowstride) {
    const s16x4 lo = __builtin_bit_cast(s16x4, __builtin_amdgcn_ds_read_tr16_b64_v4i16((LAS s16x4*)p));
    const s16x4 hh = __builtin_bit_cast(s16x4, __builtin_amdgcn_ds_read_tr16_b64_v4i16((LAS s16x4*)(p + 8 * rowstride)));
    return __builtin_shufflevector(lo, hh, 0, 1, 2, 3, 4, 5, 6, 7);
}
DI void ssd_chunk_prologue(const Params& P, LAS uchar* lds, int cg, int g) {
    const int tid = otid(), lane = tid & 63, wave = tid >> 6;
    const bf16_t* xbc2 = (const bf16_t*)(P.ws + WS_XBC2); const float* dtg = (const float*)(P.ws + WS_DT);
    const int row0 = cg * 128, head = g * 8 + wave;
    __syncthreads();
#pragma unroll
    for (int k = 0; k < 2; ++k) { const int c = tid + 512 * k, row = c >> 3, c16 = c & 7;
        const bf16_t* src = xbc2 + (size_t)(row0 + row) * NXBC + 1024 + g * 64 + c16 * 8;
        *(LAS u32x4*)(lds + SSD_BT + row * BCROW + c16 * 16) = *(const u32x4*)src;
        *(LAS u32x4*)(lds + SSD_CT + row * BCROW + c16 * 16) = *(const u32x4*)(src + 128); }
    LAS float* arr = (LAS float*)(lds + SSD_WAVE + wave * SSD_WSZ + 8192);
    const float Af = -__expf(P.a_log_f[head]), Ab = -__expf(P.a_log_b[head]);
    const float df0 = dtg[(size_t)(row0 + lane) * 32 + head], df1 = dtg[(size_t)(row0 + 64 + lane) * 32 + head];
    const float db0 = dtg[(size_t)(row0 + lane) * 32 + 16 + head], db1 = dtg[(size_t)(row0 + 64 + lane) * 32 + 16 + head];
    float p0 = wave_incl_scan(Af * df0, lane); const float tot0 = __shfl(p0, 63); float p1 = wave_incl_scan(Af * df1, lane) + tot0;
    float q0 = wave_incl_scan(Ab * db0, lane); const float qt0 = __shfl(q0, 63); float q1 = wave_incl_scan(Ab * db1, lane) + qt0; const float qtot = __shfl(q1, 63);
    arr[lane] = df0; arr[64 + lane] = df1; arr[128 + lane] = db0; arr[192 + lane] = db1;
    arr[256 + lane] = p0; arr[320 + lane] = p1;
    arr[384 + lane] = qtot - q0 + Ab * db0; arr[448 + lane] = qtot - q1 + Ab * db1;
    __syncthreads();
}
DI void ssd_xload(const Params& P, u32x4 (&v)[4], int row0, int sb, int head, int lane) {
    const bf16_t* xbc2 = (const bf16_t*)(P.ws + WS_XBC2);
#pragma unroll
    for (int i = 0; i < 4; ++i) { const int c = lane + 64 * i, row = c >> 3, c16 = c & 7; v[i] = *(const u32x4*)(xbc2 + (size_t)(row0 + 32 * sb + row) * NXBC + head * 64 + c16 * 8); }
}
DI void ssd_xstore(LAS uchar* xb, const u32x4 (&v)[4], int lane) {
#pragma unroll
    for (int i = 0; i < 4; ++i) { const int c = lane + 64 * i, row = c >> 3, c16 = c & 7; *(LAS u32x4*)(xb + row * 128 + c16 * 16) = v[i]; }
}
DI void p3_s1_states(const Params& P, LAS uchar* lds) {
    const int tid = otid(), lane = tid & 63, wave = tid >> 6, r32 = lane & 31, hi = lane >> 5;
    const int i16 = lane & 15, qq = i16 >> 2, pp = i16 & 3, blk = (lane >> 4) & 1;
    bf16_t* st = (bf16_t*)P.out; float* dec = (float*)(P.ws + WS_DEC);
    LAS uchar* xbuf = lds + SSD_WAVE + wave * SSD_WSZ; const LAS float* arr = (const LAS float*)(xbuf + 8192);
    for (int item = blockIdx.x; item < 1280; item += gridDim.x) {
        const int cg = item >> 1, g = item & 1, row0 = cg * 128, head = g * 8 + wave;
        u32x4 xr[4]; ssd_xload(P, xr, row0, 0, head, lane);
        ssd_chunk_prologue(P, lds, cg, g);
        f32x16 acc[2][2][2];
#pragma unroll
        for (int d = 0; d < 2; ++d)
#pragma unroll
            for (int a = 0; a < 2; ++a)
#pragma unroll
                for (int b = 0; b < 2; ++b)
#pragma unroll
                    for (int r = 0; r < 16; ++r) acc[d][a][b][r] = 0.f;
        const float wlf = arr[256 + 127], wlb = arr[384];
#pragma unroll 1
        for (int sb = 0; sb < 4; ++sb) {
            LAS uchar* xb = xbuf + (sb & 1) * 4096;
            ssd_xstore(xb, xr, lane);
            if (sb < 3) ssd_xload(P, xr, row0, sb + 1, head, lane);
#pragma unroll
            for (int k2 = 0; k2 < 2; ++k2) {
                const int sbase = 32 * sb + 16 * k2 + 4 * hi;
                float wf[8], wb[8];
                { const f32x4 a0 = *(const LAS f32x4*)(arr + 256 + sbase), a1 = *(const LAS f32x4*)(arr + 256 + sbase + 8), d0 = *(const LAS f32x4*)(arr + sbase), d1 = *(const LAS f32x4*)(arr + sbase + 8);
#pragma unroll
                  for (int j = 0; j < 4; ++j) { wf[j] = __expf(wlf - a0[j]) * d0[j]; wf[4 + j] = __expf(wlf - a1[j]) * d1[j]; } }
                { const f32x4 a0 = *(const LAS f32x4*)(arr + 384 + sbase), a1 = *(const LAS f32x4*)(arr + 384 + sbase + 8), d0 = *(const LAS f32x4*)(arr + 128 + sbase), d1 = *(const LAS f32x4*)(arr + 128 + sbase + 8);
#pragma unroll
                  for (int j = 0; j < 4; ++j) { wb[j] = __expf(wlb - a0[j]) * d0[j]; wb[4 + j] = __expf(wlb - a1[j]) * d1[j]; } }
                bf16x8 xsf[2], xsb[2];
#pragma unroll
                for (int pb = 0; pb < 2; ++pb) {
                    const bf16x8 xf = tr_frag(xb + (16 * k2 + 4 * hi + qq) * 128 + (32 * pb + 16 * blk + 4 * pp) * 2, 128);
                    float f[8], f2[8]; unpack8(__builtin_bit_cast(u32x4, xf), f);
#pragma unroll
                    for (int j = 0; j < 8; ++j) { f2[j] = f[j] * wb[j]; f[j] *= wf[j]; }
                    xsf[pb] = __builtin_bit_cast(bf16x8, pack8(f)); xsb[pb] = __builtin_bit_cast(bf16x8, pack8(f2));
                }
#pragma unroll
                for (int nb = 0; nb < 2; ++nb) {
                    const bf16x8 bf = tr_frag(lds + SSD_BT + (32 * sb + 16 * k2 + 4 * hi + qq) * BCROW + (32 * nb + 16 * blk + 4 * pp) * 2, BCROW);
#pragma unroll
                    for (int pb = 0; pb < 2; ++pb) {
                        acc[0][nb][pb] = __builtin_amdgcn_mfma_f32_32x32x16_bf16(bf, xsf[pb], acc[0][nb][pb], 0, 0, 0);
                        acc[1][nb][pb] = __builtin_amdgcn_mfma_f32_32x32x16_bf16(bf, xsb[pb], acc[1][nb][pb], 0, 0, 0);
                    }
                }
            }
        }
#pragma unroll
        for (int d = 0; d < 2; ++d) {
            bf16_t* so = st + ((size_t)(cg * 2 + d) * 16 + head) * 4096;
#pragma unroll
            for (int nb = 0; nb < 2; ++nb)
#pragma unroll
                for (int pb = 0; pb < 2; ++pb)
#pragma unroll
                    for (int gq = 0; gq < 4; ++gq) { u32x2 o; o.x = pk2(acc[d][nb][pb][4 * gq], acc[d][nb][pb][4 * gq + 1]); o.y = pk2(acc[d][nb][pb][4 * gq + 2], acc[d][nb][pb][4 * gq + 3]);
                        *(u32x2*)(so + (32 * pb + r32) * 64 + 32 * nb + 8 * gq + 4 * hi) = o; }
        }
        if (lane == 0) { dec[(cg * 2 + 0) * 16 + head] = __expf(wlf); dec[(cg * 2 + 1) * 16 + head] = __expf(wlb); }
    }
}
DI void p3_s2_scan(const Params& P) {
    unsigned* st = (unsigned*)P.out; const float* dec = (const float*)(P.ws + WS_DEC);
    for (int e = blockIdx.x * 512 + otid(); e < 65536; e += gridDim.x * 512) {
        const int dir = e >> 15, dh = e >> 11;
        for (int seq = 0; seq < 33; ++seq) {
            const int c0 = seq * 16, nc = seq < 32 ? 16 : 128;
            float h0 = 0.f, h1 = 0.f;
            for (int b = 0; b < nc; b += 16) {
                unsigned s[16]; float d[16];
#pragma unroll
                for (int i = 0; i < 16; ++i) { const int c = dir == 0 ? c0 + b + i : c0 + nc - 1 - b - i; s[i] = st[(size_t)c * 65536 + e]; d[i] = dec[c * 32 + dh]; }
#pragma unroll
                for (int i = 0; i < 16; ++i) { const float t0 = __uint_as_float(s[i] << 16), t1 = __uint_as_float(s[i] & 0xffff0000u); s[i] = pk2(h0, h1); h0 = h0 * d[i] + t0; h1 = h1 * d[i] + t1; }
#pragma unroll
                for (int i = 0; i < 16; ++i) { const int c = dir == 0 ? c0 + b + i : c0 + nc - 1 - b - i; st[(size_t)c * 65536 + e] = s[i]; }
            }
        }
    }
}
DI void p3_s3_output(const Params& P, LAS uchar* lds, unsigned long long& tacc_) {
    unsigned long long tA_ = 0;
    const int tid = otid(), lane = tid & 63, wave = tid >> 6, r32 = lane & 31, hi = lane >> 5;
    const int i16 = lane & 15, qq = i16 >> 2, pp = i16 & 3, blk = (lane >> 4) & 1;
    const bf16_t* st = (const bf16_t*)P.out; const bf16_t* zb = (const bf16_t*)(P.ws + WS_Z); bf16_t* mix = (bf16_t*)(P.ws + WS_MIX);
    LAS uchar* xbuf = lds + SSD_WAVE + wave * SSD_WSZ; const LAS float* arr = (const LAS float*)(xbuf + 8192);
    LAS float* red = (LAS float*)(lds + SSD_RED);
    for (int item = blockIdx.x; item < 1280; item += gridDim.x) {
        const int cg = item >> 1, g = item & 1, row0 = cg * 128, head = g * 8 + wave;
        PB(13);
        bf16x8 hfr[2][4][2];
#pragma unroll
        for (int d = 0; d < 2; ++d) { const bf16_t* H = st + ((size_t)(cg * 2 + d) * 16 + head) * 4096;
#pragma unroll
            for (int ks = 0; ks < 4; ++ks)
#pragma unroll
                for (int pb = 0; pb < 2; ++pb) hfr[d][ks][pb] = *(const bf16x8*)(H + (32 * pb + r32) * 64 + 16 * ks + 8 * hi); }
        u32x4 xr[4]; ssd_xload(P, xr, row0, 0, head, lane);
        ssd_chunk_prologue(P, lds, cg, g);
        const float Dk = P.d_skip[head];
        PE(13);
#pragma unroll 1
        for (int tb = 0; tb < 4; ++tb) {
            PB(14);
            const int t = 32 * tb + r32;
            const float af_t = arr[256 + t], rb_t = arr[384 + t];
            const float ef = __expf(af_t), eb = __expf(rb_t);
            bf16x8 cfr[4];
#pragma unroll
            for (int ks = 0; ks < 4; ++ks) cfr[ks] = *(const LAS bf16x8*)(lds + SSD_CT + t * BCROW + ks * 32 + hi * 16);
            const int row = row0 + t; const int cbase = g * 512 + wave * 64;
            f32x16 acc[2];
#pragma unroll
            for (int dir = 0; dir < 2; ++dir) {
                f32x16 tmp[2];
#pragma unroll
                for (int pb = 0; pb < 2; ++pb)
#pragma unroll
                    for (int r = 0; r < 16; ++r) tmp[pb][r] = 0.f;
#pragma unroll
                for (int ks = 0; ks < 4; ++ks)
#pragma unroll
                    for (int pb = 0; pb < 2; ++pb) tmp[pb] = __builtin_amdgcn_mfma_f32_32x32x16_bf16(hfr[dir][ks][pb], cfr[ks], tmp[pb], 0, 0, 0);
                const float e = dir == 0 ? ef : eb;
#pragma unroll
                for (int pb = 0; pb < 2; ++pb)
#pragma unroll
                    for (int r = 0; r < 16; ++r) acc[pb][r] = dir == 0 ? e * tmp[pb][r] : acc[pb][r] + e * tmp[pb][r];
            }
            PE(14); PB(15);
            u32x2 zw[2][4];
#pragma unroll
            for (int pb = 0; pb < 2; ++pb)
#pragma unroll
                for (int gq = 0; gq < 4; ++gq) zw[pb][gq] = *(const u32x2*)(zb + (size_t)row * DM + cbase + 32 * pb + 8 * gq + 4 * hi);
#pragma unroll 1
            for (int sb = 0; sb < 4; ++sb) {
                LAS uchar* xb = xbuf + (sb & 1) * 4096;
                ssd_xstore(xb, xr, lane);
                if (sb < 3 || tb < 3) ssd_xload(P, xr, row0, (sb + 1) & 3, head, lane);
                f32x16 X;
#pragma unroll
                for (int r = 0; r < 16; ++r) X[r] = 0.f;
#pragma unroll
                for (int ks = 0; ks < 4; ++ks) {
                    const bf16x8 bfa = *(const LAS bf16x8*)(lds + SSD_BT + (32 * sb + r32) * BCROW + ks * 32 + hi * 16);
                    const bf16x8 cfk = *(const LAS bf16x8*)(lds + SSD_CT + t * BCROW + ks * 32 + hi * 16);
                    X = __builtin_amdgcn_mfma_f32_32x32x16_bf16(bfa, cfk, X, 0, 0, 0);
                }
                constexpr float L2E = 1.4426950408889634f;
                if (sb < tb) {
                    const float a2 = af_t * L2E;
#pragma unroll
                    for (int gq = 0; gq < 4; ++gq) { const int s0 = 32 * sb + 8 * gq + 4 * hi;
                        const f32x4 dfv = *(const LAS f32x4*)(arr + s0), afv = *(const LAS f32x4*)(arr + 256 + s0);
#pragma unroll
                        for (int j = 0; j < 4; ++j) X[4 * gq + j] *= __builtin_amdgcn_exp2f(a2 - afv[j] * L2E) * dfv[j]; }
                } else if (sb > tb) {
                    const float b2 = rb_t * L2E;
#pragma unroll
                    for (int gq = 0; gq < 4; ++gq) { const int s0 = 32 * sb + 8 * gq + 4 * hi;
                        const f32x4 dbv = *(const LAS f32x4*)(arr + 128 + s0), rbv = *(const LAS f32x4*)(arr + 384 + s0);
#pragma unroll
                        for (int j = 0; j < 4; ++j) X[4 * gq + j] *= __builtin_amdgcn_exp2f(b2 - rbv[j] * L2E) * dbv[j]; }
                } else {
#pragma unroll
                    for (int gq = 0; gq < 4; ++gq) {
                        const int s0 = 32 * sb + 8 * gq + 4 * hi;
                        const f32x4 dfv = *(const LAS f32x4*)(arr + s0), dbv = *(const LAS f32x4*)(arr + 128 + s0);
                        const f32x4 afv = *(const LAS f32x4*)(arr + 256 + s0), rbv = *(const LAS f32x4*)(arr + 384 + s0);
#pragma unroll
                        for (int j = 0; j < 4; ++j) {
                            const int s = s0 + j;
                            float coef = 0.f;
                            if (s <= t) coef = __expf(af_t - afv[j]) * dfv[j];
                            if (s >= t) coef += __expf(rb_t - rbv[j]) * dbv[j];
                            float v = X[4 * gq + j] * coef;
                            if (s == t) v += Dk;
                            X[4 * gq + j] = v;
                        }
                    }
                }
#pragma unroll
                for (int s2 = 0; s2 < 2; ++s2) {
                    u32x4 pw;
                    if (s2 == 0) { pw.x = pk2(X[0], X[1]); pw.y = pk2(X[2], X[3]); pw.z = pk2(X[4], X[5]); pw.w = pk2(X[6], X[7]); }
                    else { pw.x = pk2(X[8], X[9]); pw.y = pk2(X[10], X[11]); pw.z = pk2(X[12], X[13]); pw.w = pk2(X[14], X[15]); }
                    const bf16x8 pbk = __builtin_bit_cast(bf16x8, pw);
#pragma unroll
                    for (int pb = 0; pb < 2; ++pb) {
                        const bf16x8 xf = tr_frag(xb + (16 * s2 + 4 * hi + qq) * 128 + (32 * pb + 16 * blk + 4 * pp) * 2, 128);
                        acc[pb] = __builtin_amdgcn_mfma_f32_32x32x16_bf16(xf, pbk, acc[pb], 0, 0, 0);
                    }
                }
            }
            PE(15); PB(16);
            float ssum = 0.f;
#pragma unroll
            for (int pb = 0; pb < 2; ++pb)
#pragma unroll
                for (int gq = 0; gq < 4; ++gq) {
                    const u32x2 zz = zw[pb][gq];
                    const float z0 = __uint_as_float(zz.x << 16), z1 = __uint_as_float(zz.x & 0xffff0000u), z2 = __uint_as_float(zz.y << 16), z3 = __uint_as_float(zz.y & 0xffff0000u);
                    float v0 = acc[pb][4 * gq] * silu(z0), v1 = acc[pb][4 * gq + 1] * silu(z1), v2 = acc[pb][4 * gq + 2] * silu(z2), v3 = acc[pb][4 * gq + 3] * silu(z3);
                    acc[pb][4 * gq] = v0; acc[pb][4 * gq + 1] = v1; acc[pb][4 * gq + 2] = v2; acc[pb][4 * gq + 3] = v3;
                    ssum += (v0 * v0 + v1 * v1) + (v2 * v2 + v3 * v3);
                }
            ssum += __shfl_xor(ssum, 32);
            LAS float* rd = red + (tb & 1) * 256;
            if (hi == 0) rd[wave * 32 + r32] = ssum;
            __syncthreads();
            float tot = 0.f;
#pragma unroll
            for (int w = 0; w < 8; ++w) tot += rd[w * 32 + r32];
            const float rs = rsqrtf(tot * (1.f / 512.f) + EPS);
#pragma unroll
            for (int pb = 0; pb < 2; ++pb)
#pragma unroll
                for (int gq = 0; gq < 4; ++gq) {
                    const int p0 = 32 * pb + 8 * gq + 4 * hi;
                    const f32x4 nw = *(const f32x4*)(P.ssm_norm + cbase + p0);
                    u32x2 o; o.x = pk2(acc[pb][4 * gq] * rs * nw[0], acc[pb][4 * gq + 1] * rs * nw[1]); o.y = pk2(acc[pb][4 * gq + 2] * rs * nw[2], acc[pb][4 * gq + 3] * rs * nw[3]);
                    *(u32x2*)(mix + (size_t)row * 2048 + 1024 + cbase + p0) = o;
                }
            PE(16);
        }
    }
}

DI float max3f(float a, float b, float c) { float r; asm("v_max3_f32 %0, %1, %2, %3" : "=v"(r) : "v"(a), "v"(b), "v"(c)); return r; }
DI float fadd_s(float a, float b) { float r; asm("v_add_f32_e32 %0, %1, %2" : "=v"(r) : "v"(a), "v"(b)); return r; }
constexpr int KROW = 208, VROW = 192, KTILE = 64 * KROW, VTILE = 64 * VROW;
DI void attn_unit(const Params& P, LAS uchar* lds, int rowbase, int L, int h, int qb) {
    const int tid = otid(), lane = tid & 63, wid = __builtin_amdgcn_readfirstlane(tid >> 6), r32 = lane & 31, hi = lane >> 5;
    const bf16_t* qbuf = (const bf16_t*)P.out; const bf16_t* kvb = (const bf16_t*)(P.ws + WS_KV); const bf16_t* lat = (const bf16_t*)(P.ws + WS_LAT);
    bf16_t* mix = (bf16_t*)(P.ws + WS_MIX);
    const int qrow0 = rowbase + qb * 512 + wid * 64 + r32;
    bf16x8 qf[2][6];
#pragma unroll
    for (int j = 0; j < 2; ++j) { const bf16_t* Qg = qbuf + (size_t)(qrow0 + 32 * j) * NQ;
#pragma unroll
      for (int ks = 0; ks < 4; ++ks) qf[j][ks] = *(const bf16x8*)(Qg + h * 64 + ks * 16 + hi * 8);
#pragma unroll
      for (int ks = 0; ks < 2; ++ks) { float f[8], o[8]; unpack8(*(const u32x4*)(Qg + 1024 + h * 32 + ks * 16 + hi * 8), f);
          const float* tp = (const float*)(P.ws + WS_TAB) + ((size_t)(qrow0 + 32 * j - rowbase) * 16 + 8 * ks + 4 * hi) * 2;
          const f32x4 c0 = *(const f32x4*)tp, c1 = *(const f32x4*)(tp + 4);
          o[0] = f[0] * c0[0] - f[1] * c0[1]; o[1] = f[1] * c0[0] + f[0] * c0[1]; o[2] = f[2] * c0[2] - f[3] * c0[3]; o[3] = f[3] * c0[2] + f[2] * c0[3];
          o[4] = f[4] * c1[0] - f[5] * c1[1]; o[5] = f[5] * c1[0] + f[4] * c1[1]; o[6] = f[6] * c1[2] - f[7] * c1[3]; o[7] = f[7] * c1[2] + f[6] * c1[3];
          qf[j][4 + ks] = __builtin_bit_cast(bf16x8, pack8(o)); } }
    LAS uchar* Kb0 = lds; LAS uchar* Vb0 = lds + 2 * KTILE;
    const int skey = tid >> 3, sch = tid & 7, rkey = (tid >> 2) & 63, rch = tid & 3;
    const bf16_t* kn_src = kvb + (size_t)(rowbase + skey) * NKV + h * 64 + sch * 8;
    const bf16_t* v_src = kn_src + 1024;
    const bf16_t* kr_src = lat + (size_t)(rowbase + rkey) * NLAT + 640 + rch * 8;
    u32x4 rkn, rv, rkr = {0u, 0u, 0u, 0u};
    rkn = *(const u32x4*)kn_src; rv = *(const u32x4*)v_src; if (tid < 256) rkr = *(const u32x4*)kr_src;
    *(LAS u32x4*)(Kb0 + skey * KROW + sch * 16) = rkn; *(LAS u32x4*)(Vb0 + skey * VROW + sch * 16) = rv; if (tid < 256) *(LAS u32x4*)(Kb0 + rkey * KROW + 128 + rch * 16) = rkr;
    { const size_t adv = 64; rkn = *(const u32x4*)(kn_src + adv * NKV); rv = *(const u32x4*)(v_src + adv * NKV); if (tid < 256) rkr = *(const u32x4*)(kr_src + adv * NLAT); }
    __syncthreads();
    if (wid >= 4) __builtin_amdgcn_s_barrier();
    bf16x8 kaug, qaug[2];
    { const short one = hi == 0 ? (short)0x3F80 : (short)0; kaug = (bf16x8){one, 0, 0, 0, 0, 0, 0, 0}; }
    {
        f32x16 p[2][2];
#pragma unroll
        for (int j = 0; j < 2; ++j)
#pragma unroll
            for (int hh = 0; hh < 2; ++hh)
#pragma unroll
                for (int r = 0; r < 16; ++r) p[j][hh][r] = 0.f;
#pragma unroll
        for (int ks = 0; ks < 6; ++ks) {
            const bf16x8 k0 = *(const LAS bf16x8*)(Kb0 + r32 * KROW + ks * 32 + hi * 16);
            const bf16x8 k1 = *(const LAS bf16x8*)(Kb0 + (32 + r32) * KROW + ks * 32 + hi * 16);
#pragma unroll
            for (int j = 0; j < 2; ++j) {
                p[j][0] = __builtin_amdgcn_mfma_f32_32x32x16_bf16(k0, qf[j][ks], p[j][0], 0, 0, 0);
                p[j][1] = __builtin_amdgcn_mfma_f32_32x32x16_bf16(k1, qf[j][ks], p[j][1], 0, 0, 0);
            }
        }
        asm volatile("s_nop 15\n\ts_nop 7" : "+v"(p[0][0]), "+v"(p[0][1]), "+v"(p[1][0]), "+v"(p[1][1]));
#pragma unroll
        for (int j = 0; j < 2; ++j) {
            float mxa = max3f(p[j][0][0], p[j][0][1], p[j][1][0]), mxb = max3f(p[j][0][2], p[j][0][3], p[j][1][1]);
            mxa = max3f(mxa, p[j][1][2], p[j][1][3]);
#pragma unroll
            for (int r = 4; r < 16; r += 4) { mxa = max3f(mxa, p[j][0][r], p[j][0][r + 1]); mxb = max3f(mxb, p[j][0][r + 2], p[j][0][r + 3]); mxa = max3f(mxa, p[j][1][r], p[j][1][r + 1]); mxb = max3f(mxb, p[j][1][r + 2], p[j][1][r + 3]); }
            float mx = max3f(mxa, mxb, mxa); mx = fmaxf(mx, __shfl_xor(mx, 32));
            const short nb = hi == 0 ? (short)(pk2(-mx, 0.f) & 0xffffu) : (short)0;
            qaug[j] = (bf16x8){nb, 0, 0, 0, 0, 0, 0, 0};
        }
    }
    float lrun[2] = {0.f, 0.f}; f32x16 o[2][2];
#pragma unroll
    for (int j = 0; j < 2; ++j)
#pragma unroll
        for (int d = 0; d < 2; ++d)
#pragma unroll
            for (int r = 0; r < 16; ++r) o[j][d][r] = 0.f;
    const int NT = L / 64;
    const int i16 = lane & 15, qq = i16 >> 2, pp = i16 & 3, blk = (lane >> 4) & 1;
    const int vtr_off = (4 * hi + qq) * VROW + (16 * blk + 4 * pp) * 2;
    for (int kt = 0; kt < NT; ++kt) {
        const int cur = kt & 1;
        const LAS uchar* Kb = Kb0 + cur * KTILE; const LAS uchar* Vb = Vb0 + cur * VTILE;
        f32x16 p[2][2];
#pragma unroll
        for (int j = 0; j < 2; ++j)
#pragma unroll
            for (int hh = 0; hh < 2; ++hh)
#pragma unroll
                for (int r = 0; r < 16; ++r) p[j][hh][r] = 0.f;
#pragma unroll
        for (int ks = 0; ks < 6; ++ks) {
            const bf16x8 k0 = *(const LAS bf16x8*)(Kb + r32 * KROW + ks * 32 + hi * 16);
            const bf16x8 k1 = *(const LAS bf16x8*)(Kb + (32 + r32) * KROW + ks * 32 + hi * 16);
#pragma unroll
            for (int j = 0; j < 2; ++j) {
                p[j][0] = __builtin_amdgcn_mfma_f32_32x32x16_bf16(k0, qf[j][ks], p[j][0], 0, 0, 0);
                p[j][1] = __builtin_amdgcn_mfma_f32_32x32x16_bf16(k1, qf[j][ks], p[j][1], 0, 0, 0);
            }
        }
#pragma unroll
        for (int j = 0; j < 2; ++j) { p[j][0] = __builtin_amdgcn_mfma_f32_32x32x16_bf16(kaug, qaug[j], p[j][0], 0, 0, 0); p[j][1] = __builtin_amdgcn_mfma_f32_32x32x16_bf16(kaug, qaug[j], p[j][1], 0, 0, 0); }
        if (kt + 1 < NT) { LAS uchar* Kn = Kb0 + (cur ^ 1) * KTILE;
            *(LAS u32x4*)(Kn + skey * KROW + sch * 16) = rkn; if (tid < 256) *(LAS u32x4*)(Kn + rkey * KROW + 128 + rch * 16) = rkr; }
        __builtin_amdgcn_sched_barrier(0);
        asm volatile("s_waitcnt lgkmcnt(0)" ::: "memory"); __builtin_amdgcn_s_barrier(); asm volatile("" ::: "memory");
        __builtin_amdgcn_sched_barrier(0);
        __builtin_amdgcn_s_setprio(1);
#pragma unroll
        for (int s = 0; s < 4; ++s) {
            bf16x8 va[2];
#pragma unroll
            for (int db = 0; db < 2; ++db) {
                const LAS uchar* vp = Vb + vtr_off + s * 16 * VROW + db * 64;
                const s16x4 lo = __builtin_bit_cast(s16x4, __builtin_amdgcn_ds_read_tr16_b64_v4i16((LAS s16x4*)vp));
                const s16x4 hh = __builtin_bit_cast(s16x4, __builtin_amdgcn_ds_read_tr16_b64_v4i16((LAS s16x4*)(vp + 8 * VROW)));
                va[db] = __builtin_shufflevector(lo, hh, 0, 1, 2, 3, 4, 5, 6, 7);
            }
#pragma unroll
            for (int j = 0; j < 2; ++j) {
                const f32x16& pp_ = p[j][s >> 1]; const int b = 8 * (s & 1);
                float e[8];
#pragma unroll
                for (int i = 0; i < 8; ++i) e[i] = __builtin_amdgcn_exp2f(pp_[b + i]);
                lrun[j] = fadd_s(lrun[j], fadd_s(fadd_s(fadd_s(e[0], e[1]), fadd_s(e[2], e[3])), fadd_s(fadd_s(e[4], e[5]), fadd_s(e[6], e[7]))));
                u32x4 pw; pw.x = pk2(e[0], e[1]); pw.y = pk2(e[2], e[3]); pw.z = pk2(e[4], e[5]); pw.w = pk2(e[6], e[7]);
                const bf16x8 pbj = __builtin_bit_cast(bf16x8, pw);
                o[j][0] = __builtin_amdgcn_mfma_f32_32x32x16_bf16(va[0], pbj, o[j][0], 0, 0, 0);
                o[j][1] = __builtin_amdgcn_mfma_f32_32x32x16_bf16(va[1], pbj, o[j][1], 0, 0, 0);
                __builtin_amdgcn_sched_barrier(0);
            }
        }
        __builtin_amdgcn_s_setprio(0);
        if (kt + 1 < NT) { LAS uchar* Vn = Vb0 + (cur ^ 1) * VTILE; *(LAS u32x4*)(Vn + skey * VROW + sch * 16) = rv; }
        if (kt + 2 < NT) { const size_t adv = (size_t)(kt + 2) * 64; rkn = *(const u32x4*)(kn_src + adv * NKV); rv = *(const u32x4*)(v_src + adv * NKV); if (tid < 256) rkr = *(const u32x4*)(kr_src + adv * NLAT); }
        asm volatile("s_waitcnt lgkmcnt(0)" ::: "memory"); __builtin_amdgcn_s_barrier(); asm volatile("" ::: "memory");
    }
    if (wid < 4) __builtin_amdgcn_s_barrier();
#pragma unroll
    for (int j = 0; j < 2; ++j) {
        const float ltot = lrun[j] + __shfl_xor(lrun[j], 32); const float inv = 1.f / ltot;
        bf16_t* op = mix + (size_t)(qrow0 + 32 * j) * 2048 + h * 64 + 4 * hi;
#pragma unroll
        for (int g = 0; g < 4; ++g) {
            u32x2 w0, w1;
            w0.x = pk2(o[j][0][4 * g] * inv, o[j][0][4 * g + 1] * inv); w0.y = pk2(o[j][0][4 * g + 2] * inv, o[j][0][4 * g + 3] * inv);
            w1.x = pk2(o[j][1][4 * g] * inv, o[j][1][4 * g + 1] * inv); w1.y = pk2(o[j][1][4 * g + 2] * inv, o[j][1][4 * g + 3] * inv);
            *(u32x2*)(op + 8 * g) = w0; *(u32x2*)(op + 32 + 8 * g) = w1;
        }
    }
}
DI void p5_attention(const Params& P, LAS uchar* lds) {
    const int G = gridDim.x, bx = blockIdx.x; const int vcu = (G % 8 == 0) ? (bx % 8) * (G / 8) + bx / 8 : bx;
    const int perS = (512 + G - 1) / G, perP = (2048 + G - 1) / G;
    for (int i = 0; i < perS; ++i) { const int s = vcu * perS + i; if (s < 512) attn_unit(P, lds, TP, LS, s >> 5, s & 31); }
    for (int i = 0; i < perP; ++i) { const int s = vcu * perP + i; if (s < 2048) { const int b = s >> 6, rem = s & 63; attn_unit(P, lds, b * LP, LP, rem >> 2, rem & 3); } }
}

DI void p8_act(const Params& P, int rows, int row_off) {
    const int gt = blockIdx.x * 512 + otid(), NGT = gridDim.x * 512;
    const bf16_t* g = (const bf16_t*)(P.ws + WS_G); bf16_t* uo = (bf16_t*)(P.ws + WS_U);
    for (int idx = gt; idx < (rows / 8) * 352; idx += NGT) { const int rb = idx / 352, c0 = (idx - rb * 352) * 8; conv8_item<true>(g, uo, DFF, rb * 8, row_off + rb * 8, c0, P.ffn_conv_w, P.ffn_conv_b); }
}
DI void p2_fixup(const Params& P) {
    const int gt = blockIdx.x * 512 + otid(), NGT = gridDim.x * 512;
    const float* halo = (const float*)(P.ws + WS_HALO2); bf16_t* xbc2 = (bf16_t*)(P.ws + WS_XBC2); const size_t hs = (size_t)320 * 2 * NXBC;
    for (int idx = gt; idx < 320 * 2 * NXBC; idx += NGT) {
        const int ch = idx % NXBC, r2 = idx / NXBC, pm = r2 >> 1, lastrow = r2 & 1;
        const int row = pm * 256 + (lastrow ? 255 : 0); const int pos = posof(row), L = lenof(row);
        const float part = halo[(size_t)r2 * NXBC + ch];
        float gn = 0.f, w;
        if (!lastrow) { w = P.conv_w[ch]; if (pos > 0) gn = halo[hs + ((size_t)(pm - 1) * 2 + 1) * NXBC + ch]; }
        else { w = P.conv_w[2 * NXBC + ch]; if (pos < L - 1) gn = halo[hs + ((size_t)(pm + 1) * 2 + 0) * NXBC + ch]; }
        xbc2[(size_t)row * NXBC + ch] = (unsigned short)(pk2(silu(part + w * gn), 0.f) & 0xffffu);
    }
}
DI void p_fixup(const Params& P) {
    const int gt = blockIdx.x * 512 + otid(), NGT = gridDim.x * 512;
    const float* halo = (const float*)(P.ws + WS_HALO); bf16_t* act = (bf16_t*)(P.ws + WS_ACT);
    for (int idx = gt; idx < 320 * 2 * DFF; idx += NGT) {
        const int ch = idx % DFF, r2 = idx / DFF, pm = r2 >> 1, lastrow = r2 & 1;
        const int row = pm * 256 + (lastrow ? 255 : 0); const int pos = posof(row), L = lenof(row);
        const float part = halo[((size_t)(0 * 320 + pm) * 2 + lastrow) * DFF + ch], uv = halo[((size_t)(1 * 320 + pm) * 2 + lastrow) * DFF + ch];
        float gn = 0.f, w;
        if (!lastrow) { w = P.ffn_conv_w[ch]; if (pos > 0) gn = halo[((size_t)(2 * 320 + pm - 1) * 2 + 1) * DFF + ch]; }
        else { w = P.ffn_conv_w[2 * DFF + ch]; if (pos < L - 1) gn = halo[((size_t)(2 * 320 + pm + 1) * 2 + 0) * DFF + ch]; }
        const float v = part + w * gn;
        const unsigned short ob = (unsigned short)(pk2(silu(v) * uv, 0.f) & 0xffffu);
        act[(size_t)row * DFF + ch] = ob;
    }
}
DI void p_final(const Params& P) {
    const int gt = blockIdx.x * 512 + otid(), NGT = gridDim.x * 512;
    const float* ss2 = (const float*)(P.ws + WS_SS) + T;
    for (int idx = gt; idx < T * 256; idx += 4 * NGT) {
        f32x4 v[4]; float rs[4];
#pragma unroll
        for (int k = 0; k < 4; ++k) { const int i = idx + k * NGT; if (i < T * 256) { v[k] = ((const f32x4*)P.out)[i]; rs[k] = ss2[i >> 8]; } }
#pragma unroll
        for (int k = 0; k < 4; ++k) { const int i = idx + k * NGT; if (i < T * 256) { const f32x4 w = ((const f32x4*)P.final_norm)[i & 255]; __builtin_nontemporal_store(v[k] * rsqrtf(rs[k] * (1.f / DM) + EPS) * w, (f32x4*)P.out + i); } }
    }
}

#define XB_TMO      128
#define XB_XCNT(j)  (256  + 64 * (j))
#define XB_XSUB(j)  (1280 + 64 * (j))
#define XB_XGEN(j)  (2304 + 64 * (j))
#define XB_TOP      3328
#define XB_TOPGEN   3392
#define XCD_BAR_WORDS 3456
#define XB_SPIN_CAP (1u << 18)

__device__ __forceinline__ unsigned xb_ld(unsigned* p)              { return __hip_atomic_load(p, __ATOMIC_RELAXED, __HIP_MEMORY_SCOPE_AGENT); }
__device__ __forceinline__ unsigned xb_add(unsigned* p, unsigned v) { return __hip_atomic_fetch_add(p, v, __ATOMIC_RELAXED, __HIP_MEMORY_SCOPE_AGENT); }
__device__ __forceinline__ unsigned xb_xcc_id() { return (unsigned)__builtin_amdgcn_s_getreg((3 << 11) | 20) & 0xFu; }
#define XB_SPIN(cond, bar) do { unsigned _sp = 0; while (cond) { __builtin_amdgcn_s_sleep(1); \
    if ((++_sp & 255u) == 0u) { if (xb_ld(&(bar)[XB_TMO])) break; if (_sp > XB_SPIN_CAP) { atomicAdd(&(bar)[XB_TMO], 1u); break; } } } } while (0)

struct XcdBarrier {
    unsigned* bar; unsigned x;
    volatile LAS unsigned* st;
};

__device__ __forceinline__ XcdBarrier xcd_barrier_post(unsigned* bar, volatile LAS unsigned* st) {
    XcdBarrier b; b.bar = bar; b.x = xb_xcc_id(); b.st = st;
    if (threadIdx.x == 0) (void)xb_add(&bar[XB_XCNT(b.x)], 1u);
    return b;
}
__device__ __forceinline__ void xcd_barrier_complete(unsigned* bar, unsigned x, unsigned& nloc, unsigned& nx) {
    const unsigned G = gridDim.x * gridDim.y * gridDim.z;
    unsigned sum, cnt, mine, sp = 0u;
    for (;;) {
        sum = 0u; cnt = 0u; mine = 0u;
#pragma unroll
        for (unsigned j = 0; j < 16; ++j) { const unsigned c = xb_ld(&bar[XB_XCNT(j)]); sum += c; cnt += (c > 0u) ? 1u : 0u; mine = (j == x) ? c : mine; }
        if (sum == G) break;
        __builtin_amdgcn_s_sleep(1);
        if ((++sp & 255u) == 0u) { if (xb_ld(&bar[XB_TMO])) break; if (sp > XB_SPIN_CAP) { atomicAdd(&bar[XB_TMO], 1u); break; } }
    }
    nloc = mine > 0u ? mine : 1u; nx = cnt > 0u ? cnt : 1u;
}

__device__ __forceinline__ void xcd_barrier(const XcdBarrier& b) {
    asm volatile("s_waitcnt vmcnt(0)" ::: "memory");
    __syncthreads();
    if (threadIdx.x == 0) {
        unsigned* bar = b.bar; const unsigned bx_ = xb_xcc_id();
        __builtin_amdgcn_s_waitcnt(0);
        unsigned nloc = b.st[0], nx = b.st[1];
        if (nloc == 0u) { xcd_barrier_complete(bar, bx_, nloc, nx); b.st[0] = nloc; b.st[1] = nx; }
        const unsigned old = xb_add(&bar[XB_XSUB(bx_)], 1u);
        const unsigned gen = old / nloc;
        if (old + 1u == (gen + 1u) * nloc) {
            __builtin_amdgcn_fence(__ATOMIC_RELEASE, "agent");
            asm volatile("s_waitcnt vmcnt(0)" ::: "memory");
            const unsigned og = xb_add(&bar[XB_TOP], 1u);
            const unsigned tg = og / nx;
            if (og + 1u == (tg + 1u) * nx) xb_add(&bar[XB_TOPGEN], 1u);
            else XB_SPIN(xb_ld(&bar[XB_TOPGEN]) == tg, bar);
            __builtin_amdgcn_fence(__ATOMIC_ACQUIRE, "agent");
            xb_add(&bar[XB_XGEN(bx_)], 1u);
            asm volatile("s_waitcnt vmcnt(0)" ::: "memory");
        } else {
            XB_SPIN(xb_ld(&bar[XB_XGEN(bx_)]) == gen, bar);
            __builtin_amdgcn_fence(__ATOMIC_ACQUIRE, "agent");
            asm volatile("s_waitcnt vmcnt(0)" ::: "memory");
        }
    }
    __syncthreads();
}

constexpr int LDS_BYTES = 151552;
template <class Epi> DI void run_gemm(LAS uchar* lds, const bf16_t* A, int lda, const bf16_t* Bt, int M, int N, int K, const Epi& E) {
    pg8::Gemm g{A, Bt, M, N, K, lda}; pg8::StaticOrder S; S.init(M, N, (int)gridDim.x, (int)blockIdx.x);
    pg8::gemm_phase<Epi, pg8::StaticOrder, true, true>(lds, g, S, E);
}
__global__ void __launch_bounds__(512, 2) mega(Params P) {
    extern __shared__ __attribute__((aligned(16))) uchar lds_[];
    LAS uchar* lds = (LAS uchar*)lds_;
    cg::grid_group grid = cg::this_grid();
    uchar* ws = P.ws;
    volatile LAS unsigned* bst = (volatile LAS unsigned*)(lds + LDS_BYTES - 16);
    if (threadIdx.x < 4) bst[threadIdx.x] = 0u;
    __syncthreads();
    const XcdBarrier bar = xcd_barrier_post((unsigned*)(ws + WS_BAR), bst);
    bf16_t* lat = (bf16_t*)(ws + WS_LAT); float* ss = (float*)(ws + WS_SS);
    unsigned long long tA_ = 0, tacc_ = 0;
    PB(0); p0_prologue(P, lds);
    if (P.ws == nullptr) grid.sync();
    xcd_barrier(bar); PE(0);
    PB(1);
    { EpiIn2 E{(bf16_t*)(ws + WS_Z), (bf16_t*)(ws + WS_XBC2), lat, (float*)(ws + WS_DT), ss + 2 * T, ss + 3 * T, (const float*)(ws + WS_TAB), P.conv_w, P.conv_b, (float*)(ws + WS_HALO2), (LAS float*)(lds + XCH_OFF), P.dt_bias_f, P.dt_bias_b, 0};
      run_gemm(lds, (const bf16_t*)(ws + WS_H), DM, (const bf16_t*)(ws + WS_WIN), T, DINP, DM, E); }
    xcd_barrier(bar); PE(1);
    PB(2); p2_fixup(P);
    xcd_barrier(bar); PE(2);
    PB(3); p3_s1_states(P, lds);
    xcd_barrier(bar); PE(3);
    PB(4); p3_s2_scan(P);
    xcd_barrier(bar); PE(4);
    PB(5); p3_s3_output(P, lds, tacc_);
    xcd_barrier(bar); PE(5);
    PB(6);
    { EpiPlain E{(bf16_t*)P.out, NQ, QSCALE, ss + 2 * T, 1.f / 384.f};
      run_gemm(lds, lat, NLAT, (const bf16_t*)(ws + WS_WQB), T, NQ, 384, E); }
    __syncthreads();
    { EpiPlain E{(bf16_t*)(ws + WS_KV), NKV, 1.0f, ss + 3 * T, 1.f / 256.f};
      run_gemm(lds, lat + 384, NLAT, (const bf16_t*)(ws + WS_WKVB), T, NKV, 256, E); }
    xcd_barrier(bar); PE(6);
    PB(7); p5_attention(P, lds);
    xcd_barrier(bar); PE(7);
    PB(8);
    { EpiRes E{P.xp, P.xs, nullptr, (bf16_t*)(ws + WS_X1B), ss, 0, nullptr};
      run_gemm(lds, (const bf16_t*)(ws + WS_MIX), 2048, (const bf16_t*)(ws + WS_WOUT), T, DM, 2048, E); }
    xcd_barrier(bar); PE(8);
    PB(9);
    { EpiGU2 E{(bf16_t*)(ws + WS_ACT), ss, P.ffn_conv_w, P.ffn_conv_b, (float*)(ws + WS_HALO), (LAS float*)(lds + XCH_OFF), 0};
      run_gemm(lds, (const bf16_t*)(ws + WS_X1B), DM, (const bf16_t*)(ws + WS_WGU), T, NGU, DM, E); }
    xcd_barrier(bar); PE(9);
    PB(10); p_fixup(P);
    xcd_barrier(bar); PE(10);
    PB(11);
    { EpiRes E{nullptr, nullptr, P.out, nullptr, ss + T, 0, (const bf16_t*)(ws + WS_X1B)};
      run_gemm(lds, (const bf16_t*)(ws + WS_ACT), DFF, (const bf16_t*)(ws + WS_WDN), T, DM, DFF, E); }
    xcd_barrier(bar); PE(11);
    PB(12); p_final(P); PE(12);
    if (PROBE_MASK && blockIdx.x == 0) { const unsigned long long t0_ = __builtin_amdgcn_s_memrealtime(); while (__builtin_amdgcn_s_memrealtime() - t0_ < (unsigned long long)PROBE_K * tacc_) __builtin_amdgcn_s_sleep(8); }
}

extern "C" void kernel_launch(void* const* d_in, const int* in_sizes, int n_in, void* d_out, int out_size, void* d_ws, size_t ws_size, hipStream_t stream) {
    static int grid = 0;
    if (grid == 0) {
        int dev = 0, cus = 0, per_cu = 0;
        hipGetDevice(&dev); hipDeviceGetAttribute(&cus, hipDeviceAttributeMultiprocessorCount, dev);
        hipFuncSetAttribute((const void*)mega, hipFuncAttributeMaxDynamicSharedMemorySize, LDS_BYTES);
        if (hipOccupancyMaxActiveBlocksPerMultiprocessor(&per_cu, (const void*)mega, 512, LDS_BYTES) != hipSuccess || per_cu < 1) per_cu = 1;
        (void)hipGetLastError();
        grid = cus * per_cu;
        if (ws_size < 1020 * MiB) fprintf(stderr, "kernel_launch: workspace too small: %zu\n", ws_size);
    }
    (void)hipMemsetAsync((char*)d_ws + WS_BAR, 0, 16384, stream);
    Params p{};
    const float** pf = (const float**)&p;
    for (int i = 0; i < 24; ++i) pf[i] = (const float*)d_in[i];
    p.out = (float*)d_out; p.ws = (uchar*)d_ws;
    void* args[] = {&p};
    hipError_t e = hipLaunchCooperativeKernel((const void*)mega, dim3(grid), dim3(512), args, LDS_BYTES, stream);
    if (e != hipSuccess) fprintf(stderr, "cooperative launch failed: %s (grid %d)\n", hipGetErrorString(e), grid);
}
```
